# Optimizing an MI355X kernel written in HIP

```python
import jax, jax.numpy as jnp
from jax import lax
import numpy as np

D_MODEL = 1024
BATCH = 2
SEQ = 8192
DEPTH = 1

MIX_WIDTH = D_MODEL
HGRN_WIDTH = MIX_WIDTH // 2
CONV_WIDTH = MIX_WIDTH - HGRN_WIDTH
HGRN_HEAD_DIM = 128
HGRN_HEADS = HGRN_WIDTH // HGRN_HEAD_DIM
CONV_GROUPS = 4
CONV_GROUP_DIM = CONV_WIDTH // CONV_GROUPS
CONV_TAPS = 3
CHUNK = 64
IN_COLS = 4 * HGRN_WIDTH + 3 * CONV_WIDTH
PEER_HEADS = 8
PEER_NKEYS = 128
PEER_EXPERTS = PEER_NKEYS * PEER_NKEYS
PEER_QDIM = 256
PEER_HALF = PEER_QDIM // 2
PEER_TOPK = 16
TOKEN_BLOCK = 128
EPS = 1e-6

kernel_name = "hymba_hgrn2_shortconv_peer_adaln"


def rmsnorm(x, w):
    xf = x.astype(jnp.float32)
    y = xf * lax.rsqrt(jnp.mean(xf * xf, axis=-1, keepdims=True) + EPS)
    return (y * w.astype(jnp.float32)).astype(x.dtype)


def group_rmsnorm(x, w, groups):
    shp = x.shape
    xg = x.reshape(shp[:-1] + (groups, shp[-1] // groups))
    return rmsnorm(xg, w.reshape(groups, shp[-1] // groups)).reshape(shp)


def hgrn2_chunkwise(q, k, v, log_f):
    B, H, S, DK = q.shape
    DV = v.shape[-1]
    n = S // CHUNK

    def to_chunks(t):
        return t.reshape(B, H, n, CHUNK, t.shape[-1]).transpose(2, 0, 1, 3, 4)

    qc, kc, vc, gc = to_chunks(q), to_chunks(k), to_chunks(v), to_chunks(log_f)
    causal = jnp.tril(jnp.ones((CHUNK, CHUNK), dtype=bool))[:, :, None]

    def step(state, inp):
        qb, kb, vb, gb = inp
        b = jnp.cumsum(gb, axis=2)
        diff = b[:, :, :, None, :] - b[:, :, None, :, :]
        decay = jnp.exp(jnp.where(causal, diff, -jnp.inf))
        scores = jnp.einsum('bhtd,bhsd,bhtsd->bhts', qb, kb, decay)
        o = (jnp.einsum('bhts,bhsv->bhtv', scores, vb)
             + jnp.einsum('bhtd,bhdv->bhtv', qb * jnp.exp(b), state))
        b_last = b[:, :, -1:, :]
        new_state = (jnp.exp(b_last[:, :, 0, :])[..., None] * state
                     + jnp.einsum('bhsd,bhsv->bhdv', kb * jnp.exp(b_last - b), vb))
        return new_state, o

    s0 = jnp.zeros((B, H, DK, DV), jnp.float32)
    _, o = lax.scan(step, s0, (qc, kc, vc, gc))
    return o.transpose(1, 2, 0, 3, 4).reshape(B, H, S, DV)


def hgrn2_group(p, lb, onorm_w):
    B, S, _ = p.shape
    pf = p.astype(jnp.float32)
    q, f_raw, i, g = jnp.split(pf, 4, axis=-1)
    f = lb + (1.0 - lb) * jax.nn.sigmoid(f_raw)
    log_f = jnp.log(f)
    k = (1.0 - lb) * jax.nn.sigmoid(-f_raw)

    def heads(t):
        return t.reshape(B, S, HGRN_HEADS, HGRN_HEAD_DIM).transpose(0, 2, 1, 3)

    o = hgrn2_chunkwise(heads(q), heads(k), heads(i), heads(log_f))
    o = o.transpose(0, 2, 1, 3).reshape(B, S, HGRN_WIDTH)
    o = group_rmsnorm(o, onorm_w, HGRN_HEADS) * jax.nn.silu(g)
    return o.astype(p.dtype)


def short_conv_group(p, conv_w, onorm_w):
    b_gate, c_gate, xin = jnp.split(p, 3, axis=-1)
    u = c_gate * xin
    y = lax.conv_general_dilated(
        u, conv_w[:, None, :].astype(u.dtype), window_strides=(1,),
        padding=[(CONV_TAPS - 1, 0)], dimension_numbers=('NWC', 'WIO', 'NWC'),
        feature_group_count=CONV_WIDTH)
    y = b_gate * y
    return group_rmsnorm(y, onorm_w, CONV_GROUPS)


def peer(h, w_query, sub_keys, expert_u, expert_v):
    B, S, D = h.shape
    hb = h.reshape(B * S // TOKEN_BLOCK, TOKEN_BLOCK, D)

    def block(xb):
        T = xb.shape[0]
        q = (xb @ w_query).reshape(T, PEER_HEADS, 2, PEER_HALF)
        s = jnp.einsum('thpk,hpnk->thpn', q, sub_keys).astype(jnp.float32)
        top_s, top_i = lax.top_k(s, PEER_TOPK)
        cand_s = top_s[:, :, 0, :, None] + top_s[:, :, 1, None, :]
        cand_i = top_i[:, :, 0, :, None] * PEER_NKEYS + top_i[:, :, 1, None, :]
        best_s, best_pos = lax.top_k(cand_s.reshape(T, PEER_HEADS, PEER_TOPK * PEER_TOPK), PEER_TOPK)
        idx = jnp.take_along_axis(cand_i.reshape(T, PEER_HEADS, PEER_TOPK * PEER_TOPK), best_pos, axis=-1)
        gate = jax.nn.softmax(best_s, axis=-1)
        u = expert_u[idx]
        v = expert_v[idx]
        act = jax.nn.gelu(jnp.einsum('td,thkd->thk', xb, u).astype(jnp.float32), approximate=False)
        return jnp.einsum('thk,thkd->td', (gate * act).astype(xb.dtype), v)

    return lax.map(block, hb).reshape(B, S, D)


def setup_inputs(seed: int = 0) -> dict:
    key = jax.random.key(seed)
    ks = jax.random.split(key, 17)
    f32 = jnp.float32
    D = D_MODEL
    return {
        "x": jax.random.normal(ks[0], (BATCH, SEQ, D), f32),
        "c": jax.random.normal(ks[1], (BATCH, D), f32),
        "w_ada": jax.random.normal(ks[2], (DEPTH, D, 6 * D), f32) * (0.5 * D ** -0.5),
        "b_ada": jax.random.normal(ks[3], (DEPTH, 6 * D), f32) * 0.02,
        "norm1_w": 1.0 + 0.02 * jax.random.normal(ks[4], (DEPTH, D), f32),
        "w_in": jax.random.normal(ks[5], (DEPTH, D, IN_COLS), f32) * D ** -0.5,
        "hgrn_lb_logits": jax.random.normal(ks[6], (DEPTH + 1, HGRN_WIDTH), f32) * 0.5,
        "hgrn_onorm_w": 1.0 + 0.02 * jax.random.normal(ks[7], (DEPTH, HGRN_WIDTH), f32),
        "conv_w": jax.random.normal(ks[8], (DEPTH, CONV_TAPS, CONV_WIDTH), f32) * CONV_TAPS ** -0.5,
        "conv_onorm_w": 1.0 + 0.02 * jax.random.normal(ks[9], (DEPTH, CONV_WIDTH), f32),
        "w_out": jax.random.normal(ks[10], (DEPTH, MIX_WIDTH, D), f32) * MIX_WIDTH ** -0.5,
        "norm2_w": 1.0 + 0.02 * jax.random.normal(ks[11], (DEPTH, D), f32),
        "peer_w_query": jax.random.normal(ks[12], (DEPTH, D, PEER_HEADS * PEER_QDIM), f32) * D ** -0.5,
        "peer_sub_keys": jax.random.normal(ks[13], (DEPTH, PEER_HEADS, 2, PEER_NKEYS, PEER_HALF), f32) * PEER_HALF ** -0.5,
        "peer_u": jax.random.normal(ks[14], (DEPTH, PEER_EXPERTS, D), f32) * D ** -0.5,
        "peer_v": jax.random.normal(ks[15], (DEPTH, PEER_EXPERTS, D), f32),
        "final_norm_w": 1.0 + 0.02 * jax.random.normal(ks[16], (D,), f32),
    }


def reference(x, c, w_ada, b_ada, norm1_w, w_in, hgrn_lb_logits, hgrn_onorm_w, conv_w,
              conv_onorm_w, w_out, norm2_w, peer_w_query, peer_sub_keys, peer_u, peer_v,
              final_norm_w):
    lower_bounds = jnp.cumsum(jax.nn.softmax(hgrn_lb_logits.astype(jnp.float32), axis=0), axis=0)
    c_act = jax.nn.silu(c)
    for l in range(DEPTH):
        mod = (c_act @ w_ada[l] + b_ada[l])[:, None, :]
        shift1, scale1, gate1, shift2, scale2, gate2 = jnp.split(mod, 6, axis=-1)

        h = rmsnorm(x, norm1_w[l]) * (1.0 + scale1) + shift1
        proj = h @ w_in[l]
        y_a = hgrn2_group(proj[..., :4 * HGRN_WIDTH], lower_bounds[l], hgrn_onorm_w[l])
        y_b = short_conv_group(proj[..., 4 * HGRN_WIDTH:], conv_w[l], conv_onorm_w[l])
        mix = jnp.concatenate([y_a, y_b], axis=-1) @ w_out[l]
        x = x + gate1 * mix

        h = rmsnorm(x, norm2_w[l]) * (1.0 + scale2) + shift2
        x = x + gate2 * peer(h, peer_w_query[l], peer_sub_keys[l], peer_u[l], peer_v[l])
    return rmsnorm(x, final_norm_w)
```

```cpp
#include <hip/hip_runtime.h>
#include <hip/hip_cooperative_groups.h>
#include <cstdio>
#include <cstdint>
namespace cg = cooperative_groups;

#ifndef MK_LAUNCHES
#define MK_LAUNCHES 1
#endif

#define LAS __attribute__((address_space(3)))
typedef unsigned short bf16;
typedef unsigned v4u __attribute__((ext_vector_type(4)));
typedef unsigned v2u __attribute__((ext_vector_type(2)));
typedef float f32x4 __attribute__((ext_vector_type(4)));
typedef short bf16x8 __attribute__((ext_vector_type(8)));
typedef __bf16 bf16x2 __attribute__((ext_vector_type(2)));

constexpr int D = 1024, SEQ = 8192, M = 16384;
constexpr int NIN = 3584, NQ = 2048;
constexpr float EPS = 1e-6f;
constexpr int NWAVES = 8, NTHR = 512;

constexpr size_t MiB = 1u << 20;
constexpr size_t WS_ACH = 1 * MiB;
constexpr size_t WS_MOD = 1 * MiB + 512 * 1024;
constexpr size_t WS_LB = WS_MOD + 64 * 1024;
constexpr size_t WS_WIN = 2 * MiB;
constexpr size_t WS_WOUT = 9 * MiB;
constexpr size_t WS_WQ = 11 * MiB;
constexpr size_t WS_KEYS = 15 * MiB;
constexpr size_t WS_UE = 16 * MiB, WS_VE = 48 * MiB;
constexpr size_t WS_H1 = 80 * MiB;
constexpr size_t WS_PROJ = 112 * MiB;
constexpr size_t WS_ST = 224 * MiB;
constexpr size_t WS_END = 256 * MiB;
constexpr int LDS_BYTES = 147456, MISC_OFF = 147456 - 256;
constexpr size_t WS_CTL = 0, CTL_ZERO_BYTES = 65536;

__device__ __forceinline__ float bf2f(unsigned h) { return __uint_as_float(h << 16); }
__device__ __forceinline__ unsigned f2bf(float f) { unsigned u = __float_as_uint(f); return (u + 0x7fffu + ((u >> 16) & 1u)) >> 16; }
typedef float f32x2 __attribute__((ext_vector_type(2)));
__device__ __forceinline__ unsigned pk2(float lo, float hi) { const f32x2 v = {lo, hi}; return __builtin_bit_cast(unsigned, __builtin_convertvector(v, bf16x2)); }
__device__ __forceinline__ float dot2(unsigned w, unsigned x, float acc) { return __builtin_amdgcn_fdot2_f32_bf16(__builtin_bit_cast(bf16x2, w), __builtin_bit_cast(bf16x2, x), acc, false); }
__device__ __forceinline__ float wave_sum(float v) {
#pragma unroll
    for (int o = 1; o < 64; o <<= 1) v += __shfl_xor(v, o);
    return v;
}

namespace pg8 {
constexpr int BM = 256, BK = 64, HALF = 128, HTB = HALF * BK * 2, STAGE_BYTES = 8 * HTB, NXCD = 8, WGM = 8;
__host__ __device__ __forceinline__ int lds_byte(int r, int c) { const int st = (r >> 4) * 2 + (c >> 5), rr = r & 15, cc = c & 31, ob = rr * 64 + cc * 2; return st * 1024 + (ob ^ (((ob >> 9) & 1) << 5)); }
__host__ __device__ __forceinline__ void stage_rc(int b, int& R, int& C) { const int st = b / 1024, sb = b % 1024, swz = sb ^ (((sb >> 9) & 1) << 5); R = (st >> 1) * 16 + swz / 64; C = (st & 1) * 32 + (swz % 64) / 2; }
__host__ __device__ __forceinline__ int perm32(int rho) { const int n = rho >> 4, i = rho & 15; return 8 * (i >> 2) + 4 * n + (i & 3); }
struct Unit { int pm, pn; };
struct Gemm { const bf16* A; const bf16* Bt; int M, N, K; };
struct StaticOrder {
    int nM, nN, nwg, G, c;
    __host__ __device__ void init(int M_, int N_, int G_, int c_) { nM = M_ / BM; nN = N_ / BM; nwg = nM * nN; G = G_; c = c_; }
    __host__ __device__ bool next(int i, Unit& u) const {
        const long L = (long)i * G + c; if (L >= nwg) return false;
        int wgid = (int)L; { const int q = nwg / NXCD, r = nwg % NXCD, xcd = wgid % NXCD, off = wgid / NXCD; wgid = (xcd < r ? xcd * (q + 1) : r * (q + 1) + (xcd - r) * q) + off; }
        const int nig = WGM * nN, gid = wgid / nig, fm = gid * WGM, gsz = (nM - fm) < WGM ? (nM - fm) : WGM;
        u.pm = fm + ((wgid % nig) % gsz); u.pn = (wgid % nig) / gsz; return true;
    }
};
struct EpiBf16 {
    static constexpr bool PERM = true;
    bf16* O; int ldc;
    __device__ __forceinline__ void operator()(const f32x4 (&acc)[2][2][4][2], const Unit& u, int wr, int wc, int fr, int fq) const {
        const int row0 = u.pm * BM + wr * 64 + fr; const int col0 = u.pn * BM + wc * 32 + 8 * fq;
#pragma unroll
        for (int ai = 0; ai < 2; ++ai)
#pragma unroll
            for (int m = 0; m < 4; ++m) { bf16* rowp = O + (size_t)(row0 + ai * HALF + m * 16) * ldc + col0;
#pragma unroll
                for (int bj = 0; bj < 2; ++bj) { const f32x4 v0 = acc[ai][bj][m][0], v1 = acc[ai][bj][m][1];
                    v4u w; w.x = pk2(v0[0], v0[1]); w.y = pk2(v0[2], v0[3]); w.z = pk2(v1[0], v1[1]); w.w = pk2(v1[2], v1[3]);
                    *(v4u*)(rowp + bj * HALF) = w; } }
    }
};
struct EpiRes {
    static constexpr bool PERM = false;
    const float* x; float* out; const float* mod;
    __device__ __forceinline__ void operator()(const f32x4 (&acc)[2][2][4][2], const Unit& u, int wr, int wc, int fr, int fq) const {
        const int row0 = u.pm * BM + wr * 64 + fr, col0 = u.pn * BM + wc * 32 + 4 * fq; const int b = u.pm >> 5;
        f32x4 gv[2][2];
#pragma unroll
        for (int bj = 0; bj < 2; ++bj)
#pragma unroll
            for (int n = 0; n < 2; ++n) gv[bj][n] = *(const f32x4*)(mod + b * 6144 + 2048 + col0 + bj * HALF + n * 16);
#pragma unroll
        for (int ai = 0; ai < 2; ++ai)
#pragma unroll
            for (int m = 0; m < 4; ++m) { const size_t off = (size_t)(row0 + ai * HALF + m * 16) * D + col0;
#pragma unroll
                for (int bj = 0; bj < 2; ++bj)
#pragma unroll
                    for (int n = 0; n < 2; ++n) { const f32x4 xv = *(const f32x4*)(x + off + bj * HALF + n * 16);
                        *(f32x4*)(out + off + bj * HALF + n * 16) = xv + gv[bj][n] * acc[ai][bj][m][n]; } }
    }
};

template <class Epi, bool ALIGN_EPI = true>
__device__ __forceinline__ void gemm_phase(LAS unsigned char* lds, const Gemm g, const StaticOrder& S, const Epi& E) {
    const int tid = threadIdx.x, wid = __builtin_amdgcn_readfirstlane(tid >> 6), lane = tid & 63, wr = wid >> 2, wc = wid & 3, fr = lane & 15, fq = lane >> 4;
    const int K = g.K, nt = K / BK;
    unsigned voffA[2], voffB[2];
#pragma unroll
    for (int i = 0; i < 2; ++i) { int R, C; stage_rc(tid * 16 + i * 8192, R, C); const int Rb = Epi::PERM ? ((R & ~31) + perm32(R & 31)) : R;
        voffA[i] = (unsigned)(R * K + C) * 2u; voffB[i] = (unsigned)(Rb * K + C) * 2u; }
    const size_t kstep = (size_t)(BK * 2);
    const size_t hstep = (size_t)HALF * K * 2;
    const size_t tstep = 2 * hstep;
    const unsigned ldsw = (unsigned)wid * 1024u;
    const int aoff = lds_byte(wr * 64 + fr, fq * 8), boff = lds_byte(wc * 32 + fr, fq * 8);
#define PG8_SA(b, h) (((b) * 2 + (h)) * HTB)
#define PG8_SB(b, h) ((4 + (b) * 2 + (h)) * HTB)
#define PG8_STAGE(bufoff, gbase, voff) do { _Pragma("unroll") for (int _i = 0; _i < 2; ++_i) \
        __builtin_amdgcn_global_load_lds((const unsigned*)((const char*)(gbase) + (voff)[_i]), (LAS unsigned*)(lds + (bufoff) + ldsw + _i * 8192), 16, 0, 0); } while (0)
#define PG8_LDA(dst, b, h) do { _Pragma("unroll") for (int m = 0; m < 4; ++m) _Pragma("unroll") for (int k = 0; k < 2; ++k) dst[m][k] = *(const LAS bf16x8*)(lds + PG8_SA(b, h) + aoff + m * 2048 + k * 1024); } while (0)
#define PG8_LDB(dst, b, h) do { _Pragma("unroll") for (int n = 0; n < 2; ++n) _Pragma("unroll") for (int k = 0; k < 2; ++k) dst[n][k] = *(const LAS bf16x8*)(lds + PG8_SB(b, h) + boff + n * 2048 + k * 1024); } while (0)
#define PG8_MMA(ai, bj, At, Bt) do { __builtin_amdgcn_s_setprio(1); _Pragma("unroll") for (int m = 0; m < 4; ++m) _Pragma("unroll") for (int n = 0; n < 2; ++n) _Pragma("unroll") for (int k = 0; k < 2; ++k) \
        acc[ai][bj][m][n] = __builtin_amdgcn_mfma_f32_16x16x32_bf16(Bt[n][k], At[m][k], acc[ai][bj][m][n], 0, 0, 0); __builtin_amdgcn_s_setprio(0); } while (0)
#define PG8_WAIT_V(n) asm volatile("s_waitcnt vmcnt(" #n ")" ::: "memory")
#define PG8_WAIT_L(n) asm volatile("s_waitcnt lgkmcnt(" #n ")" ::: "memory")
#define PG8_BAR __builtin_amdgcn_s_barrier()
#define PG8_SCHED __builtin_amdgcn_sched_barrier(0)
    Unit cur, nxt; int ui = 0;
    if (!S.next(0, cur)) return;
    f32x4 acc[2][2][4][2];
#pragma unroll
    for (int a = 0; a < 2; ++a)
#pragma unroll
        for (int b = 0; b < 2; ++b)
#pragma unroll
            for (int m = 0; m < 4; ++m)
#pragma unroll
                for (int n = 0; n < 2; ++n) acc[a][b][m][n] = (f32x4){0.f, 0.f, 0.f, 0.f};
    bf16x8 At[4][2], B0[2][2], B1[2][2];
    const char* cA = (const char*)g.A + (size_t)cur.pm * tstep; const char* cB = (const char*)g.Bt + (size_t)cur.pn * tstep;
    PG8_STAGE(PG8_SB(0, 0), cB, voffB); PG8_STAGE(PG8_SB(0, 1), cB + hstep, voffB); PG8_STAGE(PG8_SA(0, 0), cA, voffA); PG8_STAGE(PG8_SA(0, 1), cA + hstep, voffA);
    if (wr == 1) PG8_BAR;
    PG8_WAIT_V(2); PG8_BAR;
    PG8_STAGE(PG8_SB(1, 0), cB + kstep, voffB); PG8_STAGE(PG8_SA(1, 0), cA + kstep, voffA); PG8_STAGE(PG8_SB(1, 1), cB + hstep + kstep, voffB);
    PG8_WAIT_V(6); PG8_BAR;
    for (;;) {
        const bool has_next = S.next(ui + 1, nxt);
        const char* nA = has_next ? (const char*)g.A + (size_t)nxt.pm * tstep : cA; const char* nB = has_next ? (const char*)g.Bt + (size_t)nxt.pn * tstep : cB;
        for (int t = 0; t < nt; t += 2) {
            const bool last = (t == nt - 2);
            const char* a1 = cA + (size_t)(t + 1) * kstep;
            const char* a2 = last ? nA : cA + (size_t)(t + 2) * kstep; const char* b2 = last ? nB : cB + (size_t)(t + 2) * kstep;
            const char* a3 = a2 + kstep; const char* b3 = b2 + kstep;
            PG8_LDB(B0, 0, 0); PG8_LDB(B1, 0, 1); PG8_SCHED; PG8_LDA(At, 0, 0); PG8_STAGE(PG8_SA(1, 1), a1 + hstep, voffA);
            PG8_WAIT_V(8); PG8_WAIT_L(0); PG8_BAR; PG8_MMA(0, 0, At, B0); PG8_MMA(0, 1, At, B1); PG8_BAR; PG8_SCHED;
            PG8_LDA(At, 0, 1); PG8_STAGE(PG8_SB(0, 0), b2, voffB); PG8_STAGE(PG8_SB(0, 1), b2 + hstep, voffB); PG8_STAGE(PG8_SA(0, 0), a2, voffA);
            PG8_WAIT_V(8); PG8_WAIT_L(0); PG8_BAR; PG8_MMA(1, 0, At, B0); PG8_MMA(1, 1, At, B1); PG8_BAR; PG8_SCHED;
            PG8_LDB(B0, 1, 0); PG8_LDB(B1, 1, 1); PG8_SCHED; PG8_LDA(At, 1, 0); PG8_STAGE(PG8_SA(0, 1), a2 + hstep, voffA);
            PG8_WAIT_V(8); PG8_WAIT_L(0); PG8_BAR; PG8_MMA(0, 0, At, B0); PG8_MMA(0, 1, At, B1); PG8_BAR; PG8_SCHED;
            PG8_LDA(At, 1, 1); PG8_STAGE(PG8_SB(1, 0), b3, voffB); PG8_STAGE(PG8_SB(1, 1), b3 + hstep, voffB); PG8_STAGE(PG8_SA(1, 0), a3, voffA);
            PG8_WAIT_V(8); PG8_WAIT_L(0); PG8_BAR; PG8_MMA(1, 0, At, B0); PG8_MMA(1, 1, At, B1); PG8_BAR; PG8_SCHED;
        }
        if constexpr (ALIGN_EPI) { if (wr == 0) PG8_BAR; }
        E(acc, cur, wr, wc, fr, fq);
        if (!has_next) break;
#pragma unroll
        for (int a = 0; a < 2; ++a)
#pragma unroll
            for (int b = 0; b < 2; ++b)
#pragma unroll
                for (int m = 0; m < 4; ++m)
#pragma unroll
                    for (int n = 0; n < 2; ++n) acc[a][b][m][n] = (f32x4){0.f, 0.f, 0.f, 0.f};
        cur = nxt; cA = nA; cB = nB; ++ui;
        if constexpr (ALIGN_EPI) { if (wr == 1) PG8_BAR; }
    }
    PG8_WAIT_V(0);
    if constexpr (!ALIGN_EPI) { if (wr == 0) PG8_BAR; }
    PG8_BAR;
#undef PG8_SA
#undef PG8_SB
#undef PG8_STAGE
#undef PG8_LDA
#undef PG8_LDB
#undef PG8_MMA
#undef PG8_WAIT_V
#undef PG8_WAIT_L
#undef PG8_BAR
#undef PG8_SCHED
}
}

struct Args { const float* in[17]; float* out; unsigned char* ws; int ph_lo, ph_hi; };
struct Ctx {
    LAS unsigned char* lds; int tid, lane, wave, G, bid;
    const float *x, *c, *w_ada, *b_ada, *norm1_w, *w_in, *lb_logits, *hgrn_onorm_w, *conv_w, *conv_onorm_w, *w_out, *norm2_w, *w_query, *sub_keys, *peer_u, *peer_v, *final_w;
    float* out; float *ACH, *MOD, *LB;
    bf16 *WIN, *WOUT, *WQ, *KEYS, *UE, *VE, *H1, *YCAT, *PROJ, *H2, *QP, *ST;
};

__device__ __forceinline__ void p0_transpose_item(const float* W, int K, int N, bf16* WT, LAS float* scr, int item, int lane) {
    const int nblk = N / 32, kb = item / nblk, nb = item % nblk, k0 = 64 * kb, n0 = 32 * nb;
#pragma unroll 8
    for (int i = 0; i < 32; ++i) { const int kk = 2 * i + (lane >> 5); scr[kk * 33 + (lane & 31)] = W[(size_t)(k0 + kk) * N + n0 + (lane & 31)]; }
    asm volatile("s_waitcnt lgkmcnt(0)" ::: "memory"); __builtin_amdgcn_wave_barrier();
    const int c = lane & 7;
#pragma unroll
    for (int j = 0; j < 4; ++j) { const int n = (lane >> 3) + 8 * j; const LAS float* s = scr + (8 * c) * 33 + n;
        v4u o; o.x = pk2(s[0 * 33], s[1 * 33]); o.y = pk2(s[2 * 33], s[3 * 33]); o.z = pk2(s[4 * 33], s[5 * 33]); o.w = pk2(s[6 * 33], s[7 * 33]);
        *(v4u*)(WT + (size_t)(n0 + n) * K + k0 + 8 * c) = o; }
    asm volatile("s_waitcnt lgkmcnt(0)" ::: "memory"); __builtin_amdgcn_wave_barrier();
}
__device__ __forceinline__ void cvt_stream(const float* src, bf16* dst, size_t n8, size_t gtid, size_t gstride) {
    for (size_t i = gtid; i < n8; i += gstride) {
        const f32x4 a = *(const f32x4*)(src + i * 8), b = *(const f32x4*)(src + i * 8 + 4);
        v4u o; o.x = pk2(a[0], a[1]); o.y = pk2(a[2], a[3]); o.z = pk2(b[0], b[1]); o.w = pk2(b[2], b[3]);
        *(v4u*)(dst + i * 8) = o;
    }
}

__device__ __forceinline__ void p0_prep(Ctx& F) {
    {
        LAS float* sc = (LAS float*)(F.lds);
        LAS float* part = (LAS float*)(F.lds + 8192);
        for (int u = F.bid; u < 96; u += F.G) {
            for (int i = F.tid; i < 2048; i += NTHR) { const float v = F.c[i]; sc[i] = v / (1.f + __expf(-v)); }
            __syncthreads();
            const int cgp = F.tid & 15, kg = F.tid >> 4, n0 = 64 * u + 4 * cgp;
            f32x4 a0 = {0.f, 0.f, 0.f, 0.f}, a1 = {0.f, 0.f, 0.f, 0.f};
#pragma unroll 4
            for (int k = kg; k < 1024; k += 32) { const f32x4 w = *(const f32x4*)(F.w_ada + (size_t)k * 6144 + n0); a0 += w * sc[k]; a1 += w * sc[1024 + k]; }
            *(LAS f32x4*)(part + (kg * 2 + 0) * 64 + 4 * cgp) = a0; *(LAS f32x4*)(part + (kg * 2 + 1) * 64 + 4 * cgp) = a1;
            __syncthreads();
            if (F.tid < 128) { const int b = F.tid >> 6, col = F.tid & 63; float s = F.b_ada[64 * u + col];
#pragma unroll 8
                for (int q = 0; q < 32; ++q) s += part[(q * 2 + b) * 64 + col];
                F.MOD[b * 6144 + 64 * u + col] = s; }
            __syncthreads();
        }
    }
    if (F.bid == (F.G > 100 ? 100 : 0)) { const float l0 = F.lb_logits[F.tid], l1 = F.lb_logits[512 + F.tid]; F.LB[F.tid] = 1.f / (1.f + __expf(l1 - l0)); }
    {
        LAS float* scr = (LAS float*)(F.lds + 32768 + F.wave * 12288);
        const int gw = F.bid * NWAVES + F.wave, NGW = F.G * NWAVES;
        constexpr int I_IN = (D / 64) * (NIN / 32), I_OUT = (D / 64) * (D / 32), I_Q = (D / 64) * (NQ / 32);
        for (int it = gw; it < I_IN + I_OUT + I_Q; it += NGW) {
            int r = it;
            if (r < I_IN) { p0_transpose_item(F.w_in, D, NIN, F.WIN, scr, r, F.lane); continue; } r -= I_IN;
            if (r < I_OUT) { p0_transpose_item(F.w_out, D, D, F.WOUT, scr, r, F.lane); continue; } r -= I_OUT;
            p0_transpose_item(F.w_query, D, NQ, F.WQ, scr, r, F.lane);
        }
    }
    {
        const size_t gtid = (size_t)F.bid * NTHR + F.tid, gs = (size_t)F.G * NTHR;
        cvt_stream(F.sub_keys, F.KEYS, (size_t)16 * 128 * 128 / 8, gtid, gs);
        cvt_stream(F.peer_u, F.UE, (size_t)16384 * 1024 / 8, gtid, gs);
        cvt_stream(F.peer_v, F.VE, (size_t)16384 * 1024 / 8, gtid, gs);
    }
}

__device__ __forceinline__ void modnorm_row(const float* xrow, const float* w, const float* shift, const float* scale, bf16* orow, int lane) {
    f32x4 v[4]; float s = 0.f;
#pragma unroll
    for (int j = 0; j < 4; ++j) { v[j] = *(const f32x4*)(xrow + 4 * lane + 256 * j); s += (v[j].x * v[j].x + v[j].y * v[j].y) + (v[j].z * v[j].z + v[j].w * v[j].w); }
    const float rstd = 1.f / sqrtf(wave_sum(s) * (1.f / D) + EPS);
#pragma unroll
    for (int j = 0; j < 4; ++j) { const int col = 4 * lane + 256 * j;
        const f32x4 wv = *(const f32x4*)(w + col), sh = *(const f32x4*)(shift + col), sc = *(const f32x4*)(scale + col);
        const f32x4 y = v[j] * rstd * wv * (sc + 1.f) + sh;
        v2u o; o.x = pk2(y.x, y.y); o.y = pk2(y.z, y.w); *(v2u*)(orow + col) = o; }
}

__device__ __forceinline__ void p3_local(Ctx& F) {
    LAS unsigned char* KT = F.lds;
    LAS unsigned char* VT = F.lds + 18432;
    LAS float* QT = (LAS float*)(F.lds + 36864);
    LAS unsigned char* OUT = F.lds + 38912;
    const int tid = F.tid, lane = F.lane, wave = F.wave, fr = lane & 15, fq = lane >> 4;
    for (int u = F.bid; u < 1024; u += F.G) {
        const int bh = u >> 7, c = u & 127, b = bh >> 2, hh = bh & 3;
        const size_t r0 = (size_t)b * SEQ + (size_t)c * 64;
        const int d = tid & 127, tq = tid >> 7;
        const bf16* pf = F.PROJ + (r0 + 16 * tq) * NIN + 512 + hh * 128 + d;
        const bf16* pv = F.PROJ + (r0 + 16 * tq) * NIN + 1024 + hh * 128 + d;
        const float lbv = F.LB[hh * 128 + d], oml = 1.f - lbv;
        unsigned short fraw[16], vraw[16];
#pragma unroll
        for (int j = 0; j < 16; ++j) { fraw[j] = pf[(size_t)j * NIN]; vraw[j] = pv[(size_t)j * NIN]; }
        float cs[16], kk[16]; float run = 0.f;
#pragma unroll
        for (int j = 0; j < 16; ++j) { const float fv = bf2f(fraw[j]); const float e = __expf(-fv); const float sg = 1.f / (1.f + e);
            const float f = lbv + oml * sg; run += __logf(f); cs[j] = run; kk[j] = oml * (e * sg); }
        QT[tq * 128 + d] = run;
        __syncthreads();
        float prefix = 0.f, total = 0.f;
#pragma unroll
        for (int q = 0; q < 4; ++q) { const float t = QT[q * 128 + d]; total += t; if (q < tq) prefix += t; }
        unsigned kp[8], vp[8];
#pragma unroll
        for (int j = 0; j < 8; ++j) { const float k0 = kk[2 * j] * __expf(total - (prefix + cs[2 * j])), k1 = kk[2 * j + 1] * __expf(total - (prefix + cs[2 * j + 1]));
            kp[j] = pk2(k0, k1); vp[j] = (unsigned)vraw[2 * j] | ((unsigned)vraw[2 * j + 1] << 16); }
        *(LAS v4u*)(KT + d * 144 + tq * 32) = (v4u){kp[0], kp[1], kp[2], kp[3]}; *(LAS v4u*)(KT + d * 144 + tq * 32 + 16) = (v4u){kp[4], kp[5], kp[6], kp[7]};
        *(LAS v4u*)(VT + d * 144 + tq * 32) = (v4u){vp[0], vp[1], vp[2], vp[3]}; *(LAS v4u*)(VT + d * 144 + tq * 32 + 16) = (v4u){vp[4], vp[5], vp[6], vp[7]};
        if (tq == 0) F.ACH[u * 128 + d] = __expf(total);
        __syncthreads();
        {
            const int dblk = wave & 3, vh = wave >> 2;
            f32x4 acc[2][4];
#pragma unroll
            for (int a = 0; a < 2; ++a)
#pragma unroll
                for (int n = 0; n < 4; ++n) acc[a][n] = (f32x4){0.f, 0.f, 0.f, 0.f};
#pragma unroll
            for (int k2 = 0; k2 < 2; ++k2) {
                bf16x8 af[2], bfv[4];
#pragma unroll
                for (int a = 0; a < 2; ++a) af[a] = *(const LAS bf16x8*)(KT + (dblk * 32 + a * 16 + fr) * 144 + (k2 * 32 + fq * 8) * 2);
#pragma unroll
                for (int n = 0; n < 4; ++n) bfv[n] = *(const LAS bf16x8*)(VT + (vh * 64 + n * 16 + fr) * 144 + (k2 * 32 + fq * 8) * 2);
#pragma unroll
                for (int a = 0; a < 2; ++a)
#pragma unroll
                    for (int n = 0; n < 4; ++n) acc[a][n] = __builtin_amdgcn_mfma_f32_16x16x32_bf16(af[a], bfv[n], acc[a][n], 0, 0, 0);
            }
#pragma unroll
            for (int a = 0; a < 2; ++a)
#pragma unroll
                for (int n = 0; n < 4; ++n) { const int v = vh * 64 + n * 16 + fr, dd = dblk * 32 + a * 16 + 4 * fq;
                    *(LAS v2u*)(OUT + v * 272 + dd * 2) = (v2u){pk2(acc[a][n][0], acc[a][n][1]), pk2(acc[a][n][2], acc[a][n][3])}; }
        }
        __syncthreads();
        { const int row = tid >> 2, part = tid & 3; bf16* dst = F.ST + (size_t)u * 16384 + row * 128 + part * 32;
#pragma unroll
            for (int i = 0; i < 4; ++i) *(v4u*)(dst + i * 8) = *(const LAS v4u*)(OUT + row * 272 + part * 64 + i * 16); }
        __syncthreads();
    }
    {
        const int gw = F.bid * NWAVES + F.wave, NGW = F.G * NWAVES;
        const int ch = lane * 8;
        float w0[8], w1[8], w2[8], ow[8];
#pragma unroll
        for (int j = 0; j < 8; ++j) { w0[j] = F.conv_w[ch + j]; w1[j] = F.conv_w[512 + ch + j]; w2[j] = F.conv_w[1024 + ch + j]; ow[j] = F.conv_onorm_w[ch + j]; }
        for (int run = gw; run < M / 8; run += NGW) {
            const int rbase = run * 8;
            float u1[8], u2[8];
#pragma unroll
            for (int j = 0; j < 8; ++j) { u1[j] = 0.f; u2[j] = 0.f; }
            const int tpos = rbase & (SEQ - 1);
            if (tpos >= 1) { const bf16* p = F.PROJ + (size_t)(rbase - 1) * NIN + 2048 + ch; const v4u cc = *(const v4u*)(p + 512), xx = *(const v4u*)(p + 1024);
#pragma unroll
                for (int j = 0; j < 4; ++j) { const unsigned cw = cc[j], xw = xx[j]; u1[2 * j] = bf2f(cw & 0xffffu) * bf2f(xw & 0xffffu); u1[2 * j + 1] = bf2f(cw >> 16) * bf2f(xw >> 16); } }
            if (tpos >= 2) { const bf16* p = F.PROJ + (size_t)(rbase - 2) * NIN + 2048 + ch; const v4u cc = *(const v4u*)(p + 512), xx = *(const v4u*)(p + 1024);
#pragma unroll
                for (int j = 0; j < 4; ++j) { const unsigned cw = cc[j], xw = xx[j]; u2[2 * j] = bf2f(cw & 0xffffu) * bf2f(xw & 0xffffu); u2[2 * j + 1] = bf2f(cw >> 16) * bf2f(xw >> 16); } }
            for (int t = 0; t < 8; ++t) {
                const bf16* p = F.PROJ + (size_t)(rbase + t) * NIN + 2048 + ch;
                const v4u bb = *(const v4u*)(p), cc = *(const v4u*)(p + 512), xx = *(const v4u*)(p + 1024);
                float u0[8], y[8]; float ss = 0.f;
#pragma unroll
                for (int j = 0; j < 4; ++j) { const unsigned cw = cc[j], xw = xx[j]; u0[2 * j] = bf2f(cw & 0xffffu) * bf2f(xw & 0xffffu); u0[2 * j + 1] = bf2f(cw >> 16) * bf2f(xw >> 16); }
#pragma unroll
                for (int j = 0; j < 8; ++j) { const float bg = bf2f((j & 1) ? (bb[j >> 1] >> 16) : (bb[j >> 1] & 0xffffu));
                    y[j] = bg * (w0[j] * u2[j] + w1[j] * u1[j] + w2[j] * u0[j]); ss += y[j] * y[j]; }
                ss += __shfl_xor(ss, 1); ss += __shfl_xor(ss, 2); ss += __shfl_xor(ss, 4); ss += __shfl_xor(ss, 8);
                const float rstd = 1.f / sqrtf(ss * (1.f / 128.f) + EPS);
                v4u o; o.x = pk2(y[0] * rstd * ow[0], y[1] * rstd * ow[1]); o.y = pk2(y[2] * rstd * ow[2], y[3] * rstd * ow[3]);
                o.z = pk2(y[4] * rstd * ow[4], y[5] * rstd * ow[5]); o.w = pk2(y[6] * rstd * ow[6], y[7] * rstd * ow[7]);
                *(v4u*)(F.YCAT + (size_t)(rbase + t) * D + 512 + ch) = o;
#pragma unroll
                for (int j = 0; j < 8; ++j) { u2[j] = u1[j]; u1[j] = u0[j]; }
            }
        }
    }
}

__device__ __forceinline__ void p4_scan(Ctx& F) {
    const int gtid = F.bid * NTHR + F.tid;
    if (gtid >= 65536) return;
    const int bh = gtid >> 13, e2 = gtid & 8191, v = e2 >> 6, d = (e2 & 63) * 2;
    unsigned* p = (unsigned*)(F.ST + (size_t)bh * 128 * 16384 + v * 128 + d);
    const float* a = F.ACH + (size_t)bh * 128 * 128 + d;
    float s0 = 0.f, s1 = 0.f;
#pragma unroll 8
    for (int c = 0; c < 128; ++c) {
        const unsigned uu = p[(size_t)c * 8192]; const float a0 = a[c * 128], a1 = a[c * 128 + 1];
        p[(size_t)c * 8192] = pk2(s0, s1);
        s0 = a0 * s0 + bf2f(uu & 0xffffu); s1 = a1 * s1 + bf2f(uu >> 16);
    }
}

__device__ __forceinline__ void p5_out(Ctx& F) {
    LAS unsigned char* QM = F.lds;
    LAS unsigned char* Q0 = F.lds + 17408;
    LAS unsigned char* KM = F.lds + 34816;
    LAS unsigned char* VT = F.lds + 52224;
    LAS unsigned char* STL = F.lds + 70656;
    LAS float* QT = (LAS float*)(F.lds + 105472);
    LAS unsigned char* PB = F.lds + 107520;
    LAS float* NRM = (LAS float*)(F.lds + 125952);
    const int tid = F.tid, lane = F.lane, wave = F.wave, fr = lane & 15, fq = lane >> 4;
    for (int u = F.bid; u < 1024; u += F.G) {
        const int bh = u >> 7, c = u & 127, b = bh >> 2, hh = bh & 3;
        const size_t r0 = (size_t)b * SEQ + (size_t)c * 64;
        const int d = tid & 127, tq = tid >> 7;
        const bf16* pq = F.PROJ + (r0 + 16 * tq) * NIN + hh * 128 + d;
        const float lbv = F.LB[hh * 128 + d], oml = 1.f - lbv;
        unsigned short qraw[16], fraw[16], vraw[16];
#pragma unroll
        for (int j = 0; j < 16; ++j) { qraw[j] = pq[(size_t)j * NIN]; fraw[j] = pq[(size_t)j * NIN + 512]; vraw[j] = pq[(size_t)j * NIN + 1024]; }
        {
            const bf16* src = F.ST + (size_t)u * 16384;
#pragma unroll
            for (int i = 0; i < 4; ++i) { const int row = (tid >> 4) + 32 * i, ck = tid & 15; *(LAS v4u*)(STL + row * 272 + ck * 16) = *(const v4u*)(src + row * 128 + ck * 8); }
        }
        float cs[16], kk[16]; float run = 0.f;
#pragma unroll
        for (int j = 0; j < 16; ++j) { const float fv = bf2f(fraw[j]); const float e = __expf(-fv); const float sg = 1.f / (1.f + e);
            const float f = lbv + oml * sg; run += __logf(f); cs[j] = run; kk[j] = oml * (e * sg); }
        QT[tq * 128 + d] = run;
        __syncthreads();
        float prefix = 0.f; const float q0t = QT[d], q1t = QT[128 + d], q2t = QT[256 + d];
        if (tq >= 1) prefix += q0t; if (tq >= 2) prefix += q1t; if (tq >= 3) prefix += q2t;
        const float bmid = q0t + q1t;
        unsigned vp[8];
#pragma unroll
        for (int j = 0; j < 16; ++j) { const float bj = prefix + cs[j]; const float qv = bf2f(qraw[j]); const int t = 16 * tq + j;
            *(LAS unsigned short*)(QM + t * 272 + d * 2) = (unsigned short)f2bf(qv * __expf(bj - bmid));
            *(LAS unsigned short*)(Q0 + t * 272 + d * 2) = (unsigned short)f2bf(qv * __expf(bj));
            *(LAS unsigned short*)(KM + t * 272 + d * 2) = (unsigned short)f2bf(kk[j] * __expf(bmid - bj)); }
#pragma unroll
        for (int j = 0; j < 8; ++j) vp[j] = (unsigned)vraw[2 * j] | ((unsigned)vraw[2 * j + 1] << 16);
        *(LAS v4u*)(VT + d * 144 + tq * 32) = (v4u){vp[0], vp[1], vp[2], vp[3]}; *(LAS v4u*)(VT + d * 144 + tq * 32 + 16) = (v4u){vp[4], vp[5], vp[6], vp[7]};
        __syncthreads();
        const int rb = wave >> 1, vh = wave & 1;
        LAS unsigned char* P = PB + wave * 2304;
        {
            f32x4 sc[4];
#pragma unroll
            for (int sf = 0; sf < 4; ++sf) sc[sf] = (f32x4){0.f, 0.f, 0.f, 0.f};
#pragma unroll
            for (int k4 = 0; k4 < 4; ++k4) {
                const bf16x8 bq = *(const LAS bf16x8*)(QM + (16 * rb + fr) * 272 + (k4 * 32 + fq * 8) * 2);
#pragma unroll
                for (int sf = 0; sf < 4; ++sf) { const bf16x8 ak = *(const LAS bf16x8*)(KM + (16 * sf + fr) * 272 + (k4 * 32 + fq * 8) * 2);
                    sc[sf] = __builtin_amdgcn_mfma_f32_16x16x32_bf16(ak, bq, sc[sf], 0, 0, 0); }
            }
            const int t = 16 * rb + fr;
#pragma unroll
            for (int sf = 0; sf < 4; ++sf) { const int s0 = 16 * sf + 4 * fq;
                const float p0 = (s0 + 0 <= t) ? sc[sf][0] : 0.f, p1 = (s0 + 1 <= t) ? sc[sf][1] : 0.f, p2 = (s0 + 2 <= t) ? sc[sf][2] : 0.f, p3 = (s0 + 3 <= t) ? sc[sf][3] : 0.f;
                *(LAS v2u*)(P + fr * 144 + s0 * 2) = (v2u){pk2(p0, p1), pk2(p2, p3)}; }
        }
        __syncthreads();
        f32x4 oc[4];
#pragma unroll
        for (int n = 0; n < 4; ++n) oc[n] = (f32x4){0.f, 0.f, 0.f, 0.f};
#pragma unroll
        for (int k2 = 0; k2 < 2; ++k2) {
            const bf16x8 bp = *(const LAS bf16x8*)(P + fr * 144 + (k2 * 32 + fq * 8) * 2);
#pragma unroll
            for (int n = 0; n < 4; ++n) { const bf16x8 av = *(const LAS bf16x8*)(VT + (64 * vh + 16 * n + fr) * 144 + (k2 * 32 + fq * 8) * 2);
                oc[n] = __builtin_amdgcn_mfma_f32_16x16x32_bf16(av, bp, oc[n], 0, 0, 0); }
        }
#pragma unroll
        for (int k4 = 0; k4 < 4; ++k4) {
            const bf16x8 bq = *(const LAS bf16x8*)(Q0 + (16 * rb + fr) * 272 + (k4 * 32 + fq * 8) * 2);
#pragma unroll
            for (int n = 0; n < 4; ++n) { const bf16x8 as = *(const LAS bf16x8*)(STL + (64 * vh + 16 * n + fr) * 272 + (k4 * 32 + fq * 8) * 2);
                oc[n] = __builtin_amdgcn_mfma_f32_16x16x32_bf16(as, bq, oc[n], 0, 0, 0); }
        }
        float ss = 0.f;
#pragma unroll
        for (int n = 0; n < 4; ++n) ss += (oc[n][0] * oc[n][0] + oc[n][1] * oc[n][1]) + (oc[n][2] * oc[n][2] + oc[n][3] * oc[n][3]);
        ss += __shfl_xor(ss, 16); ss += __shfl_xor(ss, 32);
        if (fq == 0) NRM[(16 * rb + fr) * 2 + vh] = ss;
        __syncthreads();
        {
            const int t = 16 * rb + fr; const float tot = NRM[t * 2] + NRM[t * 2 + 1];
            const float rstd = 1.f / sqrtf(tot * (1.f / 128.f) + EPS);
            const bf16* pg = F.PROJ + (r0 + t) * NIN + 1536 + hh * 128;
            bf16* po = F.YCAT + (r0 + t) * D + hh * 128;
#pragma unroll
            for (int n = 0; n < 4; ++n) { const int v = 64 * vh + 16 * n + 4 * fq;
                const v2u gw = *(const v2u*)(pg + v); const f32x4 wv = *(const f32x4*)(F.hgrn_onorm_w + hh * 128 + v);
                float g[4] = {bf2f(gw.x & 0xffffu), bf2f(gw.x >> 16), bf2f(gw.y & 0xffffu), bf2f(gw.y >> 16)}; float o[4];
#pragma unroll
                for (int j = 0; j < 4; ++j) { const float sl = g[j] / (1.f + __expf(-g[j])); o[j] = oc[n][j] * rstd * wv[j] * sl; }
                *(v2u*)(po + v) = (v2u){pk2(o[0], o[1]), pk2(o[2], o[3])}; }
        }
        __syncthreads();
    }
}

__device__ __forceinline__ unsigned f2ord(float f) { const unsigned u = __float_as_uint(f); return (u & 0x80000000u) ? ~u : (u | 0x80000000u); }
__device__ __forceinline__ float ord2f(unsigned o) { return __uint_as_float((o & 0x80000000u) ? (o & 0x7fffffffu) : ~o); }
__device__ __forceinline__ void ce_desc(unsigned& a, unsigned& b) { const unsigned mx = a > b ? a : b, mn = a > b ? b : a; a = mx; b = mn; }
template <int N> __device__ __forceinline__ void bitonic_sort_desc(unsigned (&k)[N]) {
#pragma unroll
    for (int size = 2; size <= N; size <<= 1) {
#pragma unroll
        for (int stride = size >> 1; stride > 0; stride >>= 1) {
#pragma unroll
            for (int i = 0; i < N; ++i) { const int j = i ^ stride; if (j > i) { if ((i & size) == 0) ce_desc(k[i], k[j]); else ce_desc(k[j], k[i]); } }
        }
    }
}
__device__ __forceinline__ void bitonic_merge16_desc(unsigned (&k)[16]) {
#pragma unroll
    for (int stride = 8; stride > 0; stride >>= 1) {
#pragma unroll
        for (int i = 0; i < 16; ++i) { const int j = i ^ stride; if (j > i) ce_desc(k[i], k[j]); }
    }
}
__device__ __forceinline__ void merge_top16(unsigned (&a)[16], const unsigned (&b)[16]) {
#pragma unroll
    for (int i = 0; i < 16; ++i) a[i] = a[i] > b[15 - i] ? a[i] : b[15 - i];
    bitonic_merge16_desc(a);
}
__device__ __forceinline__ float gelu_erf(float x) { return 0.5f * x * (1.f + erff(x * 0.70710678118654752f)); }

__device__ __forceinline__ void p9_peer(Ctx& F) {
    LAS unsigned* TOP = (LAS unsigned*)F.lds;
    LAS v2u* IDXG = (LAS v2u*)(F.lds + 65536);
    const int tid = F.tid, lane = F.lane, wave = F.wave, fr = lane & 15, fq = lane >> 4;
    for (int tile = F.bid; tile < M / 64; tile += F.G) {
        const size_t r0 = (size_t)tile * 64;
        {
            const int p = wave >> 2, tb = wave & 3;
            for (int h = 0; h < 8; ++h) {
                f32x4 sc[8];
#pragma unroll
                for (int nf = 0; nf < 8; ++nf) sc[nf] = (f32x4){0.f, 0.f, 0.f, 0.f};
                const bf16* qrow = F.QP + (r0 + 16 * tb + fr) * NQ + h * 256 + p * 128 + fq * 8;
                const bf16* krow = F.KEYS + (size_t)((h * 2 + p) * 128 + fr) * 128 + fq * 8;
#pragma unroll
                for (int k4 = 0; k4 < 4; ++k4) {
                    const bf16x8 bq = *(const bf16x8*)(qrow + k4 * 32);
#pragma unroll
                    for (int nf = 0; nf < 8; ++nf) { const bf16x8 ak = *(const bf16x8*)(krow + (size_t)nf * 16 * 128 + k4 * 32);
                        sc[nf] = __builtin_amdgcn_mfma_f32_16x16x32_bf16(ak, bq, sc[nf], 0, 0, 0); }
                }
                unsigned ka[16], kb[16];
#pragma unroll
                for (int nf = 0; nf < 4; ++nf)
#pragma unroll
                    for (int r = 0; r < 4; ++r) {
                        ka[nf * 4 + r] = (f2ord(sc[nf][r]) & ~127u) | (unsigned)(127 - (16 * nf + 4 * fq + r));
                        kb[nf * 4 + r] = (f2ord(sc[nf + 4][r]) & ~127u) | (unsigned)(127 - (16 * (nf + 4) + 4 * fq + r)); }
                bitonic_sort_desc<16>(ka); bitonic_sort_desc<16>(kb);
                merge_top16(ka, kb);
                {
                    unsigned o[16];
#pragma unroll
                    for (int i = 0; i < 16; ++i) o[i] = (unsigned)__shfl_xor((int)ka[i], 16);
                    merge_top16(ka, o);
#pragma unroll
                    for (int i = 0; i < 16; ++i) o[i] = (unsigned)__shfl_xor((int)ka[i], 32);
                    merge_top16(ka, o);
                }
                if (fq == 0) { LAS v4u* dst = (LAS v4u*)(TOP + (((16 * tb + fr) * 8 + h) * 2 + p) * 16);
                    dst[0] = (v4u){ka[0], ka[1], ka[2], ka[3]}; dst[1] = (v4u){ka[4], ka[5], ka[6], ka[7]}; dst[2] = (v4u){ka[8], ka[9], ka[10], ka[11]}; dst[3] = (v4u){ka[12], ka[13], ka[14], ka[15]}; }
            }
        }
        __syncthreads();
        {
            const int t = tid >> 3, h = tid & 7;
            const LAS unsigned* pa = TOP + ((t * 8 + h) * 2) * 16; const LAS unsigned* pb = pa + 16;
            float av[16], bv[16];
            { const LAS v4u* qa = (const LAS v4u*)pa; const LAS v4u* qb = (const LAS v4u*)pb;
#pragma unroll
              for (int i = 0; i < 4; ++i) { const v4u x = qa[i], y = qb[i];
#pragma unroll
                  for (int j = 0; j < 4; ++j) { av[4 * i + j] = ord2f(x[j] & ~127u); bv[4 * i + j] = ord2f(y[j] & ~127u); } } }
            unsigned c0[16], c1[16], c2[16], c3[16];
#pragma unroll
            for (int i = 0; i < 16; ++i) { c0[i] = 0u; c1[i] = 0u; c2[i] = 0u; c3[i] = 0u; }
            {
                int n = 0;
#pragma unroll
                for (int i = 0; i < 16; ++i)
#pragma unroll
                    for (int j = 0; j < 16; ++j) if ((i + 1) * (j + 1) <= 16) {
                        const unsigned key = (f2ord(av[i] + bv[j]) & ~255u) | (unsigned)(255 - (i * 16 + j));
                        if (n < 16) c0[n] = key; else if (n < 32) c1[n - 16] = key; else if (n < 48) c2[n - 32] = key; else c3[n - 48] = key;
                        ++n; }
            }
            bitonic_sort_desc<16>(c0); bitonic_sort_desc<16>(c1); bitonic_sort_desc<16>(c2); bitonic_sort_desc<16>(c3);
            merge_top16(c0, c1); merge_top16(c2, c3); merge_top16(c0, c2);
            float sv[16]; unsigned ix[16]; float mx = -3.0e38f;
#pragma unroll
            for (int k = 0; k < 16; ++k) { const unsigned pos = 255u - (c0[k] & 255u); const unsigned ua = pa[pos >> 4], ub = pb[pos & 15];
                sv[k] = ord2f(ua & ~127u) + ord2f(ub & ~127u); ix[k] = (127u - (ua & 127u)) * 128u + (127u - (ub & 127u)); mx = fmaxf(mx, sv[k]); }
            float sum = 0.f;
#pragma unroll
            for (int k = 0; k < 16; ++k) { sv[k] = __expf(sv[k] - mx); sum += sv[k]; }
            const float inv = 1.f / sum;
#pragma unroll
            for (int k = 0; k < 16; ++k) IDXG[t * 128 + h * 16 + k] = (v2u){ix[k], __float_as_uint(sv[k] * inv)};
        }
        __syncthreads();
        {
            const int c16 = lane & 15, rp = lane >> 4;
            for (int round = 0; round < 8; ++round) {
                const int tl = round * 8 + wave; const size_t row = r0 + tl; const int b = (int)(row >> 13);
                v4u hq[8];
#pragma unroll
                for (int S = 0; S < 8; ++S) hq[S] = *(const v4u*)(F.H2 + row * D + S * 128 + c16 * 8);
                float acc[64];
#pragma unroll
                for (int i = 0; i < 64; ++i) acc[i] = 0.f;
#pragma unroll 1
                for (int eg = 0; eg < 32; ++eg) {
                    const v2u ig = IDXG[tl * 128 + eg * 4 + rp];
                    const bf16* up = F.UE + (size_t)ig.x * D + c16 * 8; const bf16* vp = F.VE + (size_t)ig.x * D + c16 * 8;
                    v4u uu[8], vv[8];
#pragma unroll
                    for (int S = 0; S < 8; ++S) uu[S] = *(const v4u*)(up + S * 128);
#pragma unroll
                    for (int S = 0; S < 8; ++S) vv[S] = *(const v4u*)(vp + S * 128);
                    float d0 = 0.f, d1 = 0.f, d2 = 0.f, d3 = 0.f;
#pragma unroll
                    for (int S = 0; S < 8; ++S) { d0 = dot2(uu[S].x, hq[S].x, d0); d1 = dot2(uu[S].y, hq[S].y, d1); d2 = dot2(uu[S].z, hq[S].z, d2); d3 = dot2(uu[S].w, hq[S].w, d3); }
                    float dt = (d0 + d1) + (d2 + d3);
                    dt += __shfl_xor(dt, 1); dt += __shfl_xor(dt, 2); dt += __shfl_xor(dt, 4); dt += __shfl_xor(dt, 8);
                    const float coef = __uint_as_float(ig.y) * gelu_erf(dt);
#pragma unroll
                    for (int S = 0; S < 8; ++S)
#pragma unroll
                        for (int j = 0; j < 4; ++j) { const unsigned w = vv[S][j]; acc[S * 8 + 2 * j] += coef * bf2f(w & 0xffffu); acc[S * 8 + 2 * j + 1] += coef * __uint_as_float(w & 0xffff0000u); }
                }
                float t32[32];
#pragma unroll
                for (int i = 0; i < 32; ++i) { auto r = __builtin_amdgcn_permlane32_swap(__float_as_uint(acc[i]), __float_as_uint(acc[i + 32]), false, false);
                    t32[i] = __uint_as_float(r[0]) + __uint_as_float(r[1]); }
                const bool hi16 = (rp & 1) != 0;
                float fin[16];
#pragma unroll
                for (int i = 0; i < 16; ++i) { const float keep = hi16 ? t32[i + 16] : t32[i], send = hi16 ? t32[i] : t32[i + 16];
                    fin[i] = keep + __shfl_xor(send, 16); }
                float x2[16]; float ss = 0.f;
#pragma unroll
                for (int sp = 0; sp < 2; ++sp) { const int d0i = (2 * rp + sp) * 128 + c16 * 8;
                    const f32x4 xa = *(const f32x4*)(F.out + row * D + d0i), xb = *(const f32x4*)(F.out + row * D + d0i + 4);
                    const f32x4 ga = *(const f32x4*)(F.MOD + b * 6144 + 5120 + d0i), gb = *(const f32x4*)(F.MOD + b * 6144 + 5120 + d0i + 4);
#pragma unroll
                    for (int j = 0; j < 4; ++j) { x2[sp * 8 + j] = xa[j] + ga[j] * fin[sp * 8 + j]; x2[sp * 8 + 4 + j] = xb[j] + gb[j] * fin[sp * 8 + 4 + j]; } }
#pragma unroll
                for (int i = 0; i < 16; ++i) ss += x2[i] * x2[i];
                const float rstd = 1.f / sqrtf(wave_sum(ss) * (1.f / D) + EPS);
#pragma unroll
                for (int sp = 0; sp < 2; ++sp) { const int d0i = (2 * rp + sp) * 128 + c16 * 8;
                    const f32x4 wa = *(const f32x4*)(F.final_w + d0i), wb = *(const f32x4*)(F.final_w + d0i + 4);
                    f32x4 oa, ob;
#pragma unroll
                    for (int j = 0; j < 4; ++j) { oa[j] = x2[sp * 8 + j] * rstd * wa[j]; ob[j] = x2[sp * 8 + 4 + j] * rstd * wb[j]; }
                    *(f32x4*)(F.out + row * D + d0i) = oa; *(f32x4*)(F.out + row * D + d0i + 4) = ob; }
            }
        }
        __syncthreads();
    }
}

#define XB_TMO      128
#define XB_XCNT(j)  (256  + 64 * (j))
#define XB_XSUB(j)  (1280 + 64 * (j))
#define XB_XGEN(j)  (2304 + 64 * (j))
#define XB_TOP      3328
#define XB_TOPGEN   3392
#define XCD_BAR_WORDS 3456
#define XB_SPIN_CAP (1u << 20)
__device__ __forceinline__ unsigned xb_ld(unsigned* p)              { return __hip_atomic_load(p, __ATOMIC_RELAXED, __HIP_MEMORY_SCOPE_AGENT); }
__device__ __forceinline__ unsigned xb_add(unsigned* p, unsigned v) { return __hip_atomic_fetch_add(p, v, __ATOMIC_RELAXED, __HIP_MEMORY_SCOPE_AGENT); }
__device__ __forceinline__ unsigned xb_xcc_id() { return (unsigned)__builtin_amdgcn_s_getreg((3 << 11) | 20) & 0xFu; }
#define XB_SPIN(cond, bar) do { unsigned _sp = 0; while (cond) { __builtin_amdgcn_s_sleep(1); \
    if ((++_sp & 255u) == 0u) { if (xb_ld(&(bar)[XB_TMO])) break; if (_sp > XB_SPIN_CAP) { atomicAdd(&(bar)[XB_TMO], 1u); break; } } } } while (0)
struct XcdBarrier { unsigned* bar; unsigned x; volatile LAS unsigned* st; };
__device__ __forceinline__ XcdBarrier xcd_barrier_post(unsigned* bar, volatile LAS unsigned* st) {
    XcdBarrier b; b.bar = bar; b.x = xb_xcc_id(); b.st = st;
    if (threadIdx.x == 0) (void)xb_add(&bar[XB_XCNT(b.x)], 1u);
    return b;
}
__device__ __forceinline__ void xcd_barrier_complete(unsigned* bar, unsigned x, unsigned& nloc, unsigned& nx) {
    const unsigned G = gridDim.x * gridDim.y * gridDim.z;
    unsigned sum, cnt, mine, sp = 0u;
    for (;;) {
        sum = 0u; cnt = 0u; mine = 0u;
#pragma unroll
        for (unsigned j = 0; j < 16; ++j) { const unsigned c = xb_ld(&bar[XB_XCNT(j)]); sum += c; cnt += (c > 0u) ? 1u : 0u; mine = (j == x) ? c : mine; }
        if (sum == G) break;
        __builtin_amdgcn_s_sleep(1);
        if ((++sp & 255u) == 0u) { if (xb_ld(&bar[XB_TMO])) break; if (sp > XB_SPIN_CAP) { atomicAdd(&bar[XB_TMO], 1u); break; } }
    }
    nloc = mine > 0u ? mine : 1u; nx = cnt > 0u ? cnt : 1u;
}
__device__ __forceinline__ void xcd_barrier(const XcdBarrier& b) {
    asm volatile("s_waitcnt vmcnt(0)" ::: "memory");
    __syncthreads();
    if (threadIdx.x == 0) {
        unsigned* bar = b.bar;
        __builtin_amdgcn_s_waitcnt(0);
        unsigned nloc = b.st[0], nx = b.st[1];
        if (nloc == 0u) { xcd_barrier_complete(bar, b.x, nloc, nx); b.st[0] = nloc; b.st[1] = nx; }
        const unsigned old = xb_add(&bar[XB_XSUB(b.x)], 1u);
        const unsigned gen = old / nloc;
        if (old + 1u == (gen + 1u) * nloc) {
            __builtin_amdgcn_fence(__ATOMIC_RELEASE, "agent");
            asm volatile("s_waitcnt vmcnt(0)" ::: "memory");
            const unsigned og = xb_add(&bar[XB_TOP], 1u);
            const unsigned tg = og / nx;
            if (og + 1u == (tg + 1u) * nx) xb_add(&bar[XB_TOPGEN], 1u);
            else XB_SPIN(xb_ld(&bar[XB_TOPGEN]) == tg, bar);
            __builtin_amdgcn_fence(__ATOMIC_ACQUIRE, "agent");
            xb_add(&bar[XB_XGEN(b.x)], 1u);
            asm volatile("s_waitcnt vmcnt(0)" ::: "memory");
        } else {
            XB_SPIN(xb_ld(&bar[XB_XGEN(b.x)]) == gen, bar);
            __builtin_amdgcn_fence(__ATOMIC_ACQUIRE, "agent");
            asm volatile("s_waitcnt vmcnt(0)" ::: "memory");
        }
    }
    __syncthreads();
}

__global__ void __launch_bounds__(NTHR, 2) mk_fwd(Args args) {
    extern __shared__ __attribute__((aligned(16))) unsigned char lds_raw[];
    Ctx F;
    F.lds = (LAS unsigned char*)lds_raw;
    F.tid = threadIdx.x; F.lane = F.tid & 63; F.wave = __builtin_amdgcn_readfirstlane(F.tid >> 6); F.G = gridDim.x; F.bid = blockIdx.x;
    F.x = args.in[0]; F.c = args.in[1]; F.w_ada = args.in[2]; F.b_ada = args.in[3]; F.norm1_w = args.in[4]; F.w_in = args.in[5]; F.lb_logits = args.in[6];
    F.hgrn_onorm_w = args.in[7]; F.conv_w = args.in[8]; F.conv_onorm_w = args.in[9]; F.w_out = args.in[10]; F.norm2_w = args.in[11]; F.w_query = args.in[12];
    F.sub_keys = args.in[13]; F.peer_u = args.in[14]; F.peer_v = args.in[15]; F.final_w = args.in[16];
    F.out = args.out;
    unsigned char* ws = args.ws;
    F.ACH = (float*)(ws + WS_ACH); F.MOD = (float*)(ws + WS_MOD); F.LB = (float*)(ws + WS_LB);
    F.WIN = (bf16*)(ws + WS_WIN); F.WOUT = (bf16*)(ws + WS_WOUT); F.WQ = (bf16*)(ws + WS_WQ); F.KEYS = (bf16*)(ws + WS_KEYS);
    F.UE = (bf16*)(ws + WS_UE); F.VE = (bf16*)(ws + WS_VE); F.H1 = (bf16*)(ws + WS_H1); F.YCAT = (bf16*)(ws + WS_H1);
    F.PROJ = (bf16*)(ws + WS_PROJ); F.H2 = (bf16*)(ws + WS_PROJ); F.QP = (bf16*)(ws + WS_PROJ + 32 * MiB); F.ST = (bf16*)(ws + WS_ST);
    const int lo = args.ph_lo, hi = args.ph_hi;
    volatile LAS unsigned* MISC = (volatile LAS unsigned*)(F.lds + MISC_OFF);
    if (F.tid < 16) MISC[F.tid] = 0u;
    __syncthreads();
    XcdBarrier bar = xcd_barrier_post((unsigned*)(ws + WS_CTL), MISC);
#define IN(k) (lo <= (k) && (k) < hi)
#define SEAM(k) do { if (IN(k) && IN((k) + 1)) { xcd_barrier(bar); } } while (0)
    if (IN(0)) { p0_prep(F); } SEAM(0);
    if (IN(1)) { const int gw = F.bid * NWAVES + F.wave, NGW = F.G * NWAVES;
        for (int m = gw; m < M; m += NGW) { const float* md = F.MOD + (m >> 13) * 6144; modnorm_row(F.x + (size_t)m * D, F.norm1_w, md, md + 1024, F.H1 + (size_t)m * D, F.lane); } } SEAM(1);
    if (IN(2)) { pg8::Gemm g{F.H1, F.WIN, M, NIN, D}; pg8::StaticOrder S; S.init(M, NIN, F.G, F.bid); pg8::EpiBf16 E{F.PROJ, NIN}; pg8::gemm_phase<pg8::EpiBf16>(F.lds, g, S, E); } SEAM(2);
    if (IN(3)) { p3_local(F); } SEAM(3);
    if (IN(4)) { p4_scan(F); } SEAM(4);
    if (IN(5)) { p5_out(F); } SEAM(5);
    if (IN(6)) { pg8::Gemm g{F.YCAT, F.WOUT, M, D, D}; pg8::StaticOrder S; S.init(M, D, F.G, F.bid); pg8::EpiRes E{F.x, F.out, F.MOD}; pg8::gemm_phase<pg8::EpiRes>(F.lds, g, S, E); } SEAM(6);
    if (IN(7)) { const int gw = F.bid * NWAVES + F.wave, NGW = F.G * NWAVES;
        for (int m = gw; m < M; m += NGW) { const float* md = F.MOD + (m >> 13) * 6144; modnorm_row(F.out + (size_t)m * D, F.norm2_w, md + 3072, md + 4096, F.H2 + (size_t)m * D, F.lane); } } SEAM(7);
    if (IN(8)) { pg8::Gemm g{F.H2, F.WQ, M, NQ, D}; pg8::StaticOrder S; S.init(M, NQ, F.G, F.bid); pg8::EpiBf16 E{F.QP, NQ}; pg8::gemm_phase<pg8::EpiBf16>(F.lds, g, S, E); } SEAM(8);
#ifndef DBG_STOP
    if (IN(9)) { p9_peer(F); }
#else
    xcd_barrier(bar);
    {
        const size_t gt = (size_t)F.bid * NTHR + F.tid, gs = (size_t)F.G * NTHR;
        for (size_t i = gt; i < (size_t)M * D; i += gs) { const size_t r = i >> 10, c = i & 1023; float v = 0.f;
            if (DBG_STOP == 2) { const bf16* p = F.PROJ + r * NIN + c; v = bf2f(p[0]) + bf2f(p[1024]) + bf2f(p[2048]) + (c < 512 ? bf2f(p[3072]) : 0.f); }
            else if (DBG_STOP == 5) { v = bf2f(F.YCAT[r * D + c]); }
            else if (DBG_STOP == 6) { v = F.out[i]; }
            else if (DBG_STOP == 8) { v = bf2f(F.QP[r * NQ + c]) + bf2f(F.QP[r * NQ + c + 1024]); }
            else if (DBG_STOP == 4 || DBG_STOP == 3) { v = bf2f(F.ST[i]); }
            else if (DBG_STOP == 1) { v = bf2f(F.H1[i]); }
            F.out[i] = v; }
    }
#endif
#undef IN
#undef SEAM
}

extern "C" void kernel_launch(void* const* d_in, const int* in_sizes, int n_in, void* d_out, int out_size, void* d_ws, size_t ws_size, hipStream_t stream) {
    static int grid = 0;
    if (grid == 0) {
        if (n_in != 17 || out_size != M * D || ws_size < WS_END) { fprintf(stderr, "kernel_launch: unexpected shapes (n_in %d out %d ws %zu)\n", n_in, out_size, ws_size); grid = -1; return; }
        int dev = 0, cus = 0, per_cu = 0;
        (void)hipGetDevice(&dev); (void)hipDeviceGetAttribute(&cus, hipDeviceAttributeMultiprocessorCount, dev);
        if (hipFuncSetAttribute((const void*)mk_fwd, hipFuncAttributeMaxDynamicSharedMemorySize, LDS_BYTES) != hipSuccess) { fprintf(stderr, "kernel_launch: hipFuncSetAttribute failed\n"); grid = -1; return; }
        if (hipOccupancyMaxActiveBlocksPerMultiprocessor(&per_cu, (const void*)mk_fwd, NTHR, LDS_BYTES) != hipSuccess || per_cu < 1) { fprintf(stderr, "kernel_launch: occupancy query gives %d\n", per_cu); per_cu = 1; }
        (void)hipGetLastError();
        grid = cus;
    }
    if (grid < 0) return;
    if (hipMemsetAsync((char*)d_ws + WS_CTL, 0, CTL_ZERO_BYTES, stream) != hipSuccess) { fprintf(stderr, "kernel_launch: memset failed\n"); return; }
    Args a{};
    for (int i = 0; i < 17; ++i) a.in[i] = (const float*)d_in[i];
    a.out = (float*)d_out; a.ws = (unsigned char*)d_ws;
#if MK_LAUNCHES == 1
#ifdef DBG_STOP
    a.ph_lo = 0; a.ph_hi = DBG_STOP + 1;
#else
    a.ph_lo = 0; a.ph_hi = 10;
#endif
    void* kargs[] = {&a};
    hipError_t e = hipLaunchCooperativeKernel((const void*)mk_fwd, dim3(grid), dim3(NTHR), kargs, LDS_BYTES, stream);
    if (e != hipSuccess) fprintf(stderr, "kernel_launch: cooperative launch failed: %s (grid %d)\n", hipGetErrorString(e), grid);
#else
    for (int ph = 0; ph < 10; ++ph) { a.ph_lo = ph; a.ph_hi = ph + 1; hipLaunchKernelGGL(mk_fwd, dim3(grid), dim3(NTHR), LDS_BYTES, stream, a); }
#endif
}
```

```cpp
#include <hip/hip_runtime.h>
#include <hip/hip_cooperative_groups.h>
#include <cstdio>
#include <cstdint>
namespace cg = cooperative_groups;

#ifndef MK_LAUNCHES
#define MK_LAUNCHES 1
#endif

#define LAS __attribute__((address_space(3)))
typedef unsigned short bf16;
typedef unsigned v4u __attribute__((ext_vector_type(4)));
typedef unsigned v2u __attribute__((ext_vector_type(2)));
typedef float f32x4 __attribute__((ext_vector_type(4)));
typedef short bf16x8 __attribute__((ext_vector_type(8)));
typedef __bf16 bf16x2 __attribute__((ext_vector_type(2)));

constexpr int D = 1024, SEQ = 8192, M = 16384;
constexpr int NIN = 3584, NQ = 2048;
constexpr float EPS = 1e-6f;
constexpr int NWAVES = 8, NTHR = 512;

constexpr size_t MiB = 1u << 20;
constexpr size_t WS_ACH = 1 * MiB;
constexpr size_t WS_MOD = 1 * MiB + 512 * 1024;
constexpr size_t WS_LB = WS_MOD + 64 * 1024;
constexpr size_t WS_WIN = 2 * MiB;
constexpr size_t WS_WOUT = 9 * MiB;
constexpr size_t WS_WQ = 11 * MiB;
constexpr size_t WS_KEYS = 15 * MiB;
constexpr size_t WS_U8 = 16 * MiB, WS_V8 = 32 * MiB;
constexpr size_t WS_SU = WS_MOD + 128 * 1024, WS_SV = WS_MOD + 192 * 1024;
constexpr size_t WS_H1 = 80 * MiB;
constexpr size_t WS_PROJ = 112 * MiB;
constexpr size_t WS_ST = 224 * MiB;
constexpr size_t WS_END = 256 * MiB;
constexpr int LDS_BYTES = 147456, MISC_OFF = 147456 - 256;
constexpr size_t WS_CTL = 0, CTL_ZERO_BYTES = 65536;

__device__ __forceinline__ float bf2f(unsigned h) { return __uint_as_float(h << 16); }
__device__ __forceinline__ unsigned f2bf(float f) { unsigned u = __float_as_uint(f); return (u + 0x7fffu + ((u >> 16) & 1u)) >> 16; }
typedef float f32x2 __attribute__((ext_vector_type(2)));
__device__ __forceinline__ unsigned pk2(float lo, float hi) { const f32x2 v = {lo, hi}; return __builtin_bit_cast(unsigned, __builtin_convertvector(v, bf16x2)); }
__device__ __forceinline__ float dot2(unsigned w, unsigned x, float acc) { return __builtin_amdgcn_fdot2_f32_bf16(__builtin_bit_cast(bf16x2, w), __builtin_bit_cast(bf16x2, x), acc, false); }
__device__ __forceinline__ float wave_sum(float v) {
#pragma unroll
    for (int o = 1; o < 64; o <<= 1) v += __shfl_xor(v, o);
    return v;
}

namespace pg8 {
constexpr int BM = 256, BK = 64, HALF = 128, HTB = HALF * BK * 2, STAGE_BYTES = 8 * HTB, NXCD = 8, WGM = 8;
__host__ __device__ __forceinline__ int lds_byte(int r, int c) { const int st = (r >> 4) * 2 + (c >> 5), rr = r & 15, cc = c & 31, ob = rr * 64 + cc * 2; return st * 1024 + (ob ^ (((ob >> 9) & 1) << 5)); }
__host__ __device__ __forceinline__ void stage_rc(int b, int& R, int& C) { const int st = b / 1024, sb = b % 1024, swz = sb ^ (((sb >> 9) & 1) << 5); R = (st >> 1) * 16 + swz / 64; C = (st & 1) * 32 + (swz % 64) / 2; }
__host__ __device__ __forceinline__ int perm32(int rho) { const int n = rho >> 4, i = rho & 15; return 8 * (i >> 2) + 4 * n + (i & 3); }
struct Unit { int pm, pn; };
struct Gemm { const bf16* A; const bf16* Bt; int M, N, K; };
struct StaticOrder {
    int nM, nN, nwg, G, c;
    __host__ __device__ void init(int M_, int N_, int G_, int c_) { nM = M_ / BM; nN = N_ / BM; nwg = nM * nN; G = G_; c = c_; }
    __host__ __device__ bool next(int i, Unit& u) const {
        const long L = (long)i * G + c; if (L >= nwg) return false;
        int wgid = (int)L; { const int q = nwg / NXCD, r = nwg % NXCD, xcd = wgid % NXCD, off = wgid / NXCD; wgid = (xcd < r ? xcd * (q + 1) : r * (q + 1) + (xcd - r) * q) + off; }
        const int nig = WGM * nN, gid = wgid / nig, fm = gid * WGM, gsz = (nM - fm) < WGM ? (nM - fm) : WGM;
        u.pm = fm + ((wgid % nig) % gsz); u.pn = (wgid % nig) / gsz; return true;
    }
};
struct EpiBf16 {
    static constexpr bool PERM = true;
    bf16* O; int ldc;
    __device__ __forceinline__ void operator()(const f32x4 (&acc)[2][2][4][2], const Unit& u, int wr, int wc, int fr, int fq) const {
        const int row0 = u.pm * BM + wr * 64 + fr; const int col0 = u.pn * BM + wc * 32 + 8 * fq;
#pragma unroll
        for (int ai = 0; ai < 2; ++ai)
#pragma unroll
            for (int m = 0; m < 4; ++m) { bf16* rowp = O + (size_t)(row0 + ai * HALF + m * 16) * ldc + col0;
#pragma unroll
                for (int bj = 0; bj < 2; ++bj) { const f32x4 v0 = acc[ai][bj][m][0], v1 = acc[ai][bj][m][1];
                    v4u w; w.x = pk2(v0[0], v0[1]); w.y = pk2(v0[2], v0[3]); w.z = pk2(v1[0], v1[1]); w.w = pk2(v1[2], v1[3]);
                    *(v4u*)(rowp + bj * HALF) = w; } }
    }
};
struct EpiRes {
    static constexpr bool PERM = false;
    const float* x; float* out; const float* mod;
    __device__ __forceinline__ void operator()(const f32x4 (&acc)[2][2][4][2], const Unit& u, int wr, int wc, int fr, int fq) const {
        const int row0 = u.pm * BM + wr * 64 + fr, col0 = u.pn * BM + wc * 32 + 4 * fq; const int b = u.pm >> 5;
        f32x4 gv[2][2];
#pragma unroll
        for (int bj = 0; bj < 2; ++bj)
#pragma unroll
            for (int n = 0; n < 2; ++n) gv[bj][n] = *(const f32x4*)(mod + b * 6144 + 2048 + col0 + bj * HALF + n * 16);
#pragma unroll
        for (int ai = 0; ai < 2; ++ai)
#pragma unroll
            for (int m = 0; m < 4; ++m) { const size_t off = (size_t)(row0 + ai * HALF + m * 16) * D + col0;
#pragma unroll
                for (int bj = 0; bj < 2; ++bj)
#pragma unroll
                    for (int n = 0; n < 2; ++n) { const f32x4 xv = *(const f32x4*)(x + off + bj * HALF + n * 16);
                        *(f32x4*)(out + off + bj * HALF + n * 16) = xv + gv[bj][n] * acc[ai][bj][m][n]; } }
    }
};

template <class Epi, bool ALIGN_EPI = true>
__device__ __forceinline__ void gemm_phase(LAS unsigned char* lds, const Gemm g, const StaticOrder& S, const Epi& E) {
    const int tid = threadIdx.x, wid = __builtin_amdgcn_readfirstlane(tid >> 6), lane = tid & 63, wr = wid >> 2, wc = wid & 3, fr = lane & 15, fq = lane >> 4;
    const int K = g.K, nt = K / BK;
    unsigned voffA[2], voffB[2];
#pragma unroll
    for (int i = 0; i < 2; ++i) { int R, C; stage_rc(tid * 16 + i * 8192, R, C); const int Rb = Epi::PERM ? ((R & ~31) + perm32(R & 31)) : R;
        voffA[i] = (unsigned)(R * K + C) * 2u; voffB[i] = (unsigned)(Rb * K + C) * 2u; }
    const size_t kstep = (size_t)(BK * 2);
    const size_t hstep = (size_t)HALF * K * 2;
    const size_t tstep = 2 * hstep;
    const unsigned ldsw = (unsigned)wid * 1024u;
    const int aoff = lds_byte(wr * 64 + fr, fq * 8), boff = lds_byte(wc * 32 + fr, fq * 8);
#define PG8_SA(b, h) (((b) * 2 + (h)) * HTB)
#define PG8_SB(b, h) ((4 + (b) * 2 + (h)) * HTB)
#define PG8_STAGE(bufoff, gbase, voff) do { _Pragma("unroll") for (int _i = 0; _i < 2; ++_i) \
        __builtin_amdgcn_global_load_lds((const unsigned*)((const char*)(gbase) + (voff)[_i]), (LAS unsigned*)(lds + (bufoff) + ldsw + _i * 8192), 16, 0, 0); } while (0)
#define PG8_LDA(dst, b, h) do { _Pragma("unroll") for (int m = 0; m < 4; ++m) _Pragma("unroll") for (int k = 0; k < 2; ++k) dst[m][k] = *(const LAS bf16x8*)(lds + PG8_SA(b, h) + aoff + m * 2048 + k * 1024); } while (0)
#define PG8_LDB(dst, b, h) do { _Pragma("unroll") for (int n = 0; n < 2; ++n) _Pragma("unroll") for (int k = 0; k < 2; ++k) dst[n][k] = *(const LAS bf16x8*)(lds + PG8_SB(b, h) + boff + n * 2048 + k * 1024); } while (0)
#define PG8_MMA(ai, bj, At, Bt) do { __builtin_amdgcn_s_setprio(1); _Pragma("unroll") for (int m = 0; m < 4; ++m) _Pragma("unroll") for (int n = 0; n < 2; ++n) _Pragma("unroll") for (int k = 0; k < 2; ++k) \
        acc[ai][bj][m][n] = __builtin_amdgcn_mfma_f32_16x16x32_bf16(Bt[n][k], At[m][k], acc[ai][bj][m][n], 0, 0, 0); __builtin_amdgcn_s_setprio(0); } while (0)
#define PG8_WAIT_V(n) asm volatile("s_waitcnt vmcnt(" #n ")" ::: "memory")
#define PG8_WAIT_L(n) asm volatile("s_waitcnt lgkmcnt(" #n ")" ::: "memory")
#define PG8_BAR __builtin_amdgcn_s_barrier()
#define PG8_SCHED __builtin_amdgcn_sched_barrier(0)
    Unit cur, nxt; int ui = 0;
    if (!S.next(0, cur)) return;
    f32x4 acc[2][2][4][2];
#pragma unroll
    for (int a = 0; a < 2; ++a)
#pragma unroll
        for (int b = 0; b < 2; ++b)
#pragma unroll
            for (int m = 0; m < 4; ++m)
#pragma unroll
                for (int n = 0; n < 2; ++n) acc[a][b][m][n] = (f32x4){0.f, 0.f, 0.f, 0.f};
    bf16x8 At[4][2], B0[2][2], B1[2][2];
    const char* cA = (const char*)g.A + (size_t)cur.pm * tstep; const char* cB = (const char*)g.Bt + (size_t)cur.pn * tstep;
    PG8_STAGE(PG8_SB(0, 0), cB, voffB); PG8_STAGE(PG8_SB(0, 1), cB + hstep, voffB); PG8_STAGE(PG8_SA(0, 0), cA, voffA); PG8_STAGE(PG8_SA(0, 1), cA + hstep, voffA);
    if (wr == 1) PG8_BAR;
    PG8_WAIT_V(2); PG8_BAR;
    PG8_STAGE(PG8_SB(1, 0), cB + kstep, voffB); PG8_STAGE(PG8_SA(1, 0), cA + kstep, voffA); PG8_STAGE(PG8_SB(1, 1), cB + hstep + kstep, voffB);
    PG8_WAIT_V(6); PG8_BAR;
    for (;;) {
        const bool has_next = S.next(ui + 1, nxt);
        const char* nA = has_next ? (const char*)g.A + (size_t)nxt.pm * tstep : cA; const char* nB = has_next ? (const char*)g.Bt + (size_t)nxt.pn * tstep : cB;
        for (int t = 0; t < nt; t += 2) {
            const bool last = (t == nt - 2);
            const char* a1 = cA + (size_t)(t + 1) * kstep;
            const char* a2 = last ? nA : cA + (size_t)(t + 2) * kstep; const char* b2 = last ? nB : cB + (size_t)(t + 2) * kstep;
            const char* a3 = a2 + kstep; const char* b3 = b2 + kstep;
            PG8_LDB(B0, 0, 0); PG8_LDB(B1, 0, 1); PG8_SCHED; PG8_LDA(At, 0, 0); PG8_STAGE(PG8_SA(1, 1), a1 + hstep, voffA);
            PG8_WAIT_V(8); PG8_WAIT_L(0); PG8_BAR; PG8_MMA(0, 0, At, B0); PG8_MMA(0, 1, At, B1); PG8_BAR; PG8_SCHED;
            PG8_LDA(At, 0, 1); PG8_STAGE(PG8_SB(0, 0), b2, voffB); PG8_STAGE(PG8_SB(0, 1), b2 + hstep, voffB); PG8_STAGE(PG8_SA(0, 0), a2, voffA);
            PG8_WAIT_V(8); PG8_WAIT_L(0); PG8_BAR; PG8_MMA(1, 0, At, B0); PG8_MMA(1, 1, At, B1); PG8_BAR; PG8_SCHED;
            PG8_LDB(B0, 1, 0); PG8_LDB(B1, 1, 1); PG8_SCHED; PG8_LDA(At, 1, 0); PG8_STAGE(PG8_SA(0, 1), a2 + hstep, voffA);
            PG8_WAIT_V(8); PG8_WAIT_L(0); PG8_BAR; PG8_MMA(0, 0, At, B0); PG8_MMA(0, 1, At, B1); PG8_BAR; PG8_SCHED;
            PG8_LDA(At, 1, 1); PG8_STAGE(PG8_SB(1, 0), b3, voffB); PG8_STAGE(PG8_SB(1, 1), b3 + hstep, voffB); PG8_STAGE(PG8_SA(1, 0), a3, voffA);
            PG8_WAIT_V(8); PG8_WAIT_L(0); PG8_BAR; PG8_MMA(1, 0, At, B0); PG8_MMA(1, 1, At, B1); PG8_BAR; PG8_SCHED;
        }
        if constexpr (ALIGN_EPI) { if (wr == 0) PG8_BAR; }
        E(acc, cur, wr, wc, fr, fq);
        if (!has_next) break;
#pragma unroll
        for (int a = 0; a < 2; ++a)
#pragma unroll
            for (int b = 0; b < 2; ++b)
#pragma unroll
                for (int m = 0; m < 4; ++m)
#pragma unroll
                    for (int n = 0; n < 2; ++n) acc[a][b][m][n] = (f32x4){0.f, 0.f, 0.f, 0.f};
        cur = nxt; cA = nA; cB = nB; ++ui;
        if constexpr (ALIGN_EPI) { if (wr == 1) PG8_BAR; }
    }
    PG8_WAIT_V(0);
    if constexpr (!ALIGN_EPI) { if (wr == 0) PG8_BAR; }
    PG8_BAR;
#undef PG8_SA
#undef PG8_SB
#undef PG8_STAGE
#undef PG8_LDA
#undef PG8_LDB
#undef PG8_MMA
#undef PG8_WAIT_V
#undef PG8_WAIT_L
#undef PG8_BAR
#undef PG8_SCHED
}
}

struct Args { const float* in[17]; float* out; unsigned char* ws; int ph_lo, ph_hi; };
struct Ctx {
    LAS unsigned char* lds; int tid, lane, wave, G, bid;
    const float *x, *c, *w_ada, *b_ada, *norm1_w, *w_in, *lb_logits, *hgrn_onorm_w, *conv_w, *conv_onorm_w, *w_out, *norm2_w, *w_query, *sub_keys, *peer_u, *peer_v, *final_w;
    float* out; float *ACH, *MOD, *LB;
    bf16 *WIN, *WOUT, *WQ, *KEYS, *H1, *YCAT, *PROJ, *H2, *QP, *ST; unsigned char *U8, *V8; float *SU, *SV;
};

__device__ __forceinline__ void p0_transpose_item(const float* W, int K, int N, bf16* WT, LAS float* scr, int item, int lane) {
    const int nblk = N / 32, kb = item / nblk, nb = item % nblk, k0 = 64 * kb, n0 = 32 * nb;
#pragma unroll 8
    for (int i = 0; i < 32; ++i) { const int kk = 2 * i + (lane >> 5); scr[kk * 33 + (lane & 31)] = W[(size_t)(k0 + kk) * N + n0 + (lane & 31)]; }
    asm volatile("s_waitcnt lgkmcnt(0)" ::: "memory"); __builtin_amdgcn_wave_barrier();
    const int c = lane & 7;
#pragma unroll
    for (int j = 0; j < 4; ++j) { const int n = (lane >> 3) + 8 * j; const LAS float* s = scr + (8 * c) * 33 + n;
        v4u o; o.x = pk2(s[0 * 33], s[1 * 33]); o.y = pk2(s[2 * 33], s[3 * 33]); o.z = pk2(s[4 * 33], s[5 * 33]); o.w = pk2(s[6 * 33], s[7 * 33]);
        *(v4u*)(WT + (size_t)(n0 + n) * K + k0 + 8 * c) = o; }
    asm volatile("s_waitcnt lgkmcnt(0)" ::: "memory"); __builtin_amdgcn_wave_barrier();
}
__device__ __forceinline__ void cvt_stream(const float* src, bf16* dst, size_t n8, size_t gtid, size_t gstride) {
    for (size_t i = gtid; i < n8; i += gstride) {
        const f32x4 a = *(const f32x4*)(src + i * 8), b = *(const f32x4*)(src + i * 8 + 4);
        v4u o; o.x = pk2(a[0], a[1]); o.y = pk2(a[2], a[3]); o.z = pk2(b[0], b[1]); o.w = pk2(b[2], b[3]);
        *(v4u*)(dst + i * 8) = o;
    }
}

__device__ __forceinline__ void p0_prep(Ctx& F) {
    {
        LAS float* sc = (LAS float*)(F.lds);
        LAS float* part = (LAS float*)(F.lds + 8192);
        for (int u = F.bid; u < 96; u += F.G) {
            for (int i = F.tid; i < 2048; i += NTHR) { const float v = F.c[i]; sc[i] = v / (1.f + __expf(-v)); }
            __syncthreads();
            const int cgp = F.tid & 15, kg = F.tid >> 4, n0 = 64 * u + 4 * cgp;
            f32x4 a0 = {0.f, 0.f, 0.f, 0.f}, a1 = {0.f, 0.f, 0.f, 0.f};
#pragma unroll 4
            for (int k = kg; k < 1024; k += 32) { const f32x4 w = *(const f32x4*)(F.w_ada + (size_t)k * 6144 + n0); a0 += w * sc[k]; a1 += w * sc[1024 + k]; }
            *(LAS f32x4*)(part + (kg * 2 + 0) * 64 + 4 * cgp) = a0; *(LAS f32x4*)(part + (kg * 2 + 1) * 64 + 4 * cgp) = a1;
            __syncthreads();
            if (F.tid < 128) { const int b = F.tid >> 6, col = F.tid & 63; float s = F.b_ada[64 * u + col];
#pragma unroll 8
                for (int q = 0; q < 32; ++q) s += part[(q * 2 + b) * 64 + col];
                F.MOD[b * 6144 + 64 * u + col] = s; }
            __syncthreads();
        }
    }
    if (F.bid == (F.G > 100 ? 100 : 0)) { const float l0 = F.lb_logits[F.tid], l1 = F.lb_logits[512 + F.tid]; F.LB[F.tid] = 1.f / (1.f + __expf(l1 - l0)); }
    {
        LAS float* scr = (LAS float*)(F.lds + 32768 + F.wave * 12288);
        const int gw = F.bid * NWAVES + F.wave, NGW = F.G * NWAVES;
        constexpr int I_IN = (D / 64) * (NIN / 32), I_OUT = (D / 64) * (D / 32), I_Q = (D / 64) * (NQ / 32);
        for (int it = gw; it < I_IN + I_OUT + I_Q; it += NGW) {
            int r = it;
            if (r < I_IN) { p0_transpose_item(F.w_in, D, NIN, F.WIN, scr, r, F.lane); continue; } r -= I_IN;
            if (r < I_OUT) { p0_transpose_item(F.w_out, D, D, F.WOUT, scr, r, F.lane); continue; } r -= I_OUT;
            p0_transpose_item(F.w_query, D, NQ, F.WQ, scr, r, F.lane);
        }
    }
    {
        const size_t gtid = (size_t)F.bid * NTHR + F.tid, gs = (size_t)F.G * NTHR;
        cvt_stream(F.sub_keys, F.KEYS, (size_t)16 * 128 * 128 / 8, gtid, gs);
    }
    {
        const int gw = F.bid * NWAVES + F.wave, NGW = F.G * NWAVES;
        for (int r = gw; r < 32768; r += NGW) {
            const bool isv = r >= 16384; const int e = r & 16383;
            const float* srow = (isv ? F.peer_v : F.peer_u) + (size_t)e * D;
            f32x4 v[4]; float am = 0.f;
#pragma unroll
            for (int j = 0; j < 4; ++j) { v[j] = *(const f32x4*)(srow + 4 * F.lane + 256 * j);
                am = fmaxf(am, fmaxf(fmaxf(fabsf(v[j].x), fabsf(v[j].y)), fmaxf(fabsf(v[j].z), fabsf(v[j].w)))); }
#pragma unroll
            for (int o = 1; o < 64; o <<= 1) am = fmaxf(am, __shfl_xor(am, o));
            const float inv = am > 0.f ? 127.f / am : 0.f; const int off = isv ? 128 : 0;
            unsigned* drow = (unsigned*)((isv ? F.V8 : F.U8) + (size_t)e * D);
#pragma unroll
            for (int j = 0; j < 4; ++j) {
                const int q0 = (int)rintf(v[j].x * inv) + off, q1 = (int)rintf(v[j].y * inv) + off, q2 = (int)rintf(v[j].z * inv) + off, q3 = (int)rintf(v[j].w * inv) + off;
                drow[F.lane + 64 * j] = (unsigned)(q0 & 255) | ((unsigned)(q1 & 255) << 8) | ((unsigned)(q2 & 255) << 16) | ((unsigned)(q3 & 255) << 24); }
            if (F.lane == 0) (isv ? F.SV : F.SU)[e] = am * (1.f / 127.f);
        }
    }
}

__device__ __forceinline__ void modnorm_row(const float* xrow, const float* w, const float* shift, const float* scale, bf16* orow, int lane) {
    f32x4 v[4]; float s = 0.f;
#pragma unroll
    for (int j = 0; j < 4; ++j) { v[j] = *(const f32x4*)(xrow + 4 * lane + 256 * j); s += (v[j].x * v[j].x + v[j].y * v[j].y) + (v[j].z * v[j].z + v[j].w * v[j].w); }
    const float rstd = 1.f / sqrtf(wave_sum(s) * (1.f / D) + EPS);
#pragma unroll
    for (int j = 0; j < 4; ++j) { const int col = 4 * lane + 256 * j;
        const f32x4 wv = *(const f32x4*)(w + col), sh = *(const f32x4*)(shift + col), sc = *(const f32x4*)(scale + col);
        const f32x4 y = v[j] * rstd * wv * (sc + 1.f) + sh;
        v2u o; o.x = pk2(y.x, y.y); o.y = pk2(y.z, y.w); *(v2u*)(orow + col) = o; }
}

__device__ __forceinline__ void p3_local(Ctx& F) {
    LAS unsigned char* KT = F.lds;
    LAS unsigned char* VT = F.lds + 18432;
    LAS float* QT = (LAS float*)(F.lds + 36864);
    LAS unsigned char* OUT = F.lds + 38912;
    const int tid = F.tid, lane = F.lane, wave = F.wave, fr = lane & 15, fq = lane >> 4;
    for (int u = F.bid; u < 1024; u += F.G) {
        const int bh = u >> 7, c = u & 127, b = bh >> 2, hh = bh & 3;
        const size_t r0 = (size_t)b * SEQ + (size_t)c * 64;
        const int d = tid & 127, tq = tid >> 7;
        const bf16* pf = F.PROJ + (r0 + 16 * tq) * NIN + 512 + hh * 128 + d;
        const bf16* pv = F.PROJ + (r0 + 16 * tq) * NIN + 1024 + hh * 128 + d;
        const float lbv = F.LB[hh * 128 + d], oml = 1.f - lbv;
        unsigned short fraw[16], vraw[16];
#pragma unroll
        for (int j = 0; j < 16; ++j) { fraw[j] = pf[(size_t)j * NIN]; vraw[j] = pv[(size_t)j * NIN]; }
        float cs[16], kk[16]; float run = 0.f;
#pragma unroll
        for (int j = 0; j < 16; ++j) { const float fv = bf2f(fraw[j]); const float e = __expf(-fv); const float sg = 1.f / (1.f + e);
            const float f = lbv + oml * sg; run += __logf(f); cs[j] = run; kk[j] = oml * (e * sg); }
        QT[tq * 128 + d] = run;
        __syncthreads();
        float prefix = 0.f, total = 0.f;
#pragma unroll
        for (int q = 0; q < 4; ++q) { const float t = QT[q * 128 + d]; total += t; if (q < tq) prefix += t; }
        unsigned kp[8], vp[8];
#pragma unroll
        for (int j = 0; j < 8; ++j) { const float k0 = kk[2 * j] * __expf(total - (prefix + cs[2 * j])), k1 = kk[2 * j + 1] * __expf(total - (prefix + cs[2 * j + 1]));
            kp[j] = pk2(k0, k1); vp[j] = (unsigned)vraw[2 * j] | ((unsigned)vraw[2 * j + 1] << 16); }
        *(LAS v4u*)(KT + d * 144 + tq * 32) = (v4u){kp[0], kp[1], kp[2], kp[3]}; *(LAS v4u*)(KT + d * 144 + tq * 32 + 16) = (v4u){kp[4], kp[5], kp[6], kp[7]};
        *(LAS v4u*)(VT + d * 144 + tq * 32) = (v4u){vp[0], vp[1], vp[2], vp[3]}; *(LAS v4u*)(VT + d * 144 + tq * 32 + 16) = (v4u){vp[4], vp[5], vp[6], vp[7]};
        if (tq == 0) F.ACH[u * 128 + d] = __expf(total);
        __syncthreads();
        {
            const int dblk = wave & 3, vh = wave >> 2;
            f32x4 acc[2][4];
#pragma unroll
            for (int a = 0; a < 2; ++a)
#pragma unroll
                for (int n = 0; n < 4; ++n) acc[a][n] = (f32x4){0.f, 0.f, 0.f, 0.f};
#pragma unroll
            for (int k2 = 0; k2 < 2; ++k2) {
                bf16x8 af[2], bfv[4];
#pragma unroll
                for (int a = 0; a < 2; ++a) af[a] = *(const LAS bf16x8*)(KT + (dblk * 32 + a * 16 + fr) * 144 + (k2 * 32 + fq * 8) * 2);
#pragma unroll
                for (int n = 0; n < 4; ++n) bfv[n] = *(const LAS bf16x8*)(VT + (vh * 64 + n * 16 + fr) * 144 + (k2 * 32 + fq * 8) * 2);
#pragma unroll
                for (int a = 0; a < 2; ++a)
#pragma unroll
                    for (int n = 0; n < 4; ++n) acc[a][n] = __builtin_amdgcn_mfma_f32_16x16x32_bf16(af[a], bfv[n], acc[a][n], 0, 0, 0);
            }
#pragma unroll
            for (int a = 0; a < 2; ++a)
#pragma unroll
                for (int n = 0; n < 4; ++n) { const int v = vh * 64 + n * 16 + fr, dd = dblk * 32 + a * 16 + 4 * fq;
                    *(LAS v2u*)(OUT + v * 272 + dd * 2) = (v2u){pk2(acc[a][n][0], acc[a][n][1]), pk2(acc[a][n][2], acc[a][n][3])}; }
        }
        __syncthreads();
        { const int row = tid >> 2, part = tid & 3; bf16* dst = F.ST + (size_t)u * 16384 + row * 128 + part * 32;
#pragma unroll
            for (int i = 0; i < 4; ++i) *(v4u*)(dst + i * 8) = *(const LAS v4u*)(OUT + row * 272 + part * 64 + i * 16); }
        __syncthreads();
    }
    {
        const int gw = F.bid * NWAVES + F.wave, NGW = F.G * NWAVES;
        const int ch = lane * 8;
        float w0[8], w1[8], w2[8], ow[8];
#pragma unroll
        for (int j = 0; j < 8; ++j) { w0[j] = F.conv_w[ch + j]; w1[j] = F.conv_w[512 + ch + j]; w2[j] = F.conv_w[1024 + ch + j]; ow[j] = F.conv_onorm_w[ch + j]; }
        for (int run = gw; run < M / 8; run += NGW) {
            const int rbase = run * 8;
            float u1[8], u2[8];
#pragma unroll
            for (int j = 0; j < 8; ++j) { u1[j] = 0.f; u2[j] = 0.f; }
            const int tpos = rbase & (SEQ - 1);
            if (tpos >= 1) { const bf16* p = F.PROJ + (size_t)(rbase - 1) * NIN + 2048 + ch; const v4u cc = *(const v4u*)(p + 512), xx = *(const v4u*)(p + 1024);
#pragma unroll
                for (int j = 0; j < 4; ++j) { const unsigned cw = cc[j], xw = xx[j]; u1[2 * j] = bf2f(cw & 0xffffu) * bf2f(xw & 0xffffu); u1[2 * j + 1] = bf2f(cw >> 16) * bf2f(xw >> 16); } }
            if (tpos >= 2) { const bf16* p = F.PROJ + (size_t)(rbase - 2) * NIN + 2048 + ch; const v4u cc = *(const v4u*)(p + 512), xx = *(const v4u*)(p + 1024);
#pragma unroll
                for (int j = 0; j < 4; ++j) { const unsigned cw = cc[j], xw = xx[j]; u2[2 * j] = bf2f(cw & 0xffffu) * bf2f(xw & 0xffffu); u2[2 * j + 1] = bf2f(cw >> 16) * bf2f(xw >> 16); } }
            for (int t = 0; t < 8; ++t) {
                const bf16* p = F.PROJ + (size_t)(rbase + t) * NIN + 2048 + ch;
                const v4u bb = *(const v4u*)(p), cc = *(const v4u*)(p + 512), xx = *(const v4u*)(p + 1024);
                float u0[8], y[8]; float ss = 0.f;
#pragma unroll
                for (int j = 0; j < 4; ++j) { const unsigned cw = cc[j], xw = xx[j]; u0[2 * j] = bf2f(cw & 0xffffu) * bf2f(xw & 0xffffu); u0[2 * j + 1] = bf2f(cw >> 16) * bf2f(xw >> 16); }
#pragma unroll
                for (int j = 0; j < 8; ++j) { const float bg = bf2f((j & 1) ? (bb[j >> 1] >> 16) : (bb[j >> 1] & 0xffffu));
                    y[j] = bg * (w0[j] * u2[j] + w1[j] * u1[j] + w2[j] * u0[j]); ss += y[j] * y[j]; }
                ss += __shfl_xor(ss, 1); ss += __shfl_xor(ss, 2); ss += __shfl_xor(ss, 4); ss += __shfl_xor(ss, 8);
                const float rstd = 1.f / sqrtf(ss * (1.f / 128.f) + EPS);
                v4u o; o.x = pk2(y[0] * rstd * ow[0], y[1] * rstd * ow[1]); o.y = pk2(y[2] * rstd * ow[2], y[3] * rstd * ow[3]);
                o.z = pk2(y[4] * rstd * ow[4], y[5] * rstd * ow[5]); o.w = pk2(y[6] * rstd * ow[6], y[7] * rstd * ow[7]);
                *(v4u*)(F.YCAT + (size_t)(rbase + t) * D + 512 + ch) = o;
#pragma unroll
                for (int j = 0; j < 8; ++j) { u2[j] = u1[j]; u1[j] = u0[j]; }
            }
        }
    }
}

__device__ __forceinline__ void p4_scan(Ctx& F) {
    const int gtid = F.bid * NTHR + F.tid;
    if (gtid >= 65536) return;
    const int bh = gtid >> 13, e2 = gtid & 8191, v = e2 >> 6, d = (e2 & 63) * 2;
    unsigned* p = (unsigned*)(F.ST + (size_t)bh * 128 * 16384 + v * 128 + d);
    const float* a = F.ACH + (size_t)bh * 128 * 128 + d;
    float s0 = 0.f, s1 = 0.f;
#pragma unroll 8
    for (int c = 0; c < 128; ++c) {
        const unsigned uu = p[(size_t)c * 8192]; const float a0 = a[c * 128], a1 = a[c * 128 + 1];
        p[(size_t)c * 8192] = pk2(s0, s1);
        s0 = a0 * s0 + bf2f(uu & 0xffffu); s1 = a1 * s1 + bf2f(uu >> 16);
    }
}

__device__ __forceinline__ void p5_out(Ctx& F) {
    LAS unsigned char* QM = F.lds;
    LAS unsigned char* Q0 = F.lds + 17408;
    LAS unsigned char* KM = F.lds + 34816;
    LAS unsigned char* VT = F.lds + 52224;
    LAS unsigned char* STL = F.lds + 70656;
    LAS float* QT = (LAS float*)(F.lds + 105472);
    LAS unsigned char* PB = F.lds + 107520;
    LAS float* NRM = (LAS float*)(F.lds + 125952);
    const int tid = F.tid, lane = F.lane, wave = F.wave, fr = lane & 15, fq = lane >> 4;
    for (int u = F.bid; u < 1024; u += F.G) {
        const int bh = u >> 7, c = u & 127, b = bh >> 2, hh = bh & 3;
        const size_t r0 = (size_t)b * SEQ + (size_t)c * 64;
        const int d = tid & 127, tq = tid >> 7;
        const bf16* pq = F.PROJ + (r0 + 16 * tq) * NIN + hh * 128 + d;
        const float lbv = F.LB[hh * 128 + d], oml = 1.f - lbv;
        unsigned short qraw[16], fraw[16], vraw[16];
#pragma unroll
        for (int j = 0; j < 16; ++j) { qraw[j] = pq[(size_t)j * NIN]; fraw[j] = pq[(size_t)j * NIN + 512]; vraw[j] = pq[(size_t)j * NIN + 1024]; }
        {
            const bf16* src = F.ST + (size_t)u * 16384;
#pragma unroll
            for (int i = 0; i < 4; ++i) { const int row = (tid >> 4) + 32 * i, ck = tid & 15; *(LAS v4u*)(STL + row * 272 + ck * 16) = *(const v4u*)(src + row * 128 + ck * 8); }
        }
        float cs[16], kk[16]; float run = 0.f;
#pragma unroll
        for (int j = 0; j < 16; ++j) { const float fv = bf2f(fraw[j]); const float e = __expf(-fv); const float sg = 1.f / (1.f + e);
            const float f = lbv + oml * sg; run += __logf(f); cs[j] = run; kk[j] = oml * (e * sg); }
        QT[tq * 128 + d] = run;
        __syncthreads();
        float prefix = 0.f; const float q0t = QT[d], q1t = QT[128 + d], q2t = QT[256 + d];
        if (tq >= 1) prefix += q0t; if (tq >= 2) prefix += q1t; if (tq >= 3) prefix += q2t;
        const float bmid = q0t + q1t;
        unsigned vp[8];
#pragma unroll
        for (int j = 0; j < 16; ++j) { const float bj = prefix + cs[j]; const float qv = bf2f(qraw[j]); const int t = 16 * tq + j;
            *(LAS unsigned short*)(QM + t * 272 + d * 2) = (unsigned short)f2bf(qv * __expf(bj - bmid));
            *(LAS unsigned short*)(Q0 + t * 272 + d * 2) = (unsigned short)f2bf(qv * __expf(bj));
            *(LAS unsigned short*)(KM + t * 272 + d * 2) = (unsigned short)f2bf(kk[j] * __expf(bmid - bj)); }
#pragma unroll
        for (int j = 0; j < 8; ++j) vp[j] = (unsigned)vraw[2 * j] | ((unsigned)vraw[2 * j + 1] << 16);
        *(LAS v4u*)(VT + d * 144 + tq * 32) = (v4u){vp[0], vp[1], vp[2], vp[3]}; *(LAS v4u*)(VT + d * 144 + tq * 32 + 16) = (v4u){vp[4], vp[5], vp[6], vp[7]};
        __syncthreads();
        const int rb = wave >> 1, vh = wave & 1;
        LAS unsigned char* P = PB + wave * 2304;
        {
            f32x4 sc[4];
#pragma unroll
            for (int sf = 0; sf < 4; ++sf) sc[sf] = (f32x4){0.f, 0.f, 0.f, 0.f};
#pragma unroll
            for (int k4 = 0; k4 < 4; ++k4) {
                const bf16x8 bq = *(const LAS bf16x8*)(QM + (16 * rb + fr) * 272 + (k4 * 32 + fq * 8) * 2);
#pragma unroll
                for (int sf = 0; sf < 4; ++sf) { const bf16x8 ak = *(const LAS bf16x8*)(KM + (16 * sf + fr) * 272 + (k4 * 32 + fq * 8) * 2);
                    sc[sf] = __builtin_amdgcn_mfma_f32_16x16x32_bf16(ak, bq, sc[sf], 0, 0, 0); }
            }
            const int t = 16 * rb + fr;
#pragma unroll
            for (int sf = 0; sf < 4; ++sf) { const int s0 = 16 * sf + 4 * fq;
                const float p0 = (s0 + 0 <= t) ? sc[sf][0] : 0.f, p1 = (s0 + 1 <= t) ? sc[sf][1] : 0.f, p2 = (s0 + 2 <= t) ? sc[sf][2] : 0.f, p3 = (s0 + 3 <= t) ? sc[sf][3] : 0.f;
                *(LAS v2u*)(P + fr * 144 + s0 * 2) = (v2u){pk2(p0, p1), pk2(p2, p3)}; }
        }
        __syncthreads();
        f32x4 oc[4];
#pragma unroll
        for (int n = 0; n < 4; ++n) oc[n] = (f32x4){0.f, 0.f, 0.f, 0.f};
#pragma unroll
        for (int k2 = 0; k2 < 2; ++k2) {
            const bf16x8 bp = *(const LAS bf16x8*)(P + fr * 144 + (k2 * 32 + fq * 8) * 2);
#pragma unroll
            for (int n = 0; n < 4; ++n) { const bf16x8 av = *(const LAS bf16x8*)(VT + (64 * vh + 16 * n + fr) * 144 + (k2 * 32 + fq * 8) * 2);
                oc[n] = __builtin_amdgcn_mfma_f32_16x16x32_bf16(av, bp, oc[n], 0, 0, 0); }
        }
#pragma unroll
        for (int k4 = 0; k4 < 4; ++k4) {
            const bf16x8 bq = *(const LAS bf16x8*)(Q0 + (16 * rb + fr) * 272 + (k4 * 32 + fq * 8) * 2);
#pragma unroll
            for (int n = 0; n < 4; ++n) { const bf16x8 as = *(const LAS bf16x8*)(STL + (64 * vh + 16 * n + fr) * 272 + (k4 * 32 + fq * 8) * 2);
                oc[n] = __builtin_amdgcn_mfma_f32_16x16x32_bf16(as, bq, oc[n], 0, 0, 0); }
        }
        float ss = 0.f;
#pragma unroll
        for (int n = 0; n < 4; ++n) ss += (oc[n][0] * oc[n][0] + oc[n][1] * oc[n][1]) + (oc[n][2] * oc[n][2] + oc[n][3] * oc[n][3]);
        ss += __shfl_xor(ss, 16); ss += __shfl_xor(ss, 32);
        if (fq == 0) NRM[(16 * rb + fr) * 2 + vh] = ss;
        __syncthreads();
        {
            const int t = 16 * rb + fr; const float tot = NRM[t * 2] + NRM[t * 2 + 1];
            const float rstd = 1.f / sqrtf(tot * (1.f / 128.f) + EPS);
            const bf16* pg = F.PROJ + (r0 + t) * NIN + 1536 + hh * 128;
            bf16* po = F.YCAT + (r0 + t) * D + hh * 128;
#pragma unroll
            for (int n = 0; n < 4; ++n) { const int v = 64 * vh + 16 * n + 4 * fq;
                const v2u gw = *(const v2u*)(pg + v); const f32x4 wv = *(const f32x4*)(F.hgrn_onorm_w + hh * 128 + v);
                float g[4] = {bf2f(gw.x & 0xffffu), bf2f(gw.x >> 16), bf2f(gw.y & 0xffffu), bf2f(gw.y >> 16)}; float o[4];
#pragma unroll
                for (int j = 0; j < 4; ++j) { const float sl = g[j] / (1.f + __expf(-g[j])); o[j] = oc[n][j] * rstd * wv[j] * sl; }
                *(v2u*)(po + v) = (v2u){pk2(o[0], o[1]), pk2(o[2], o[3])}; }
        }
        __syncthreads();
    }
}

__device__ __forceinline__ unsigned f2ord(float f) { const unsigned u = __float_as_uint(f); return (u & 0x80000000u) ? ~u : (u | 0x80000000u); }
__device__ __forceinline__ float ord2f(unsigned o) { return __uint_as_float((o & 0x80000000u) ? (o & 0x7fffffffu) : ~o); }
__device__ __forceinline__ void ce_desc(unsigned& a, unsigned& b) { const unsigned mx = a > b ? a : b, mn = a > b ? b : a; a = mx; b = mn; }
template <int N> __device__ __forceinline__ void bitonic_sort_desc(unsigned (&k)[N]) {
#pragma unroll
    for (int size = 2; size <= N; size <<= 1) {
#pragma unroll
        for (int stride = size >> 1; stride > 0; stride >>= 1) {
#pragma unroll
            for (int i = 0; i < N; ++i) { const int j = i ^ stride; if (j > i) { if ((i & size) == 0) ce_desc(k[i], k[j]); else ce_desc(k[j], k[i]); } }
        }
    }
}
__device__ __forceinline__ void bitonic_merge16_desc(unsigned (&k)[16]) {
#pragma unroll
    for (int stride = 8; stride > 0; stride >>= 1) {
#pragma unroll
        for (int i = 0; i < 16; ++i) { const int j = i ^ stride; if (j > i) ce_desc(k[i], k[j]); }
    }
}
__device__ __forceinline__ void merge_top16(unsigned (&a)[16], const unsigned (&b)[16]) {
#pragma unroll
    for (int i = 0; i < 16; ++i) a[i] = a[i] > b[15 - i] ? a[i] : b[15 - i];
    bitonic_merge16_desc(a);
}
__device__ __forceinline__ float gelu_erf(float x) { return 0.5f * x * (1.f + erff(x * 0.70710678118654752f)); }

__device__ __forceinline__ void p9_peer(Ctx& F) {
    LAS unsigned* TOP = (LAS unsigned*)F.lds;
    LAS v2u* IDXG = (LAS v2u*)(F.lds + 65536);
    const int tid = F.tid, lane = F.lane, wave = F.wave, fr = lane & 15, fq = lane >> 4;
    for (int tile = F.bid; tile < M / 64; tile += F.G) {
        const size_t r0 = (size_t)tile * 64;
        {
            const int p = wave >> 2, tb = wave & 3;
            for (int h = 0; h < 8; ++h) {
                f32x4 sc[8];
#pragma unroll
                for (int nf = 0; nf < 8; ++nf) sc[nf] = (f32x4){0.f, 0.f, 0.f, 0.f};
                const bf16* qrow = F.QP + (r0 + 16 * tb + fr) * NQ + h * 256 + p * 128 + fq * 8;
                const bf16* krow = F.KEYS + (size_t)((h * 2 + p) * 128 + fr) * 128 + fq * 8;
#pragma unroll
                for (int k4 = 0; k4 < 4; ++k4) {
                    const bf16x8 bq = *(const bf16x8*)(qrow + k4 * 32);
#pragma unroll
                    for (int nf = 0; nf < 8; ++nf) { const bf16x8 ak = *(const bf16x8*)(krow + (size_t)nf * 16 * 128 + k4 * 32);
                        sc[nf] = __builtin_amdgcn_mfma_f32_16x16x32_bf16(ak, bq, sc[nf], 0, 0, 0); }
                }
                unsigned ka[16], kb[16];
#pragma unroll
                for (int nf = 0; nf < 4; ++nf)
#pragma unroll
                    for (int r = 0; r < 4; ++r) {
                        ka[nf * 4 + r] = (f2ord(sc[nf][r]) & ~127u) | (unsigned)(127 - (16 * nf + 4 * fq + r));
                        kb[nf * 4 + r] = (f2ord(sc[nf + 4][r]) & ~127u) | (unsigned)(127 - (16 * (nf + 4) + 4 * fq + r)); }
                bitonic_sort_desc<16>(ka); bitonic_sort_desc<16>(kb);
                merge_top16(ka, kb);
                {
                    unsigned o[16];
#pragma unroll
                    for (int i = 0; i < 16; ++i) o[i] = (unsigned)__shfl_xor((int)ka[i], 16);
                    merge_top16(ka, o);
#pragma unroll
                    for (int i = 0; i < 16; ++i) o[i] = (unsigned)__shfl_xor((int)ka[i], 32);
                    merge_top16(ka, o);
                }
                if (fq == 0) { LAS v4u* dst = (LAS v4u*)(TOP + (((16 * tb + fr) * 8 + h) * 2 + p) * 16);
                    dst[0] = (v4u){ka[0], ka[1], ka[2], ka[3]}; dst[1] = (v4u){ka[4], ka[5], ka[6], ka[7]}; dst[2] = (v4u){ka[8], ka[9], ka[10], ka[11]}; dst[3] = (v4u){ka[12], ka[13], ka[14], ka[15]}; }
            }
        }
        __syncthreads();
        {
            const int t = tid >> 3, h = tid & 7;
            const LAS unsigned* pa = TOP + ((t * 8 + h) * 2) * 16; const LAS unsigned* pb = pa + 16;
            float av[16], bv[16];
            { const LAS v4u* qa = (const LAS v4u*)pa; const LAS v4u* qb = (const LAS v4u*)pb;
#pragma unroll
              for (int i = 0; i < 4; ++i) { const v4u x = qa[i], y = qb[i];
#pragma unroll
                  for (int j = 0; j < 4; ++j) { av[4 * i + j] = ord2f(x[j] & ~127u); bv[4 * i + j] = ord2f(y[j] & ~127u); } } }
            unsigned c0[16], c1[16], c2[16], c3[16];
#pragma unroll
            for (int i = 0; i < 16; ++i) { c0[i] = 0u; c1[i] = 0u; c2[i] = 0u; c3[i] = 0u; }
            {
                int n = 0;
#pragma unroll
                for (int i = 0; i < 16; ++i)
#pragma unroll
                    for (int j = 0; j < 16; ++j) if ((i + 1) * (j + 1) <= 16) {
                        const unsigned key = (f2ord(av[i] + bv[j]) & ~255u) | (unsigned)(255 - (i * 16 + j));
                        if (n < 16) c0[n] = key; else if (n < 32) c1[n - 16] = key; else if (n < 48) c2[n - 32] = key; else c3[n - 48] = key;
                        ++n; }
            }
            bitonic_sort_desc<16>(c0); bitonic_sort_desc<16>(c1); bitonic_sort_desc<16>(c2); bitonic_sort_desc<16>(c3);
            merge_top16(c0, c1); merge_top16(c2, c3); merge_top16(c0, c2);
            float sv[16]; unsigned ix[16]; float mx = -3.0e38f;
#pragma unroll
            for (int k = 0; k < 16; ++k) { const unsigned pos = 255u - (c0[k] & 255u); const unsigned ua = pa[pos >> 4], ub = pb[pos & 15];
                sv[k] = ord2f(ua & ~127u) + ord2f(ub & ~127u); ix[k] = (127u - (ua & 127u)) * 128u + (127u - (ub & 127u)); mx = fmaxf(mx, sv[k]); }
            float sum = 0.f;
#pragma unroll
            for (int k = 0; k < 16; ++k) { sv[k] = __expf(sv[k] - mx); sum += sv[k]; }
            const float inv = 1.f / sum;
#pragma unroll
            for (int k = 0; k < 16; ++k) IDXG[t * 128 + h * 16 + k] = (v2u){ix[k], __float_as_uint(sv[k] * inv)};
        }
        __syncthreads();
        {
            const int c16 = lane & 15, rp = lane >> 4;
            for (int round = 0; round < 8; ++round) {
                const int tl = round * 8 + wave; const size_t row = r0 + tl; const int b = (int)(row >> 13);
                unsigned hq[16]; float sh;
                {
                    float hv[64]; float am = 0.f;
#pragma unroll
                    for (int S = 0; S < 4; ++S) { const v4u a = *(const v4u*)(F.H2 + row * D + S * 256 + c16 * 16), bq = *(const v4u*)(F.H2 + row * D + S * 256 + c16 * 16 + 8);
#pragma unroll
                        for (int w = 0; w < 4; ++w) { hv[S * 16 + 2 * w] = bf2f(a[w] & 0xffffu); hv[S * 16 + 2 * w + 1] = __uint_as_float(a[w] & 0xffff0000u);
                            hv[S * 16 + 8 + 2 * w] = bf2f(bq[w] & 0xffffu); hv[S * 16 + 8 + 2 * w + 1] = __uint_as_float(bq[w] & 0xffff0000u); } }
#pragma unroll
                    for (int i = 0; i < 64; ++i) am = fmaxf(am, fabsf(hv[i]));
                    am = fmaxf(am, __shfl_xor(am, 1)); am = fmaxf(am, __shfl_xor(am, 2)); am = fmaxf(am, __shfl_xor(am, 4)); am = fmaxf(am, __shfl_xor(am, 8));
                    const float inv = am > 0.f ? 127.f / am : 0.f; sh = am * (1.f / 127.f);
#pragma unroll
                    for (int i = 0; i < 16; ++i) { const int q0 = (int)rintf(hv[4 * i] * inv), q1 = (int)rintf(hv[4 * i + 1] * inv), q2 = (int)rintf(hv[4 * i + 2] * inv), q3 = (int)rintf(hv[4 * i + 3] * inv);
                        hq[i] = (unsigned)(q0 & 255) | ((unsigned)(q1 & 255) << 8) | ((unsigned)(q2 & 255) << 16) | ((unsigned)(q3 & 255) << 24); }
                }
                float acc[16]; float csum = 0.f;
#pragma unroll
                for (int i = 0; i < 16; ++i) acc[i] = 0.f;
#pragma unroll 1
                for (int e8 = 0; e8 < 16; ++e8) {
                    const LAS v2u* ig = IDXG + tl * 128 + e8 * 8;
                    const v2u igA = ig[rp], igB = ig[4 + rp];
                    const unsigned char* upA = F.U8 + (size_t)igA.x * D + c16 * 16; const unsigned char* upB = F.U8 + (size_t)igB.x * D + c16 * 16;
                    v4u uA[4], uB[4], vv[8]; float svj[8];
#pragma unroll
                    for (int S = 0; S < 4; ++S) { uA[S] = *(const v4u*)(upA + S * 256); uB[S] = *(const v4u*)(upB + S * 256); }
#pragma unroll
                    for (int j = 0; j < 8; ++j) { const unsigned ej = ig[j].x; vv[j] = *(const v4u*)(F.V8 + (size_t)ej * D + lane * 16); svj[j] = F.SV[ej]; }
                    const float suA = F.SU[igA.x], suB = F.SU[igB.x];
                    int dA = 0, dB = 0;
#pragma unroll
                    for (int S = 0; S < 4; ++S)
#pragma unroll
                        for (int w = 0; w < 4; ++w) { dA = __builtin_amdgcn_sdot4((int)uA[S][w], (int)hq[S * 4 + w], dA, false); dB = __builtin_amdgcn_sdot4((int)uB[S][w], (int)hq[S * 4 + w], dB, false); }
                    dA += __shfl_xor(dA, 1); dB += __shfl_xor(dB, 1); dA += __shfl_xor(dA, 2); dB += __shfl_xor(dB, 2);
                    dA += __shfl_xor(dA, 4); dB += __shfl_xor(dB, 4); dA += __shfl_xor(dA, 8); dB += __shfl_xor(dB, 8);
                    const float cA = __uint_as_float(igA.y) * gelu_erf((float)dA * suA * sh), cB = __uint_as_float(igB.y) * gelu_erf((float)dB * suB * sh);
#pragma unroll
                    for (int j = 0; j < 8; ++j) {
                        const float cj = __uint_as_float(__builtin_amdgcn_readlane(__float_as_uint(j < 4 ? cA : cB), 16 * (j & 3))) * svj[j];
                        csum += cj;
#pragma unroll
                        for (int w = 0; w < 4; ++w) { const unsigned x = vv[j][w];
                            acc[4 * w + 0] += cj * (float)(x & 255u); acc[4 * w + 1] += cj * (float)((x >> 8) & 255u);
                            acc[4 * w + 2] += cj * (float)((x >> 16) & 255u); acc[4 * w + 3] += cj * (float)(x >> 24); }
                    }
                }
                float x2[16]; float ss = 0.f; const int d0i = 16 * lane;
#pragma unroll
                for (int q = 0; q < 4; ++q) { const f32x4 xa = *(const f32x4*)(F.out + row * D + d0i + 4 * q), ga = *(const f32x4*)(F.MOD + b * 6144 + 5120 + d0i + 4 * q);
#pragma unroll
                    for (int j = 0; j < 4; ++j) { const float pv = acc[4 * q + j] - 128.f * csum; x2[4 * q + j] = xa[j] + ga[j] * pv; ss += x2[4 * q + j] * x2[4 * q + j]; } }
                const float rstd = 1.f / sqrtf(wave_sum(ss) * (1.f / D) + EPS);
#pragma unroll
                for (int q = 0; q < 4; ++q) { const f32x4 wa = *(const f32x4*)(F.final_w + d0i + 4 * q); f32x4 oa;
#pragma unroll
                    for (int j = 0; j < 4; ++j) oa[j] = x2[4 * q + j] * rstd * wa[j];
                    *(f32x4*)(F.out + row * D + d0i + 4 * q) = oa; }
            }
        }
        __syncthreads();
    }
}

#define XB_TMO      128
#define XB_XCNT(j)  (256  + 64 * (j))
#define XB_XSUB(j)  (1280 + 64 * (j))
#define XB_XGEN(j)  (2304 + 64 * (j))
#define XB_TOP      3328
#define XB_TOPGEN   3392
#define XCD_BAR_WORDS 3456
#define XB_SPIN_CAP (1u << 20)
__device__ __forceinline__ unsigned xb_ld(unsigned* p)              { return __hip_atomic_load(p, __ATOMIC_RELAXED, __HIP_MEMORY_SCOPE_AGENT); }
__device__ __forceinline__ unsigned xb_add(unsigned* p, unsigned v) { return __hip_atomic_fetch_add(p, v, __ATOMIC_RELAXED, __HIP_MEMORY_SCOPE_AGENT); }
__device__ __forceinline__ unsigned xb_xcc_id() { return (unsigned)__builtin_amdgcn_s_getreg((3 << 11) | 20) & 0xFu; }
#define XB_SPIN(cond, bar) do { unsigned _sp = 0; while (cond) { __builtin_amdgcn_s_sleep(1); \
    if ((++_sp & 255u) == 0u) { if (xb_ld(&(bar)[XB_TMO])) break; if (_sp > XB_SPIN_CAP) { atomicAdd(&(bar)[XB_TMO], 1u); break; } } } } while (0)
struct XcdBarrier { unsigned* bar; unsigned x; volatile LAS unsigned* st; };
__device__ __forceinline__ XcdBarrier xcd_barrier_post(unsigned* bar, volatile LAS unsigned* st) {
    XcdBarrier b; b.bar = bar; b.x = xb_xcc_id(); b.st = st;
    if (threadIdx.x == 0) (void)xb_add(&bar[XB_XCNT(b.x)], 1u);
    return b;
}
__device__ __forceinline__ void xcd_barrier_complete(unsigned* bar, unsigned x, unsigned& nloc, unsigned& nx) {
    const unsigned G = gridDim.x * gridDim.y * gridDim.z;
    unsigned sum, cnt, mine, sp = 0u;
    for (;;) {
        sum = 0u; cnt = 0u; mine = 0u;
#pragma unroll
        for (unsigned j = 0; j < 16; ++j) { const unsigned c = xb_ld(&bar[XB_XCNT(j)]); sum += c; cnt += (c > 0u) ? 1u : 0u; mine = (j == x) ? c : mine; }
        if (sum == G) break;
        __builtin_amdgcn_s_sleep(1);
        if ((++sp & 255u) == 0u) { if (xb_ld(&bar[XB_TMO])) break; if (sp > XB_SPIN_CAP) { atomicAdd(&bar[XB_TMO], 1u); break; } }
    }
    nloc = mine > 0u ? mine : 1u; nx = cnt > 0u ? cnt : 1u;
}
__device__ __forceinline__ void xcd_barrier(const XcdBarrier& b) {
    asm volatile("s_waitcnt vmcnt(0)" ::: "memory");
    __syncthreads();
    if (threadIdx.x == 0) {
        unsigned* bar = b.bar;
        __builtin_amdgcn_s_waitcnt(0);
        unsigned nloc = b.st[0], nx = b.st[1];
        if (nloc == 0u) { xcd_barrier_complete(bar, b.x, nloc, nx); b.st[0] = nloc; b.st[1] = nx; }
        const unsigned old = xb_add(&bar[XB_XSUB(b.x)], 1u);
        const unsigned gen = old / nloc;
        if (old + 1u == (gen + 1u) * nloc) {
            __builtin_amdgcn_fence(__ATOMIC_RELEASE, "agent");
            asm volatile("s_waitcnt vmcnt(0)" ::: "memory");
            const unsigned og = xb_add(&bar[XB_TOP], 1u);
            const unsigned tg = og / nx;
            if (og + 1u == (tg + 1u) * nx) xb_add(&bar[XB_TOPGEN], 1u);
            else XB_SPIN(xb_ld(&bar[XB_TOPGEN]) == tg, bar);
            __builtin_amdgcn_fence(__ATOMIC_ACQUIRE, "agent");
            xb_add(&bar[XB_XGEN(b.x)], 1u);
            asm volatile("s_waitcnt vmcnt(0)" ::: "memory");
        } else {
            XB_SPIN(xb_ld(&bar[XB_XGEN(b.x)]) == gen, bar);
            __builtin_amdgcn_fence(__ATOMIC_ACQUIRE, "agent");
            asm volatile("s_waitcnt vmcnt(0)" ::: "memory");
        }
    }
    __syncthreads();
}

__global__ void __launch_bounds__(NTHR, 2) mk_fwd(Args args) {
    extern __shared__ __attribute__((aligned(16))) unsigned char lds_raw[];
    Ctx F;
    F.lds = (LAS unsigned char*)lds_raw;
    F.tid = threadIdx.x; F.lane = F.tid & 63; F.wave = __builtin_amdgcn_readfirstlane(F.tid >> 6); F.G = gridDim.x; F.bid = blockIdx.x;
    F.x = args.in[0]; F.c = args.in[1]; F.w_ada = args.in[2]; F.b_ada = args.in[3]; F.norm1_w = args.in[4]; F.w_in = args.in[5]; F.lb_logits = args.in[6];
    F.hgrn_onorm_w = args.in[7]; F.conv_w = args.in[8]; F.conv_onorm_w = args.in[9]; F.w_out = args.in[10]; F.norm2_w = args.in[11]; F.w_query = args.in[12];
    F.sub_keys = args.in[13]; F.peer_u = args.in[14]; F.peer_v = args.in[15]; F.final_w = args.in[16];
    F.out = args.out;
    unsigned char* ws = args.ws;
    F.ACH = (float*)(ws + WS_ACH); F.MOD = (float*)(ws + WS_MOD); F.LB = (float*)(ws + WS_LB);
    F.WIN = (bf16*)(ws + WS_WIN); F.WOUT = (bf16*)(ws + WS_WOUT); F.WQ = (bf16*)(ws + WS_WQ); F.KEYS = (bf16*)(ws + WS_KEYS);
    F.U8 = ws + WS_U8; F.V8 = ws + WS_V8; F.SU = (float*)(ws + WS_SU); F.SV = (float*)(ws + WS_SV); F.H1 = (bf16*)(ws + WS_H1); F.YCAT = (bf16*)(ws + WS_H1);
    F.PROJ = (bf16*)(ws + WS_PROJ); F.H2 = (bf16*)(ws + WS_PROJ); F.QP = (bf16*)(ws + WS_PROJ + 32 * MiB); F.ST = (bf16*)(ws + WS_ST);
    const int lo = args.ph_lo, hi = args.ph_hi;
    volatile LAS unsigned* MISC = (volatile LAS unsigned*)(F.lds + MISC_OFF);
    if (F.tid < 16) MISC[F.tid] = 0u;
    __syncthreads();
    XcdBarrier bar = xcd_barrier_post((unsigned*)(ws + WS_CTL), MISC);
#define IN(k) (lo <= (k) && (k) < hi)
#define SEAM(k) do { if (IN(k) && IN((k) + 1)) { xcd_barrier(bar); } } while (0)
    if (IN(0)) { p0_prep(F); } SEAM(0);
    if (IN(1)) { const int gw = F.bid * NWAVES + F.wave, NGW = F.G * NWAVES;
        for (int m = gw; m < M; m += NGW) { const float* md = F.MOD + (m >> 13) * 6144; modnorm_row(F.x + (size_t)m * D, F.norm1_w, md, md + 1024, F.H1 + (size_t)m * D, F.lane); } } SEAM(1);
    if (IN(2)) { pg8::Gemm g{F.H1, F.WIN, M, NIN, D}; pg8::StaticOrder S; S.init(M, NIN, F.G, F.bid); pg8::EpiBf16 E{F.PROJ, NIN}; pg8::gemm_phase<pg8::EpiBf16>(F.lds, g, S, E); } SEAM(2);
    if (IN(3)) { p3_local(F); } SEAM(3);
    if (IN(4)) { p4_scan(F); } SEAM(4);
    if (IN(5)) { p5_out(F); } SEAM(5);
    if (IN(6)) { pg8::Gemm g{F.YCAT, F.WOUT, M, D, D}; pg8::StaticOrder S; S.init(M, D, F.G, F.bid); pg8::EpiRes E{F.x, F.out, F.MOD}; pg8::gemm_phase<pg8::EpiRes>(F.lds, g, S, E); } SEAM(6);
    if (IN(7)) { const int gw = F.bid * NWAVES + F.wave, NGW = F.G * NWAVES;
        for (int m = gw; m < M; m += NGW) { const float* md = F.MOD + (m >> 13) * 6144; modnorm_row(F.out + (size_t)m * D, F.norm2_w, md + 3072, md + 4096, F.H2 + (size_t)m * D, F.lane); } } SEAM(7);
    if (IN(8)) { pg8::Gemm g{F.H2, F.WQ, M, NQ, D}; pg8::StaticOrder S; S.init(M, NQ, F.G, F.bid); pg8::EpiBf16 E{F.QP, NQ}; pg8::gemm_phase<pg8::EpiBf16>(F.lds, g, S, E); } SEAM(8);
#ifndef DBG_STOP
    if (IN(9)) { p9_peer(F); }
#else
    xcd_barrier(bar);
    {
        const size_t gt = (size_t)F.bid * NTHR + F.tid, gs = (size_t)F.G * NTHR;
        for (size_t i = gt; i < (size_t)M * D; i += gs) { const size_t r = i >> 10, c = i & 1023; float v = 0.f;
            if (DBG_STOP == 2) { const bf16* p = F.PROJ + r * NIN + c; v = bf2f(p[0]) + bf2f(p[1024]) + bf2f(p[2048]) + (c < 512 ? bf2f(p[3072]) : 0.f); }
            else if (DBG_STOP == 5) { v = bf2f(F.YCAT[r * D + c]); }
            else if (DBG_STOP == 6) { v = F.out[i]; }
            else if (DBG_STOP == 8) { v = bf2f(F.QP[r * NQ + c]) + bf2f(F.QP[r * NQ + c + 1024]); }
            else if (DBG_STOP == 4 || DBG_STOP == 3) { v = bf2f(F.ST[i]); }
            else if (DBG_STOP == 1) { v = bf2f(F.H1[i]); }
            F.out[i] = v; }
    }
#endif
#undef IN
#undef SEAM
}

extern "C" void kernel_launch(void* const* d_in, const int* in_sizes, int n_in, void* d_out, int out_size, void* d_ws, size_t ws_size, hipStream_t stream) {
    static int grid = 0;
    if (grid == 0) {
        if (n_in != 17 || out_size != M * D || ws_size < WS_END) { fprintf(stderr, "kernel_launch: unexpected shapes (n_in %d out %d ws %zu)\n", n_in, out_size, ws_size); grid = -1; return; }
        int dev = 0, cus = 0, per_cu = 0;
        (void)hipGetDevice(&dev); (void)hipDeviceGetAttribute(&cus, hipDeviceAttributeMultiprocessorCount, dev);
        if (hipFuncSetAttribute((const void*)mk_fwd, hipFuncAttributeMaxDynamicSharedMemorySize, LDS_BYTES) != hipSuccess) { fprintf(stderr, "kernel_launch: hipFuncSetAttribute failed\n"); grid = -1; return; }
        if (hipOccupancyMaxActiveBlocksPerMultiprocessor(&per_cu, (const void*)mk_fwd, NTHR, LDS_BYTES) != hipSuccess || per_cu < 1) { fprintf(stderr, "kernel_launch: occupancy query gives %d\n", per_cu); per_cu = 1; }
        (void)hipGetLastError();
        grid = cus;
    }
    if (grid < 0) return;
    if (hipMemsetAsync((char*)d_ws + WS_CTL, 0, CTL_ZERO_BYTES, stream) != hipSuccess) { fprintf(stderr, "kernel_launch: memset failed\n"); return; }
    Args a{};
    for (int i = 0; i < 17; ++i) a.in[i] = (const float*)d_in[i];
    a.out = (float*)d_out; a.ws = (unsigned char*)d_ws;
#if MK_LAUNCHES == 1
#ifdef DBG_STOP
    a.ph_lo = 0; a.ph_hi = DBG_STOP + 1;
#else
    a.ph_lo = 0; a.ph_hi = 10;
#endif
    void* kargs[] = {&a};
    hipError_t e = hipLaunchCooperativeKernel((const void*)mk_fwd, dim3(grid), dim3(NTHR), kargs, LDS_BYTES, stream);
    if (e != hipSuccess) fprintf(stderr, "kernel_launch: cooperative launch failed: %s (grid %d)\n", hipGetErrorString(e), grid);
#else
    for (int ph = 0; ph < 10; ++ph) { a.ph_lo = ph; a.ph_hi = ph + 1; hipLaunchKernelGGL(mk_fwd, dim3(grid), dim3(NTHR), LDS_BYTES, stream, a); }
#endif
}
```

```cpp
#include <hip/hip_runtime.h>
#include <hip/hip_cooperative_groups.h>
#include <cstdio>
#include <cstdint>
namespace cg = cooperative_groups;

#ifndef REP_MASK
#define REP_MASK 0
#endif
#define NREP(k) (((REP_MASK) >> (k)) & 1 ? 2 : 1)
#ifndef MK_LAUNCHES
#define MK_LAUNCHES 1
#endif

#define LAS __attribute__((address_space(3)))
typedef unsigned short bf16;
typedef unsigned v4u __attribute__((ext_vector_type(4)));
typedef unsigned v2u __attribute__((ext_vector_type(2)));
typedef float f32x4 __attribute__((ext_vector_type(4)));
typedef short bf16x8 __attribute__((ext_vector_type(8)));
typedef __bf16 bf16x2 __attribute__((ext_vector_type(2)));

constexpr int D = 1024, SEQ = 8192, M = 16384;
constexpr int NIN = 3584, NQ = 2048;
constexpr float EPS = 1e-6f;
constexpr int NWAVES = 8, NTHR = 512;

constexpr size_t MiB = 1u << 20;
constexpr size_t WS_ACH = 1 * MiB;
constexpr size_t WS_MOD = 1 * MiB + 512 * 1024;
constexpr size_t WS_LB = WS_MOD + 64 * 1024;
constexpr size_t WS_WIN = 2 * MiB;
constexpr size_t WS_WOUT = 9 * MiB;
constexpr size_t WS_WQ = 11 * MiB;
constexpr size_t WS_KEYS = 15 * MiB;
constexpr size_t WS_U8 = 16 * MiB, WS_V8 = 32 * MiB;
constexpr size_t WS_SU = WS_MOD + 128 * 1024, WS_SV = WS_MOD + 192 * 1024;
constexpr size_t WS_H1 = 80 * MiB;
constexpr size_t WS_PROJ = 112 * MiB;
constexpr size_t WS_ST = 224 * MiB;
constexpr size_t WS_END = 256 * MiB;
constexpr int LDS_BYTES = 147456, MISC_OFF = 147456 - 256;
constexpr size_t WS_CTL = 0, CTL_ZERO_BYTES = 65536;

__device__ __forceinline__ float bf2f(unsigned h) { return __uint_as_float(h << 16); }
__device__ __forceinline__ unsigned f2bf(float f) { unsigned u = __float_as_uint(f); return (u + 0x7fffu + ((u >> 16) & 1u)) >> 16; }
typedef float f32x2 __attribute__((ext_vector_type(2)));
__device__ __forceinline__ unsigned pk2(float lo, float hi) { const f32x2 v = {lo, hi}; return __builtin_bit_cast(unsigned, __builtin_convertvector(v, bf16x2)); }
__device__ __forceinline__ float dot2(unsigned w, unsigned x, float acc) { return __builtin_amdgcn_fdot2_f32_bf16(__builtin_bit_cast(bf16x2, w), __builtin_bit_cast(bf16x2, x), acc, false); }
__device__ __forceinline__ float wave_sum(float v) {
#pragma unroll
    for (int o = 1; o < 64; o <<= 1) v += __shfl_xor(v, o);
    return v;
}

namespace pg8 {
constexpr int BM = 256, BK = 64, HALF = 128, HTB = HALF * BK * 2, STAGE_BYTES = 8 * HTB, NXCD = 8, WGM = 8;
__host__ __device__ __forceinline__ int lds_byte(int r, int c) { const int st = (r >> 4) * 2 + (c >> 5), rr = r & 15, cc = c & 31, ob = rr * 64 + cc * 2; return st * 1024 + (ob ^ (((ob >> 9) & 1) << 5)); }
__host__ __device__ __forceinline__ void stage_rc(int b, int& R, int& C) { const int st = b / 1024, sb = b % 1024, swz = sb ^ (((sb >> 9) & 1) << 5); R = (st >> 1) * 16 + swz / 64; C = (st & 1) * 32 + (swz % 64) / 2; }
__host__ __device__ __forceinline__ int perm32(int rho) { const int n = rho >> 4, i = rho & 15; return 8 * (i >> 2) + 4 * n + (i & 3); }
struct Unit { int pm, pn; };
struct Gemm { const bf16* A; const bf16* Bt; int M, N, K; };
struct StaticOrder {
    int nM, nN, nwg, G, c;
    __host__ __device__ void init(int M_, int N_, int G_, int c_) { nM = M_ / BM; nN = N_ / BM; nwg = nM * nN; G = G_; c = c_; }
    __host__ __device__ bool next(int i, Unit& u) const {
        const long L = (long)i * G + c; if (L >= nwg) return false;
        int wgid = (int)L; { const int q = nwg / NXCD, r = nwg % NXCD, xcd = wgid % NXCD, off = wgid / NXCD; wgid = (xcd < r ? xcd * (q + 1) : r * (q + 1) + (xcd - r) * q) + off; }
        const int nig = WGM * nN, gid = wgid / nig, fm = gid * WGM, gsz = (nM - fm) < WGM ? (nM - fm) : WGM;
        u.pm = fm + ((wgid % nig) % gsz); u.pn = (wgid % nig) / gsz; return true;
    }
};
struct EpiBf16 {
    static constexpr bool PERM = true;
    bf16* O; int ldc;
    __device__ __forceinline__ void operator()(const f32x4 (&acc)[2][2][4][2], const Unit& u, int wr, int wc, int fr, int fq) const {
        const int row0 = u.pm * BM + wr * 64 + fr; const int col0 = u.pn * BM + wc * 32 + 8 * fq;
#pragma unroll
        for (int ai = 0; ai < 2; ++ai)
#pragma unroll
            for (int m = 0; m < 4; ++m) { bf16* rowp = O + (size_t)(row0 + ai * HALF + m * 16) * ldc + col0;
#pragma unroll
                for (int bj = 0; bj < 2; ++bj) { const f32x4 v0 = acc[ai][bj][m][0], v1 = acc[ai][bj][m][1];
                    v4u w; w.x = pk2(v0[0], v0[1]); w.y = pk2(v0[2], v0[3]); w.z = pk2(v1[0], v1[1]); w.w = pk2(v1[2], v1[3]);
                    *(v4u*)(rowp + bj * HALF) = w; } }
    }
};
struct EpiRes {
    static constexpr bool PERM = false;
    const float* x; float* out; const float* mod;
    __device__ __forceinline__ void operator()(const f32x4 (&acc)[2][2][4][2], const Unit& u, int wr, int wc, int fr, int fq) const {
        const int row0 = u.pm * BM + wr * 64 + fr, col0 = u.pn * BM + wc * 32 + 4 * fq; const int b = u.pm >> 5;
        f32x4 gv[2][2];
#pragma unroll
        for (int bj = 0; bj < 2; ++bj)
#pragma unroll
            for (int n = 0; n < 2; ++n) gv[bj][n] = *(const f32x4*)(mod + b * 6144 + 2048 + col0 + bj * HALF + n * 16);
#pragma unroll
        for (int ai = 0; ai < 2; ++ai)
#pragma unroll
            for (int m = 0; m < 4; ++m) { const size_t off = (size_t)(row0 + ai * HALF + m * 16) * D + col0;
#pragma unroll
                for (int bj = 0; bj < 2; ++bj)
#pragma unroll
                    for (int n = 0; n < 2; ++n) { const f32x4 xv = *(const f32x4*)(x + off + bj * HALF + n * 16);
                        *(f32x4*)(out + off + bj * HALF + n * 16) = xv + gv[bj][n] * acc[ai][bj][m][n]; } }
    }
};

template <class Epi, bool ALIGN_EPI = true>
__device__ __forceinline__ void gemm_phase(LAS unsigned char* lds, const Gemm g, const StaticOrder& S, const Epi& E) {
    const int tid = threadIdx.x, wid = __builtin_amdgcn_readfirstlane(tid >> 6), lane = tid & 63, wr = wid >> 2, wc = wid & 3, fr = lane & 15, fq = lane >> 4;
    const int K = g.K, nt = K / BK;
    unsigned voffA[2], voffB[2];
#pragma unroll
    for (int i = 0; i < 2; ++i) { int R, C; stage_rc(tid * 16 + i * 8192, R, C); const int Rb = Epi::PERM ? ((R & ~31) + perm32(R & 31)) : R;
        voffA[i] = (unsigned)(R * K + C) * 2u; voffB[i] = (unsigned)(Rb * K + C) * 2u; }
    const size_t kstep = (size_t)(BK * 2);
    const size_t hstep = (size_t)HALF * K * 2;
    const size_t tstep = 2 * hstep;
    const unsigned ldsw = (unsigned)wid * 1024u;
    const int aoff = lds_byte(wr * 64 + fr, fq * 8), boff = lds_byte(wc * 32 + fr, fq * 8);
#define PG8_SA(b, h) (((b) * 2 + (h)) * HTB)
#define PG8_SB(b, h) ((4 + (b) * 2 + (h)) * HTB)
#define PG8_STAGE(bufoff, gbase, voff) do { _Pragma("unroll") for (int _i = 0; _i < 2; ++_i) \
        __builtin_amdgcn_global_load_lds((const unsigned*)((const char*)(gbase) + (voff)[_i]), (LAS unsigned*)(lds + (bufoff) + ldsw + _i * 8192), 16, 0, 0); } while (0)
#define PG8_LDA(dst, b, h) do { _Pragma("unroll") for (int m = 0; m < 4; ++m) _Pragma("unroll") for (int k = 0; k < 2; ++k) dst[m][k] = *(const LAS bf16x8*)(lds + PG8_SA(b, h) + aoff + m * 2048 + k * 1024); } while (0)
#define PG8_LDB(dst, b, h) do { _Pragma("unroll") for (int n = 0; n < 2; ++n) _Pragma("unroll") for (int k = 0; k < 2; ++k) dst[n][k] = *(const LAS bf16x8*)(lds + PG8_SB(b, h) + boff + n * 2048 + k * 1024); } while (0)
#define PG8_MMA(ai, bj, At, Bt) do { __builtin_amdgcn_s_setprio(1); _Pragma("unroll") for (int m = 0; m < 4; ++m) _Pragma("unroll") for (int n = 0; n < 2; ++n) _Pragma("unroll") for (int k = 0; k < 2; ++k) \
        acc[ai][bj][m][n] = __builtin_amdgcn_mfma_f32_16x16x32_bf16(Bt[n][k], At[m][k], acc[ai][bj][m][n], 0, 0, 0); __builtin_amdgcn_s_setprio(0); } while (0)
#define PG8_WAIT_V(n) asm volatile("s_waitcnt vmcnt(" #n ")" ::: "memory")
#define PG8_WAIT_L(n) asm volatile("s_waitcnt lgkmcnt(" #n ")" ::: "memory")
#define PG8_BAR __builtin_amdgcn_s_barrier()
#define PG8_SCHED __builtin_amdgcn_sched_barrier(0)
    Unit cur, nxt; int ui = 0;
    if (!S.next(0, cur)) return;
    f32x4 acc[2][2][4][2];
#pragma unroll
    for (int a = 0; a < 2; ++a)
#pragma unroll
        for (int b = 0; b < 2; ++b)
#pragma unroll
            for (int m = 0; m < 4; ++m)
#pragma unroll
                for (int n = 0; n < 2; ++n) acc[a][b][m][n] = (f32x4){0.f, 0.f, 0.f, 0.f};
    bf16x8 At[4][2], B0[2][2], B1[2][2];
    const char* cA = (const char*)g.A + (size_t)cur.pm * tstep; const char* cB = (const char*)g.Bt + (size_t)cur.pn * tstep;
    PG8_STAGE(PG8_SB(0, 0), cB, voffB); PG8_STAGE(PG8_SB(0, 1), cB + hstep, voffB); PG8_STAGE(PG8_SA(0, 0), cA, voffA); PG8_STAGE(PG8_SA(0, 1), cA + hstep, voffA);
    if (wr == 1) PG8_BAR;
    PG8_WAIT_V(2); PG8_BAR;
    PG8_STAGE(PG8_SB(1, 0), cB + kstep, voffB); PG8_STAGE(PG8_SA(1, 0), cA + kstep, voffA); PG8_STAGE(PG8_SB(1, 1), cB + hstep + kstep, voffB);
    PG8_WAIT_V(6); PG8_BAR;
    for (;;) {
        const bool has_next = S.next(ui + 1, nxt);
        const char* nA = has_next ? (const char*)g.A + (size_t)nxt.pm * tstep : cA; const char* nB = has_next ? (const char*)g.Bt + (size_t)nxt.pn * tstep : cB;
        for (int t = 0; t < nt; t += 2) {
            const bool last = (t == nt - 2);
            const char* a1 = cA + (size_t)(t + 1) * kstep;
            const char* a2 = last ? nA : cA + (size_t)(t + 2) * kstep; const char* b2 = last ? nB : cB + (size_t)(t + 2) * kstep;
            const char* a3 = a2 + kstep; const char* b3 = b2 + kstep;
            PG8_LDB(B0, 0, 0); PG8_LDB(B1, 0, 1); PG8_SCHED; PG8_LDA(At, 0, 0); PG8_STAGE(PG8_SA(1, 1), a1 + hstep, voffA);
            PG8_WAIT_V(8); PG8_WAIT_L(0); PG8_BAR; PG8_MMA(0, 0, At, B0); PG8_MMA(0, 1, At, B1); PG8_BAR; PG8_SCHED;
            PG8_LDA(At, 0, 1); PG8_STAGE(PG8_SB(0, 0), b2, voffB); PG8_STAGE(PG8_SB(0, 1), b2 + hstep, voffB); PG8_STAGE(PG8_SA(0, 0), a2, voffA);
            PG8_WAIT_V(8); PG8_WAIT_L(0); PG8_BAR; PG8_MMA(1, 0, At, B0); PG8_MMA(1, 1, At, B1); PG8_BAR; PG8_SCHED;
            PG8_LDB(B0, 1, 0); PG8_LDB(B1, 1, 1); PG8_SCHED; PG8_LDA(At, 1, 0); PG8_STAGE(PG8_SA(0, 1), a2 + hstep, voffA);
            PG8_WAIT_V(8); PG8_WAIT_L(0); PG8_BAR; PG8_MMA(0, 0, At, B0); PG8_MMA(0, 1, At, B1); PG8_BAR; PG8_SCHED;
            PG8_LDA(At, 1, 1); PG8_STAGE(PG8_SB(1, 0), b3, voffB); PG8_STAGE(PG8_SB(1, 1), b3 + hstep, voffB); PG8_STAGE(PG8_SA(1, 0), a3, voffA);
            PG8_WAIT_V(8); PG8_WAIT_L(0); PG8_BAR; PG8_MMA(1, 0, At, B0); PG8_MMA(1, 1, At, B1); PG8_BAR; PG8_SCHED;
        }
        if constexpr (ALIGN_EPI) { if (wr == 0) PG8_BAR; }
        E(acc, cur, wr, wc, fr, fq);
        if (!has_next) break;
#pragma unroll
        for (int a = 0; a < 2; ++a)
#pragma unroll
            for (int b = 0; b < 2; ++b)
#pragma unroll
                for (int m = 0; m < 4; ++m)
#pragma unroll
                    for (int n = 0; n < 2; ++n) acc[a][b][m][n] = (f32x4){0.f, 0.f, 0.f, 0.f};
        cur = nxt; cA = nA; cB = nB; ++ui;
        if constexpr (ALIGN_EPI) { if (wr == 1) PG8_BAR; }
    }
    PG8_WAIT_V(0);
    if constexpr (!ALIGN_EPI) { if (wr == 0) PG8_BAR; }
    PG8_BAR;
#undef PG8_SA
#undef PG8_SB
#undef PG8_STAGE
#undef PG8_LDA
#undef PG8_LDB
#undef PG8_MMA
#undef PG8_WAIT_V
#undef PG8_WAIT_L
#undef PG8_BAR
#undef PG8_SCHED
}
}

struct Args { const float* in[17]; float* out; unsigned char* ws; int ph_lo, ph_hi; };
struct Ctx {
    LAS unsigned char* lds; int tid, lane, wave, G, bid;
    const float *x, *c, *w_ada, *b_ada, *norm1_w, *w_in, *lb_logits, *hgrn_onorm_w, *conv_w, *conv_onorm_w, *w_out, *norm2_w, *w_query, *sub_keys, *peer_u, *peer_v, *final_w;
    float* out; float *ACH, *MOD, *LB;
    bf16 *WIN, *WOUT, *WQ, *KEYS, *H1, *YCAT, *PROJ, *H2, *QP, *ST; unsigned char *U8, *V8; float *SU, *SV;
};

__device__ __forceinline__ void p0_transpose_item(const float* W, int K, int N, bf16* WT, LAS float* scr, int item, int lane) {
    const int nblk = N / 32, kb = item / nblk, nb = item % nblk, k0 = 64 * kb, n0 = 32 * nb;
#pragma unroll 8
    for (int i = 0; i < 32; ++i) { const int kk = 2 * i + (lane >> 5); scr[kk * 33 + (lane & 31)] = W[(size_t)(k0 + kk) * N + n0 + (lane & 31)]; }
    asm volatile("s_waitcnt lgkmcnt(0)" ::: "memory"); __builtin_amdgcn_wave_barrier();
    const int c = lane & 7;
#pragma unroll
    for (int j = 0; j < 4; ++j) { const int n = (lane >> 3) + 8 * j; const LAS float* s = scr + (8 * c) * 33 + n;
        v4u o; o.x = pk2(s[0 * 33], s[1 * 33]); o.y = pk2(s[2 * 33], s[3 * 33]); o.z = pk2(s[4 * 33], s[5 * 33]); o.w = pk2(s[6 * 33], s[7 * 33]);
        *(v4u*)(WT + (size_t)(n0 + n) * K + k0 + 8 * c) = o; }
    asm volatile("s_waitcnt lgkmcnt(0)" ::: "memory"); __builtin_amdgcn_wave_barrier();
}
__device__ __forceinline__ void cvt_stream(const float* src, bf16* dst, size_t n8, size_t gtid, size_t gstride) {
    for (size_t i = gtid; i < n8; i += gstride) {
        const f32x4 a = *(const f32x4*)(src + i * 8), b = *(const f32x4*)(src + i * 8 + 4);
        v4u o; o.x = pk2(a[0], a[1]); o.y = pk2(a[2], a[3]); o.z = pk2(b[0], b[1]); o.w = pk2(b[2], b[3]);
        *(v4u*)(dst + i * 8) = o;
    }
}

__device__ __forceinline__ void p0_prep(Ctx& F) {
    {
        LAS float* sc = (LAS float*)(F.lds);
        LAS float* part = (LAS float*)(F.lds + 8192);
        for (int u = F.bid; u < 96; u += F.G) {
            for (int i = F.tid; i < 2048; i += NTHR) { const float v = F.c[i]; sc[i] = v / (1.f + __expf(-v)); }
            __syncthreads();
            const int cgp = F.tid & 15, kg = F.tid >> 4, n0 = 64 * u + 4 * cgp;
            f32x4 a0 = {0.f, 0.f, 0.f, 0.f}, a1 = {0.f, 0.f, 0.f, 0.f};
#pragma unroll 4
            for (int k = kg; k < 1024; k += 32) { const f32x4 w = *(const f32x4*)(F.w_ada + (size_t)k * 6144 + n0); a0 += w * sc[k]; a1 += w * sc[1024 + k]; }
            *(LAS f32x4*)(part + (kg * 2 + 0) * 64 + 4 * cgp) = a0; *(LAS f32x4*)(part + (kg * 2 + 1) * 64 + 4 * cgp) = a1;
            __syncthreads();
            if (F.tid < 128) { const int b = F.tid >> 6, col = F.tid & 63; float s = F.b_ada[64 * u + col];
#pragma unroll 8
                for (int q = 0; q < 32; ++q) s += part[(q * 2 + b) * 64 + col];
                F.MOD[b * 6144 + 64 * u + col] = s; }
            __syncthreads();
        }
    }
    if (F.bid == (F.G > 100 ? 100 : 0)) { const float l0 = F.lb_logits[F.tid], l1 = F.lb_logits[512 + F.tid]; F.LB[F.tid] = 1.f / (1.f + __expf(l1 - l0)); }
    {
        LAS float* scr = (LAS float*)(F.lds + 32768 + F.wave * 12288);
        const int gw = F.bid * NWAVES + F.wave, NGW = F.G * NWAVES;
        constexpr int I_IN = (D / 64) * (NIN / 32), I_OUT = (D / 64) * (D / 32), I_Q = (D / 64) * (NQ / 32);
        for (int it = gw; it < I_IN + I_OUT + I_Q; it += NGW) {
            int r = it;
            if (r < I_IN) { p0_transpose_item(F.w_in, D, NIN, F.WIN, scr, r, F.lane); continue; } r -= I_IN;
            if (r < I_OUT) { p0_transpose_item(F.w_out, D, D, F.WOUT, scr, r, F.lane); continue; } r -= I_OUT;
            p0_transpose_item(F.w_query, D, NQ, F.WQ, scr, r, F.lane);
        }
    }
    {
        const size_t gtid = (size_t)F.bid * NTHR + F.tid, gs = (size_t)F.G * NTHR;
        cvt_stream(F.sub_keys, F.KEYS, (size_t)16 * 128 * 128 / 8, gtid, gs);
    }
    {
        const int gw = F.bid * NWAVES + F.wave, NGW = F.G * NWAVES;
        for (int r = gw; r < 32768; r += NGW) {
            const bool isv = r >= 16384; const int e = r & 16383;
            const float* srow = (isv ? F.peer_v : F.peer_u) + (size_t)e * D;
            f32x4 v[4]; float am = 0.f;
#pragma unroll
            for (int j = 0; j < 4; ++j) { v[j] = *(const f32x4*)(srow + 4 * F.lane + 256 * j);
                am = fmaxf(am, fmaxf(fmaxf(fabsf(v[j].x), fabsf(v[j].y)), fmaxf(fabsf(v[j].z), fabsf(v[j].w)))); }
#pragma unroll
            for (int o = 1; o < 64; o <<= 1) am = fmaxf(am, __shfl_xor(am, o));
            const float inv = am > 0.f ? 127.f / am : 0.f; const int off = isv ? 128 : 0;
            unsigned* drow = (unsigned*)((isv ? F.V8 : F.U8) + (size_t)e * D);
#pragma unroll
            for (int j = 0; j < 4; ++j) {
                const int q0 = (int)rintf(v[j].x * inv) + off, q1 = (int)rintf(v[j].y * inv) + off, q2 = (int)rintf(v[j].z * inv) + off, q3 = (int)rintf(v[j].w * inv) + off;
                drow[F.lane + 64 * j] = (unsigned)(q0 & 255) | ((unsigned)(q1 & 255) << 8) | ((unsigned)(q2 & 255) << 16) | ((unsigned)(q3 & 255) << 24); }
            if (F.lane == 0) (isv ? F.SV : F.SU)[e] = am * (1.f / 127.f);
        }
    }
}

__device__ __forceinline__ void modnorm_row(const float* xrow, const float* w, const float* shift, const float* scale, bf16* orow, int lane) {
    f32x4 v[4]; float s = 0.f;
#pragma unroll
    for (int j = 0; j < 4; ++j) { v[j] = *(const f32x4*)(xrow + 4 * lane + 256 * j); s += (v[j].x * v[j].x + v[j].y * v[j].y) + (v[j].z * v[j].z + v[j].w * v[j].w); }
    const float rstd = 1.f / sqrtf(wave_sum(s) * (1.f / D) + EPS);
#pragma unroll
    for (int j = 0; j < 4; ++j) { const int col = 4 * lane + 256 * j;
        const f32x4 wv = *(const f32x4*)(w + col), sh = *(const f32x4*)(shift + col), sc = *(const f32x4*)(scale + col);
        const f32x4 y = v[j] * rstd * wv * (sc + 1.f) + sh;
        v2u o; o.x = pk2(y.x, y.y); o.y = pk2(y.z, y.w); *(v2u*)(orow + col) = o; }
}

__device__ __forceinline__ void p3_local(Ctx& F) {
    LAS unsigned char* KT = F.lds;
    LAS unsigned char* VT = F.lds + 18432;
    LAS float* QT = (LAS float*)(F.lds + 36864);
    LAS unsigned char* OUT = F.lds + 38912;
    const int tid = F.tid, lane = F.lane, wave = F.wave, fr = lane & 15, fq = lane >> 4;
    for (int u = F.bid; u < 1024; u += F.G) {
        const int bh = u >> 7, c = u & 127, b = bh >> 2, hh = bh & 3;
        const size_t r0 = (size_t)b * SEQ + (size_t)c * 64;
        const int d = tid & 127, tq = tid >> 7;
        const bf16* pf = F.PROJ + (r0 + 16 * tq) * NIN + 512 + hh * 128 + d;
        const bf16* pv = F.PROJ + (r0 + 16 * tq) * NIN + 1024 + hh * 128 + d;
        const float lbv = F.LB[hh * 128 + d], oml = 1.f - lbv;
        unsigned short fraw[16], vraw[16];
#pragma unroll
        for (int j = 0; j < 16; ++j) { fraw[j] = pf[(size_t)j * NIN]; vraw[j] = pv[(size_t)j * NIN]; }
        float cs[16], kk[16]; float run = 0.f;
#pragma unroll
        for (int j = 0; j < 16; ++j) { const float fv = bf2f(fraw[j]); const float e = __expf(-fv); const float sg = 1.f / (1.f + e);
            const float f = lbv + oml * sg; run += __logf(f); cs[j] = run; kk[j] = oml * (e * sg); }
        QT[tq * 128 + d] = run;
        __syncthreads();
        float prefix = 0.f, total = 0.f;
#pragma unroll
        for (int q = 0; q < 4; ++q) { const float t = QT[q * 128 + d]; total += t; if (q < tq) prefix += t; }
        unsigned kp[8], vp[8];
#pragma unroll
        for (int j = 0; j < 8; ++j) { const float k0 = kk[2 * j] * __expf(total - (prefix + cs[2 * j])), k1 = kk[2 * j + 1] * __expf(total - (prefix + cs[2 * j + 1]));
            kp[j] = pk2(k0, k1); vp[j] = (unsigned)vraw[2 * j] | ((unsigned)vraw[2 * j + 1] << 16); }
        *(LAS v4u*)(KT + d * 144 + tq * 32) = (v4u){kp[0], kp[1], kp[2], kp[3]}; *(LAS v4u*)(KT + d * 144 + tq * 32 + 16) = (v4u){kp[4], kp[5], kp[6], kp[7]};
        *(LAS v4u*)(VT + d * 144 + tq * 32) = (v4u){vp[0], vp[1], vp[2], vp[3]}; *(LAS v4u*)(VT + d * 144 + tq * 32 + 16) = (v4u){vp[4], vp[5], vp[6], vp[7]};
        if (tq == 0) F.ACH[u * 128 + d] = __expf(total);
        __syncthreads();
        {
            const int dblk = wave & 3, vh = wave >> 2;
            f32x4 acc[2][4];
#pragma unroll
            for (int a = 0; a < 2; ++a)
#pragma unroll
                for (int n = 0; n < 4; ++n) acc[a][n] = (f32x4){0.f, 0.f, 0.f, 0.f};
#pragma unroll
            for (int k2 = 0; k2 < 2; ++k2) {
                bf16x8 af[2], bfv[4];
#pragma unroll
                for (int a = 0; a < 2; ++a) af[a] = *(const LAS bf16x8*)(KT + (dblk * 32 + a * 16 + fr) * 144 + (k2 * 32 + fq * 8) * 2);
#pragma unroll
                for (int n = 0; n < 4; ++n) bfv[n] = *(const LAS bf16x8*)(VT + (vh * 64 + n * 16 + fr) * 144 + (k2 * 32 + fq * 8) * 2);
#pragma unroll
                for (int a = 0; a < 2; ++a)
#pragma unroll
                    for (int n = 0; n < 4; ++n) acc[a][n] = __builtin_amdgcn_mfma_f32_16x16x32_bf16(af[a], bfv[n], acc[a][n], 0, 0, 0);
            }
#pragma unroll
            for (int a = 0; a < 2; ++a)
#pragma unroll
                for (int n = 0; n < 4; ++n) { const int v = vh * 64 + n * 16 + fr, dd = dblk * 32 + a * 16 + 4 * fq;
                    *(LAS v2u*)(OUT + v * 272 + dd * 2) = (v2u){pk2(acc[a][n][0], acc[a][n][1]), pk2(acc[a][n][2], acc[a][n][3])}; }
        }
        __syncthreads();
        { const int row = tid >> 2, part = tid & 3; bf16* dst = F.ST + (size_t)u * 16384 + row * 128 + part * 32;
#pragma unroll
            for (int i = 0; i < 4; ++i) *(v4u*)(dst + i * 8) = *(const LAS v4u*)(OUT + row * 272 + part * 64 + i * 16); }
        __syncthreads();
    }
    {
        const int gw = F.bid * NWAVES + F.wave, NGW = F.G * NWAVES;
        const int ch = lane * 8;
        float w0[8], w1[8], w2[8], ow[8];
#pragma unroll
        for (int j = 0; j < 8; ++j) { w0[j] = F.conv_w[ch + j]; w1[j] = F.conv_w[512 + ch + j]; w2[j] = F.conv_w[1024 + ch + j]; ow[j] = F.conv_onorm_w[ch + j]; }
        for (int run = gw; run < M / 8; run += NGW) {
            const int rbase = run * 8;
            float u1[8], u2[8];
#pragma unroll
            for (int j = 0; j < 8; ++j) { u1[j] = 0.f; u2[j] = 0.f; }
            const int tpos = rbase & (SEQ - 1);
            if (tpos >= 1) { const bf16* p = F.PROJ + (size_t)(rbase - 1) * NIN + 2048 + ch; const v4u cc = *(const v4u*)(p + 512), xx = *(const v4u*)(p + 1024);
#pragma unroll
                for (int j = 0; j < 4; ++j) { const unsigned cw = cc[j], xw = xx[j]; u1[2 * j] = bf2f(cw & 0xffffu) * bf2f(xw & 0xffffu); u1[2 * j + 1] = bf2f(cw >> 16) * bf2f(xw >> 16); } }
            if (tpos >= 2) { const bf16* p = F.PROJ + (size_t)(rbase - 2) * NIN + 2048 + ch; const v4u cc = *(const v4u*)(p + 512), xx = *(const v4u*)(p + 1024);
#pragma unroll
                for (int j = 0; j < 4; ++j) { const unsigned cw = cc[j], xw = xx[j]; u2[2 * j] = bf2f(cw & 0xffffu) * bf2f(xw & 0xffffu); u2[2 * j + 1] = bf2f(cw >> 16) * bf2f(xw >> 16); } }
            for (int t = 0; t < 8; ++t) {
                const bf16* p = F.PROJ + (size_t)(rbase + t) * NIN + 2048 + ch;
                const v4u bb = *(const v4u*)(p), cc = *(const v4u*)(p + 512), xx = *(const v4u*)(p + 1024);
                float u0[8], y[8]; float ss = 0.f;
#pragma unroll
                for (int j = 0; j < 4; ++j) { const unsigned cw = cc[j], xw = xx[j]; u0[2 * j] = bf2f(cw & 0xffffu) * bf2f(xw & 0xffffu); u0[2 * j + 1] = bf2f(cw >> 16) * bf2f(xw >> 16); }
#pragma unroll
                for (int j = 0; j < 8; ++j) { const float bg = bf2f((j & 1) ? (bb[j >> 1] >> 16) : (bb[j >> 1] & 0xffffu));
                    y[j] = bg * (w0[j] * u2[j] + w1[j] * u1[j] + w2[j] * u0[j]); ss += y[j] * y[j]; }
                ss += __shfl_xor(ss, 1); ss += __shfl_xor(ss, 2); ss += __shfl_xor(ss, 4); ss += __shfl_xor(ss, 8);
                const float rstd = 1.f / sqrtf(ss * (1.f / 128.f) + EPS);
                v4u o; o.x = pk2(y[0] * rstd * ow[0], y[1] * rstd * ow[1]); o.y = pk2(y[2] * rstd * ow[2], y[3] * rstd * ow[3]);
                o.z = pk2(y[4] * rstd * ow[4], y[5] * rstd * ow[5]); o.w = pk2(y[6] * rstd * ow[6], y[7] * rstd * ow[7]);
                *(v4u*)(F.YCAT + (size_t)(rbase + t) * D + 512 + ch) = o;
#pragma unroll
                for (int j = 0; j < 8; ++j) { u2[j] = u1[j]; u1[j] = u0[j]; }
            }
        }
    }
}

__device__ __forceinline__ void p4_scan(Ctx& F) {
    const int gtid = F.bid * NTHR + F.tid;
    if (gtid >= 65536) return;
    const int bh = gtid >> 13, e2 = gtid & 8191, v = e2 >> 6, d = (e2 & 63) * 2;
    unsigned* p = (unsigned*)(F.ST + (size_t)bh * 128 * 16384 + v * 128 + d);
    const float* a = F.ACH + (size_t)bh * 128 * 128 + d;
    float s0 = 0.f, s1 = 0.f;
#pragma unroll 8
    for (int c = 0; c < 128; ++c) {
        const unsigned uu = p[(size_t)c * 8192]; const float a0 = a[c * 128], a1 = a[c * 128 + 1];
        p[(size_t)c * 8192] = pk2(s0, s1);
        s0 = a0 * s0 + bf2f(uu & 0xffffu); s1 = a1 * s1 + bf2f(uu >> 16);
    }
}

__device__ __forceinline__ void p5_out(Ctx& F) {
    LAS unsigned char* QM = F.lds;
    LAS unsigned char* Q0 = F.lds + 17408;
    LAS unsigned char* KM = F.lds + 34816;
    LAS unsigned char* VT = F.lds + 52224;
    LAS unsigned char* STL = F.lds + 70656;
    LAS float* QT = (LAS float*)(F.lds + 105472);
    LAS unsigned char* PB = F.lds + 107520;
    LAS float* NRM = (LAS float*)(F.lds + 125952);
    const int tid = F.tid, lane = F.lane, wave = F.wave, fr = lane & 15, fq = lane >> 4;
    for (int u = F.bid; u < 1024; u += F.G) {
        const int bh = u >> 7, c = u & 127, b = bh >> 2, hh = bh & 3;
        const size_t r0 = (size_t)b * SEQ + (size_t)c * 64;
        const int d = tid & 127, tq = tid >> 7;
        const bf16* pq = F.PROJ + (r0 + 16 * tq) * NIN + hh * 128 + d;
        const float lbv = F.LB[hh * 128 + d], oml = 1.f - lbv;
        unsigned short qraw[16], fraw[16], vraw[16];
#pragma unroll
        for (int j = 0; j < 16; ++j) { qraw[j] = pq[(size_t)j * NIN]; fraw[j] = pq[(size_t)j * NIN + 512]; vraw[j] = pq[(size_t)j * NIN + 1024]; }
        {
            const bf16* src = F.ST + (size_t)u * 16384;
#pragma unroll
            for (int i = 0; i < 4; ++i) { const int row = (tid >> 4) + 32 * i, ck = tid & 15; *(LAS v4u*)(STL + row * 272 + ck * 16) = *(const v4u*)(src + row * 128 + ck * 8); }
        }
        float cs[16], kk[16]; float run = 0.f;
#pragma unroll
        for (int j = 0; j < 16; ++j) { const float fv = bf2f(fraw[j]); const float e = __expf(-fv); const float sg = 1.f / (1.f + e);
            const float f = lbv + oml * sg; run += __logf(f); cs[j] = run; kk[j] = oml * (e * sg); }
        QT[tq * 128 + d] = run;
        __syncthreads();
        float prefix = 0.f; const float q0t = QT[d], q1t = QT[128 + d], q2t = QT[256 + d];
        if (tq >= 1) prefix += q0t; if (tq >= 2) prefix += q1t; if (tq >= 3) prefix += q2t;
        const float bmid = q0t + q1t;
        unsigned vp[8];
#pragma unroll
        for (int j = 0; j < 16; ++j) { const float bj = prefix + cs[j]; const float qv = bf2f(qraw[j]); const int t = 16 * tq + j;
            *(LAS unsigned short*)(QM + t * 272 + d * 2) = (unsigned short)f2bf(qv * __expf(bj - bmid));
            *(LAS unsigned short*)(Q0 + t * 272 + d * 2) = (unsigned short)f2bf(qv * __expf(bj));
            *(LAS unsigned short*)(KM + t * 272 + d * 2) = (unsigned short)f2bf(kk[j] * __expf(bmid - bj)); }
#pragma unroll
        for (int j = 0; j < 8; ++j) vp[j] = (unsigned)vraw[2 * j] | ((unsigned)vraw[2 * j + 1] << 16);
        *(LAS v4u*)(VT + d * 144 + tq * 32) = (v4u){vp[0], vp[1], vp[2], vp[3]}; *(LAS v4u*)(VT + d * 144 + tq * 32 + 16) = (v4u){vp[4], vp[5], vp[6], vp[7]};
        __syncthreads();
        const int rb = wave >> 1, vh = wave & 1;
        LAS unsigned char* P = PB + wave * 2304;
        {
            f32x4 sc[4];
#pragma unroll
            for (int sf = 0; sf < 4; ++sf) sc[sf] = (f32x4){0.f, 0.f, 0.f, 0.f};
#pragma unroll
            for (int k4 = 0; k4 < 4; ++k4) {
                const bf16x8 bq = *(const LAS bf16x8*)(QM + (16 * rb + fr) * 272 + (k4 * 32 + fq * 8) * 2);
#pragma unroll
                for (int sf = 0; sf < 4; ++sf) { const bf16x8 ak = *(const LAS bf16x8*)(KM + (16 * sf + fr) * 272 + (k4 * 32 + fq * 8) * 2);
                    sc[sf] = __builtin_amdgcn_mfma_f32_16x16x32_bf16(ak, bq, sc[sf], 0, 0, 0); }
            }
            const int t = 16 * rb + fr;
#pragma unroll
            for (int sf = 0; sf < 4; ++sf) { const int s0 = 16 * sf + 4 * fq;
                const float p0 = (s0 + 0 <= t) ? sc[sf][0] : 0.f, p1 = (s0 + 1 <= t) ? sc[sf][1] : 0.f, p2 = (s0 + 2 <= t) ? sc[sf][2] : 0.f, p3 = (s0 + 3 <= t) ? sc[sf][3] : 0.f;
                *(LAS v2u*)(P + fr * 144 + s0 * 2) = (v2u){pk2(p0, p1), pk2(p2, p3)}; }
        }
        __syncthreads();
        f32x4 oc[4];
#pragma unroll
        for (int n = 0; n < 4; ++n) oc[n] = (f32x4){0.f, 0.f, 0.f, 0.f};
#pragma unroll
        for (int k2 = 0; k2 < 2; ++k2) {
            const bf16x8 bp = *(const LAS bf16x8*)(P + fr * 144 + (k2 * 32 + fq * 8) * 2);
#pragma unroll
            for (int n = 0; n < 4; ++n) { const bf16x8 av = *(const LAS bf16x8*)(VT + (64 * vh + 16 * n + fr) * 144 + (k2 * 32 + fq * 8) * 2);
                oc[n] = __builtin_amdgcn_mfma_f32_16x16x32_bf16(av, bp, oc[n], 0, 0, 0); }
        }
#pragma unroll
        for (int k4 = 0; k4 < 4; ++k4) {
            const bf16x8 bq = *(const LAS bf16x8*)(Q0 + (16 * rb + fr) * 272 + (k4 * 32 + fq * 8) * 2);
#pragma unroll
            for (int n = 0; n < 4; ++n) { const bf16x8 as = *(const LAS bf16x8*)(STL + (64 * vh + 16 * n + fr) * 272 + (k4 * 32 + fq * 8) * 2);
                oc[n] = __builtin_amdgcn_mfma_f32_16x16x32_bf16(as, bq, oc[n], 0, 0, 0); }
        }
        float ss = 0.f;
#pragma unroll
        for (int n = 0; n < 4; ++n) ss += (oc[n][0] * oc[n][0] + oc[n][1] * oc[n][1]) + (oc[n][2] * oc[n][2] + oc[n][3] * oc[n][3]);
        ss += __shfl_xor(ss, 16); ss += __shfl_xor(ss, 32);
        if (fq == 0) NRM[(16 * rb + fr) * 2 + vh] = ss;
        __syncthreads();
        {
            const int t = 16 * rb + fr; const float tot = NRM[t * 2] + NRM[t * 2 + 1];
            const float rstd = 1.f / sqrtf(tot * (1.f / 128.f) + EPS);
            const bf16* pg = F.PROJ + (r0 + t) * NIN + 1536 + hh * 128;
            bf16* po = F.YCAT + (r0 + t) * D + hh * 128;
#pragma unroll
            for (int n = 0; n < 4; ++n) { const int v = 64 * vh + 16 * n + 4 * fq;
                const v2u gw = *(const v2u*)(pg + v); const f32x4 wv = *(const f32x4*)(F.hgrn_onorm_w + hh * 128 + v);
                float g[4] = {bf2f(gw.x & 0xffffu), bf2f(gw.x >> 16), bf2f(gw.y & 0xffffu), bf2f(gw.y >> 16)}; float o[4];
#pragma unroll
                for (int j = 0; j < 4; ++j) { const float sl = g[j] / (1.f + __expf(-g[j])); o[j] = oc[n][j] * rstd * wv[j] * sl; }
                *(v2u*)(po + v) = (v2u){pk2(o[0], o[1]), pk2(o[2], o[3])}; }
        }
        __syncthreads();
    }
}

__device__ __forceinline__ unsigned f2ord(float f) { const unsigned u = __float_as_uint(f); return (u & 0x80000000u) ? ~u : (u | 0x80000000u); }
__device__ __forceinline__ float ord2f(unsigned o) { return __uint_as_float((o & 0x80000000u) ? (o & 0x7fffffffu) : ~o); }
__device__ __forceinline__ void ce_desc(unsigned& a, unsigned& b) { const unsigned mx = a > b ? a : b, mn = a > b ? b : a; a = mx; b = mn; }
template <int N> __device__ __forceinline__ void bitonic_sort_desc(unsigned (&k)[N]) {
#pragma unroll
    for (int size = 2; size <= N; size <<= 1) {
#pragma unroll
        for (int stride = size >> 1; stride > 0; stride >>= 1) {
#pragma unroll
            for (int i = 0; i < N; ++i) { const int j = i ^ stride; if (j > i) { if ((i & size) == 0) ce_desc(k[i], k[j]); else ce_desc(k[j], k[i]); } }
        }
    }
}
__device__ __forceinline__ void bitonic_merge16_desc(unsigned (&k)[16]) {
#pragma unroll
    for (int stride = 8; stride > 0; stride >>= 1) {
#pragma unroll
        for (int i = 0; i < 16; ++i) { const int j = i ^ stride; if (j > i) ce_desc(k[i], k[j]); }
    }
}
__device__ __forceinline__ void merge_top16(unsigned (&a)[16], const unsigned (&b)[16]) {
#pragma unroll
    for (int i = 0; i < 16; ++i) a[i] = a[i] > b[15 - i] ? a[i] : b[15 - i];
    bitonic_merge16_desc(a);
}
__device__ __forceinline__ float gelu_as(float v) {
    const float av = fabsf(v), t = __builtin_amdgcn_rcpf(av * 0.2316418882f + 1.0f);
    float q = t * 0.5307027145f + (-0.7265760135f); q = q * t + 0.7107068705f; q = q * t + (-0.142248368f); q = q * t + 0.127414796f; q = q * t;
    const float e = __builtin_amdgcn_exp2f((v * v) * (-0.72134752044f));
    const float m = v * (q * e);
    return v < 0.f ? m : v - m;
}
__device__ __forceinline__ float gelu_erf(float x) { return 0.5f * x * (1.f + erff(x * 0.70710678118654752f)); }

__device__ __forceinline__ void p9_peer(Ctx& F) {
    LAS unsigned* TOP = (LAS unsigned*)F.lds;
    LAS v2u* IDXS = (LAS v2u*)(F.lds + 65536);
    LAS v4u* CNT = (LAS v4u*)(F.lds + 131072);
    LAS unsigned char* OFFS = F.lds + 139264;
    LAS float* SH = (LAS float*)(F.lds + 141312);
    LAS unsigned char* HQ = F.lds;
    const int tid = F.tid, lane = F.lane, wave = F.wave, fr = lane & 15, fq = lane >> 4;
    for (int tile = F.bid; tile < M / 64; tile += F.G) {
        const size_t r0 = (size_t)tile * 64;
        for (int rep9 = 0; rep9 < NREP(9); ++rep9) {
            const int p = wave >> 2, tb = wave & 3;
            for (int h = 0; h < 8; ++h) {
                f32x4 sc[8];
#pragma unroll
                for (int nf = 0; nf < 8; ++nf) sc[nf] = (f32x4){0.f, 0.f, 0.f, 0.f};
                const bf16* qrow = F.QP + (r0 + 16 * tb + fr) * NQ + h * 256 + p * 128 + fq * 8;
                const bf16* krow = F.KEYS + (size_t)((h * 2 + p) * 128 + fr) * 128 + fq * 8;
#pragma unroll
                for (int k4 = 0; k4 < 4; ++k4) {
                    const bf16x8 bq = *(const bf16x8*)(qrow + k4 * 32);
#pragma unroll
                    for (int nf = 0; nf < 8; ++nf) { const bf16x8 ak = *(const bf16x8*)(krow + (size_t)nf * 16 * 128 + k4 * 32);
                        sc[nf] = __builtin_amdgcn_mfma_f32_16x16x32_bf16(ak, bq, sc[nf], 0, 0, 0); }
                }
                unsigned ka[16], kb[16];
#pragma unroll
                for (int nf = 0; nf < 4; ++nf)
#pragma unroll
                    for (int r = 0; r < 4; ++r) {
                        ka[nf * 4 + r] = (f2ord(sc[nf][r]) & ~127u) | (unsigned)(127 - (16 * nf + 4 * fq + r));
                        kb[nf * 4 + r] = (f2ord(sc[nf + 4][r]) & ~127u) | (unsigned)(127 - (16 * (nf + 4) + 4 * fq + r)); }
                bitonic_sort_desc<16>(ka); bitonic_sort_desc<16>(kb);
                merge_top16(ka, kb);
                {
                    unsigned o[16];
#pragma unroll
                    for (int i = 0; i < 16; ++i) o[i] = (unsigned)__shfl_xor((int)ka[i], 16);
                    merge_top16(ka, o);
#pragma unroll
                    for (int i = 0; i < 16; ++i) o[i] = (unsigned)__shfl_xor((int)ka[i], 32);
                    merge_top16(ka, o);
                }
                if (fq == 0) { LAS v4u* dst = (LAS v4u*)(TOP + (((16 * tb + fr) * 8 + h) * 2 + p) * 16);
                    dst[0] = (v4u){ka[0], ka[1], ka[2], ka[3]}; dst[1] = (v4u){ka[4], ka[5], ka[6], ka[7]}; dst[2] = (v4u){ka[8], ka[9], ka[10], ka[11]}; dst[3] = (v4u){ka[12], ka[13], ka[14], ka[15]}; }
            }
        }
        __syncthreads();
        {
            const int t = tid >> 3, h = tid & 7;
            const LAS unsigned* pa = TOP + ((t * 8 + h) * 2) * 16; const LAS unsigned* pb = pa + 16;
            float av[16], bv[16];
            { const LAS v4u* qa = (const LAS v4u*)pa; const LAS v4u* qb = (const LAS v4u*)pb;
#pragma unroll
              for (int i = 0; i < 4; ++i) { const v4u x = qa[i], y = qb[i];
#pragma unroll
                  for (int j = 0; j < 4; ++j) { av[4 * i + j] = ord2f(x[j] & ~127u); bv[4 * i + j] = ord2f(y[j] & ~127u); } } }
            unsigned c0[16], c1[16], c2[16], c3[16];
#pragma unroll
            for (int i = 0; i < 16; ++i) { c0[i] = 0u; c1[i] = 0u; c2[i] = 0u; c3[i] = 0u; }
            {
                int n = 0;
#pragma unroll
                for (int i = 0; i < 16; ++i)
#pragma unroll
                    for (int j = 0; j < 16; ++j) if ((i + 1) * (j + 1) <= 16) {
                        const unsigned key = (f2ord(av[i] + bv[j]) & ~255u) | (unsigned)(255 - (i * 16 + j));
                        if (n < 16) c0[n] = key; else if (n < 32) c1[n - 16] = key; else if (n < 48) c2[n - 32] = key; else c3[n - 48] = key;
                        ++n; }
            }
            bitonic_sort_desc<16>(c0); bitonic_sort_desc<16>(c1); bitonic_sort_desc<16>(c2); bitonic_sort_desc<16>(c3);
            merge_top16(c0, c1); merge_top16(c2, c3); merge_top16(c0, c2);
            float sv[16]; unsigned ix[16]; float mx = -3.0e38f;
#pragma unroll
            for (int k = 0; k < 16; ++k) { const unsigned pos = 255u - (c0[k] & 255u); const unsigned ua = pa[pos >> 4], ub = pb[pos & 15];
                sv[k] = ord2f(ua & ~127u) + ord2f(ub & ~127u); ix[k] = (127u - (ua & 127u)) * 128u + (127u - (ub & 127u)); mx = fmaxf(mx, sv[k]); }
            float sum = 0.f;
#pragma unroll
            for (int k = 0; k < 16; ++k) { sv[k] = __expf(sv[k] - mx); sum += sv[k]; }
            const float inv = 1.f / sum;
            unsigned c4[4] = {0u, 0u, 0u, 0u};
#pragma unroll
            for (int k = 0; k < 16; ++k) { const unsigned s = ix[k] >> 10, inc = 1u << ((s & 3u) * 8u);
#pragma unroll
                for (int w = 0; w < 4; ++w) c4[w] += ((s >> 2) == (unsigned)w) ? inc : 0u; }
            CNT[t * 8 + h] = (v4u){c4[0], c4[1], c4[2], c4[3]};
            unsigned e0[16]; float e1[16];
#pragma unroll
            for (int k = 0; k < 16; ++k) { e0[k] = ix[k] | (f2bf(F.SU[ix[k]]) << 16); e1[k] = sv[k] * inv * F.SV[ix[k]]; }
            __syncthreads();
            unsigned A4[4] = {0u, 0u, 0u, 0u}, B4[4] = {0u, 0u, 0u, 0u};
#pragma unroll
            for (int hh = 0; hh < 8; ++hh) { const v4u v = CNT[t * 8 + hh];
#pragma unroll
                for (int w = 0; w < 4; ++w) { A4[w] += v[w]; B4[w] += (hh < h) ? v[w] : 0u; } }
            unsigned off4[4] = {0u, 0u, 0u, 0u}; unsigned run = 0u;
#pragma unroll
            for (int s = 0; s < 16; ++s) { off4[s >> 2] |= run << ((s & 3) * 8); run += (A4[s >> 2] >> ((s & 3) * 8)) & 255u; }
            if (h == 0) { *(LAS v4u*)(OFFS + t * 32) = (v4u){off4[0], off4[1], off4[2], off4[3]}; OFFS[t * 32 + 16] = (unsigned char)128; }
            unsigned base4[4], r4[4] = {0u, 0u, 0u, 0u};
#pragma unroll
            for (int w = 0; w < 4; ++w) base4[w] = off4[w] + B4[w];
#pragma unroll
            for (int k = 0; k < 16; ++k) { const unsigned s = ix[k] >> 10, wsel = s >> 2, sh8 = (s & 3u) * 8u;
                const unsigned bsel = wsel == 0 ? base4[0] : wsel == 1 ? base4[1] : wsel == 2 ? base4[2] : base4[3];
                const unsigned rsel = wsel == 0 ? r4[0] : wsel == 1 ? r4[1] : wsel == 2 ? r4[2] : r4[3];
                const unsigned pos = ((bsel >> sh8) & 255u) + ((rsel >> sh8) & 255u);
                IDXS[t * 128 + pos] = (v2u){e0[k], __float_as_uint(e1[k])};
#pragma unroll
                for (int w = 0; w < 4; ++w) r4[w] += (wsel == (unsigned)w) ? (1u << sh8) : 0u; }
        }
        __syncthreads();
        {
#pragma unroll 2
            for (int tk = 0; tk < 8; ++tk) { const int tl = wave * 8 + tk; const size_t row = r0 + tl;
                const v4u a = *(const v4u*)(F.H2 + row * D + 16 * lane), bq = *(const v4u*)(F.H2 + row * D + 16 * lane + 8);
                float hv[16]; float am = 0.f;
#pragma unroll
                for (int w = 0; w < 4; ++w) { hv[2 * w] = bf2f(a[w] & 0xffffu); hv[2 * w + 1] = __uint_as_float(a[w] & 0xffff0000u); hv[8 + 2 * w] = bf2f(bq[w] & 0xffffu); hv[8 + 2 * w + 1] = __uint_as_float(bq[w] & 0xffff0000u); }
#pragma unroll
                for (int i = 0; i < 16; ++i) am = fmaxf(am, fabsf(hv[i]));
#pragma unroll
                for (int o = 1; o < 64; o <<= 1) am = fmaxf(am, __shfl_xor(am, o));
                const float inv = am > 0.f ? 127.f / am : 0.f; unsigned hq[4];
#pragma unroll
                for (int i = 0; i < 4; ++i) { const int q0 = (int)rintf(hv[4 * i] * inv), q1 = (int)rintf(hv[4 * i + 1] * inv), q2 = (int)rintf(hv[4 * i + 2] * inv), q3 = (int)rintf(hv[4 * i + 3] * inv);
                    hq[i] = (unsigned)(q0 & 255) | ((unsigned)(q1 & 255) << 8) | ((unsigned)(q2 & 255) << 16) | ((unsigned)(q3 & 255) << 24); }
                *(LAS v4u*)(HQ + tl * 1024 + 16 * lane) = (v4u){hq[0], hq[1], hq[2], hq[3]};
                if (lane == 0) SH[tl] = am * (1.f / 127.f); }
        }
        __syncthreads();
        {
            const int c16 = lane & 15, rp = lane >> 4;
            f32x2 acc[8][8]; float csum[8];
#pragma unroll
            for (int tk = 0; tk < 8; ++tk) { csum[tk] = 0.f;
#pragma unroll
                for (int i = 0; i < 8; ++i) acc[tk][i] = (f32x2){0.f, 0.f}; }
#pragma unroll 1
            for (int s = 0; s < 16; ++s) {
#pragma unroll
                for (int tk = 0; tk < 8; ++tk) {
                    const int tl = wave * 8 + tk;
                    const int n0 = OFFS[tl * 32 + s], n1 = OFFS[tl * 32 + s + 1];
                    const float sh = SH[tl];
                    const LAS v2u* ent = IDXS + tl * 128;
                    const LAS unsigned char* hrow = HQ + tl * 1024 + c16 * 16;
#pragma unroll 1
                    for (int i = n0; i < n1; i += 4) {
                        const int last = n1 - 1;
                        const int iu = (i + rp) < last ? (i + rp) : last;
                        const v2u eu = ent[iu];
                        const unsigned char* up = F.U8 + (size_t)(eu.x & 0x3fffu) * D + c16 * 16;
                        v4u uu[4], vv[4]; float gsv[4];
#pragma unroll
                        for (int S = 0; S < 4; ++S) uu[S] = *(const v4u*)(up + S * 256);
#pragma unroll
                        for (int j = 0; j < 4; ++j) { const int ij = (i + j) < last ? (i + j) : last; const v2u ev = ent[ij];
                            vv[j] = *(const v4u*)(F.V8 + (size_t)(ev.x & 0x3fffu) * D + lane * 16); gsv[j] = (i + j) <= last ? __uint_as_float(ev.y) : 0.f; }
                        int dt = 0;
#pragma unroll
                        for (int S = 0; S < 4; ++S) { const v4u hq = *(const LAS v4u*)(hrow + S * 256);
#pragma unroll
                            for (int w = 0; w < 4; ++w) dt = __builtin_amdgcn_sdot4((int)uu[S][w], (int)hq[w], dt, false); }
                        dt += __shfl_xor(dt, 1); dt += __shfl_xor(dt, 2); dt += __shfl_xor(dt, 4); dt += __shfl_xor(dt, 8);
                        const float gl = gelu_as((float)dt * (__uint_as_float(eu.x & 0xffff0000u) * sh));
#pragma unroll
                        for (int j = 0; j < 4; ++j) {
                            const float cj = __uint_as_float(__builtin_amdgcn_readlane(__float_as_uint(gl), 16 * j)) * gsv[j];
                            csum[tk] += cj; const f32x2 c2 = {cj, cj};
#pragma unroll
                            for (int w = 0; w < 4; ++w) { const unsigned x = vv[j][w];
                                acc[tk][2 * w] += c2 * (f32x2){(float)(x & 255u), (float)((x >> 8) & 255u)};
                                acc[tk][2 * w + 1] += c2 * (f32x2){(float)((x >> 16) & 255u), (float)(x >> 24)}; }
                        }
                    }
                }
            }
#pragma unroll
            for (int tk = 0; tk < 8; ++tk) {
                const int tl = wave * 8 + tk; const size_t row = r0 + tl; const int b = (int)(row >> 13);
                float x2[16]; float ss = 0.f; const int d0i = 16 * lane;
#pragma unroll
                for (int q = 0; q < 4; ++q) { const f32x4 xa = *(const f32x4*)(F.out + row * D + d0i + 4 * q), ga = *(const f32x4*)(F.MOD + b * 6144 + 5120 + d0i + 4 * q);
#pragma unroll
                    for (int j = 0; j < 4; ++j) { const float a = acc[tk][2 * q + (j >> 1)][j & 1]; const float pv = a - 128.f * csum[tk]; x2[4 * q + j] = xa[j] + ga[j] * pv; ss += x2[4 * q + j] * x2[4 * q + j]; } }
                const float rstd = 1.f / sqrtf(wave_sum(ss) * (1.f / D) + EPS);
#pragma unroll
                for (int q = 0; q < 4; ++q) { const f32x4 wa = *(const f32x4*)(F.final_w + d0i + 4 * q); f32x4 oa;
#pragma unroll
                    for (int j = 0; j < 4; ++j) oa[j] = x2[4 * q + j] * rstd * wa[j];
                    *(f32x4*)(F.out + row * D + d0i + 4 * q) = oa; }
            }
        }
        __syncthreads();
    }
}

#define XB_TMO      128
#define XB_XCNT(j)  (256  + 64 * (j))
#define XB_XSUB(j)  (1280 + 64 * (j))
#define XB_XGEN(j)  (2304 + 64 * (j))
#define XB_TOP      3328
#define XB_TOPGEN   3392
#define XCD_BAR_WORDS 3456
#define XB_SPIN_CAP (1u << 20)
__device__ __forceinline__ unsigned xb_ld(unsigned* p)              { return __hip_atomic_load(p, __ATOMIC_RELAXED, __HIP_MEMORY_SCOPE_AGENT); }
__device__ __forceinline__ unsigned xb_add(unsigned* p, unsigned v) { return __hip_atomic_fetch_add(p, v, __ATOMIC_RELAXED, __HIP_MEMORY_SCOPE_AGENT); }
__device__ __forceinline__ unsigned xb_xcc_id() { return (unsigned)__builtin_amdgcn_s_getreg((3 << 11) | 20) & 0xFu; }
#define XB_SPIN(cond, bar) do { unsigned _sp = 0; while (cond) { __builtin_amdgcn_s_sleep(1); \
    if ((++_sp & 255u) == 0u) { if (xb_ld(&(bar)[XB_TMO])) break; if (_sp > XB_SPIN_CAP) { atomicAdd(&(bar)[XB_TMO], 1u); break; } } } } while (0)
struct XcdBarrier { unsigned* bar; unsigned x; volatile LAS unsigned* st; };
__device__ __forceinline__ XcdBarrier xcd_barrier_post(unsigned* bar, volatile LAS unsigned* st) {
    XcdBarrier b; b.bar = bar; b.x = xb_xcc_id(); b.st = st;
    if (threadIdx.x == 0) (void)xb_add(&bar[XB_XCNT(b.x)], 1u);
    return b;
}
__device__ __forceinline__ void xcd_barrier_complete(unsigned* bar, unsigned x, unsigned& nloc, unsigned& nx) {
    const unsigned G = gridDim.x * gridDim.y * gridDim.z;
    unsigned sum, cnt, mine, sp = 0u;
    for (;;) {
        sum = 0u; cnt = 0u; mine = 0u;
#pragma unroll
        for (unsigned j = 0; j < 16; ++j) { const unsigned c = xb_ld(&bar[XB_XCNT(j)]); sum += c; cnt += (c > 0u) ? 1u : 0u; mine = (j == x) ? c : mine; }
        if (sum == G) break;
        __builtin_amdgcn_s_sleep(1);
        if ((++sp & 255u) == 0u) { if (xb_ld(&bar[XB_TMO])) break; if (sp > XB_SPIN_CAP) { atomicAdd(&bar[XB_TMO], 1u); break; } }
    }
    nloc = mine > 0u ? mine : 1u; nx = cnt > 0u ? cnt : 1u;
}
__device__ __forceinline__ void xcd_barrier(const XcdBarrier& b) {
    asm volatile("s_waitcnt vmcnt(0)" ::: "memory");
    __syncthreads();
    if (threadIdx.x == 0) {
        unsigned* bar = b.bar;
        __builtin_amdgcn_s_waitcnt(0);
        unsigned nloc = b.st[0], nx = b.st[1];
        if (nloc == 0u) { xcd_barrier_complete(bar, b.x, nloc, nx); b.st[0] = nloc; b.st[1] = nx; }
        const unsigned old = xb_add(&bar[XB_XSUB(b.x)], 1u);
        const unsigned gen = old / nloc;
        if (old + 1u == (gen + 1u) * nloc) {
            __builtin_amdgcn_fence(__ATOMIC_RELEASE, "agent");
            asm volatile("s_waitcnt vmcnt(0)" ::: "memory");
            const unsigned og = xb_add(&bar[XB_TOP], 1u);
            const unsigned tg = og / nx;
            if (og + 1u == (tg + 1u) * nx) xb_add(&bar[XB_TOPGEN], 1u);
            else XB_SPIN(xb_ld(&bar[XB_TOPGEN]) == tg, bar);
            __builtin_amdgcn_fence(__ATOMIC_ACQUIRE, "agent");
            xb_add(&bar[XB_XGEN(b.x)], 1u);
            asm volatile("s_waitcnt vmcnt(0)" ::: "memory");
        } else {
            XB_SPIN(xb_ld(&bar[XB_XGEN(b.x)]) == gen, bar);
            __builtin_amdgcn_fence(__ATOMIC_ACQUIRE, "agent");
            asm volatile("s_waitcnt vmcnt(0)" ::: "memory");
        }
    }
    __syncthreads();
}

__global__ void __launch_bounds__(NTHR, 2) mk_fwd(Args args) {
    extern __shared__ __attribute__((aligned(16))) unsigned char lds_raw[];
    Ctx F;
    F.lds = (LAS unsigned char*)lds_raw;
    F.tid = threadIdx.x; F.lane = F.tid & 63; F.wave = __builtin_amdgcn_readfirstlane(F.tid >> 6); F.G = gridDim.x; F.bid = blockIdx.x;
    F.x = args.in[0]; F.c = args.in[1]; F.w_ada = args.in[2]; F.b_ada = args.in[3]; F.norm1_w = args.in[4]; F.w_in = args.in[5]; F.lb_logits = args.in[6];
    F.hgrn_onorm_w = args.in[7]; F.conv_w = args.in[8]; F.conv_onorm_w = args.in[9]; F.w_out = args.in[10]; F.norm2_w = args.in[11]; F.w_query = args.in[12];
    F.sub_keys = args.in[13]; F.peer_u = args.in[14]; F.peer_v = args.in[15]; F.final_w = args.in[16];
    F.out = args.out;
    unsigned char* ws = args.ws;
    F.ACH = (float*)(ws + WS_ACH); F.MOD = (float*)(ws + WS_MOD); F.LB = (float*)(ws + WS_LB);
    F.WIN = (bf16*)(ws + WS_WIN); F.WOUT = (bf16*)(ws + WS_WOUT); F.WQ = (bf16*)(ws + WS_WQ); F.KEYS = (bf16*)(ws + WS_KEYS);
    F.U8 = ws + WS_U8; F.V8 = ws + WS_V8; F.SU = (float*)(ws + WS_SU); F.SV = (float*)(ws + WS_SV); F.H1 = (bf16*)(ws + WS_H1); F.YCAT = (bf16*)(ws + WS_H1);
    F.PROJ = (bf16*)(ws + WS_PROJ); F.H2 = (bf16*)(ws + WS_PROJ); F.QP = (bf16*)(ws + WS_PROJ + 32 * MiB); F.ST = (bf16*)(ws + WS_ST);
    const int lo = args.ph_lo, hi = args.ph_hi;
    volatile LAS unsigned* MISC = (volatile LAS unsigned*)(F.lds + MISC_OFF);
    if (F.tid < 16) MISC[F.tid] = 0u;
    __syncthreads();
    XcdBarrier bar = xcd_barrier_post((unsigned*)(ws + WS_CTL), MISC);
#define IN(k) (lo <= (k) && (k) < hi)
#define SEAM(k) do { if (IN(k) && IN((k) + 1)) { xcd_barrier(bar); } } while (0)
    if (IN(0)) { for (int rep = 0; rep < NREP(0); ++rep) p0_prep(F); } SEAM(0);
    if (IN(1)) for (int rep = 0; rep < NREP(1); ++rep) { const int gw = F.bid * NWAVES + F.wave, NGW = F.G * NWAVES;
        for (int m = gw; m < M; m += NGW) { const float* md = F.MOD + (m >> 13) * 6144; modnorm_row(F.x + (size_t)m * D, F.norm1_w, md, md + 1024, F.H1 + (size_t)m * D, F.lane); } } SEAM(1);
    if (IN(2)) for (int rep = 0; rep < NREP(2); ++rep) { pg8::Gemm g{F.H1, F.WIN, M, NIN, D}; pg8::StaticOrder S; S.init(M, NIN, F.G, F.bid); pg8::EpiBf16 E{F.PROJ, NIN}; pg8::gemm_phase<pg8::EpiBf16>(F.lds, g, S, E); } SEAM(2);
    if (IN(3)) { for (int rep = 0; rep < NREP(3); ++rep) p3_local(F); } SEAM(3);
    if (IN(4)) { p4_scan(F); } SEAM(4);
    if (IN(5)) { for (int rep = 0; rep < NREP(5); ++rep) p5_out(F); } SEAM(5);
    if (IN(6)) for (int rep = 0; rep < NREP(6); ++rep) { pg8::Gemm g{F.YCAT, F.WOUT, M, D, D}; pg8::StaticOrder S; S.init(M, D, F.G, F.bid); pg8::EpiRes E{F.x, F.out, F.MOD}; pg8::gemm_phase<pg8::EpiRes>(F.lds, g, S, E); } SEAM(6);
    if (IN(7)) for (int rep = 0; rep < NREP(7); ++rep) { const int gw = F.bid * NWAVES + F.wave, NGW = F.G * NWAVES;
        for (int m = gw; m < M; m += NGW) { const float* md = F.MOD + (m >> 13) * 6144; modnorm_row(F.out + (size_t)m * D, F.norm2_w, md + 3072, md + 4096, F.H2 + (size_t)m * D, F.lane); } } SEAM(7);
    if (IN(8)) for (int rep = 0; rep < NREP(8); ++rep) { pg8::Gemm g{F.H2, F.WQ, M, NQ, D}; pg8::StaticOrder S; S.init(M, NQ, F.G, F.bid); pg8::EpiBf16 E{F.QP, NQ}; pg8::gemm_phase<pg8::EpiBf16>(F.lds, g, S, E); } SEAM(8);
#ifndef DBG_STOP
    if (IN(9)) { p9_peer(F); }
#else
    xcd_barrier(bar);
    {
        const size_t gt = (size_t)F.bid * NTHR + F.tid, gs = (size_t)F.G * NTHR;
        for (size_t i = gt; i < (size_t)M * D; i += gs) { const size_t r = i >> 10, c = i & 1023; float v = 0.f;
            if (DBG_STOP == 2) { const bf16* p = F.PROJ + r * NIN + c; v = bf2f(p[0]) + bf2f(p[1024]) + bf2f(p[2048]) + (c < 512 ? bf2f(p[3072]) : 0.f); }
            else if (DBG_STOP == 5) { v = bf2f(F.YCAT[r * D + c]); }
            else if (DBG_STOP == 6) { v = F.out[i]; }
            else if (DBG_STOP == 8) { v = bf2f(F.QP[r * NQ + c]) + bf2f(F.QP[r * NQ + c + 1024]); }
            else if (DBG_STOP == 4 || DBG_STOP == 3) { v = bf2f(F.ST[i]); }
            else if (DBG_STOP == 1) { v = bf2f(F.H1[i]); }
            F.out[i] = v; }
    }
#endif
#undef IN
#undef SEAM
}

extern "C" void kernel_launch(void* const* d_in, const int* in_sizes, int n_in, void* d_out, int out_size, void* d_ws, size_t ws_size, hipStream_t stream) {
    static int grid = 0;
    if (grid == 0) {
        if (n_in != 17 || out_size != M * D || ws_size < WS_END) { fprintf(stderr, "kernel_launch: unexpected shapes (n_in %d out %d ws %zu)\n", n_in, out_size, ws_size); grid = -1; return; }
        int dev = 0, cus = 0, per_cu = 0;
        (void)hipGetDevice(&dev); (void)hipDeviceGetAttribute(&cus, hipDeviceAttributeMultiprocessorCount, dev);
        if (hipFuncSetAttribute((const void*)mk_fwd, hipFuncAttributeMaxDynamicSharedMemorySize, LDS_BYTES) != hipSuccess) { fprintf(stderr, "kernel_launch: hipFuncSetAttribute failed\n"); grid = -1; return; }
        if (hipOccupancyMaxActiveBlocksPerMultiprocessor(&per_cu, (const void*)mk_fwd, NTHR, LDS_BYTES) != hipSuccess || per_cu < 1) { fprintf(stderr, "kernel_launch: occupancy query gives %d\n", per_cu); per_cu = 1; }
        (void)hipGetLastError();
        grid = cus;
    }
    if (grid < 0) return;
    if (hipMemsetAsync((char*)d_ws + WS_CTL, 0, CTL_ZERO_BYTES, stream) != hipSuccess) { fprintf(stderr, "kernel_launch: memset failed\n"); return; }
    Args a{};
    for (int i = 0; i < 17; ++i) a.in[i] = (const float*)d_in[i];
    a.out = (float*)d_out; a.ws = (unsigned char*)d_ws;
#if MK_LAUNCHES == 1
#ifdef DBG_STOP
    a.ph_lo = 0; a.ph_hi = DBG_STOP + 1;
#else
    a.ph_lo = 0; a.ph_hi = 10;
#endif
    void* kargs[] = {&a};
    hipError_t e = hipLaunchCooperativeKernel((const void*)mk_fwd, dim3(grid), dim3(NTHR), kargs, LDS_BYTES, stream);
    if (e != hipSuccess) fprintf(stderr, "kernel_launch: cooperative launch failed: %s (grid %d)\n", hipGetErrorString(e), grid);
#else
    for (int ph = 0; ph < 10; ++ph) { a.ph_lo = ph; a.ph_hi = ph + 1; hipLaunchKernelGGL(mk_fwd, dim3(grid), dim3(NTHR), LDS_BYTES, stream, a); }
#endif
}
```

```cpp
#include <hip/hip_runtime.h>
#include <hip/hip_cooperative_groups.h>
#include <cstdio>
#include <cstdint>
namespace cg = cooperative_groups;

#ifndef REP_MASK
#define REP_MASK 0
#endif
#define NREP(k) (((REP_MASK) >> (k)) & 1 ? 2 : 1)
#ifndef MK_LAUNCHES
#define MK_LAUNCHES 1
#endif

#define LAS __attribute__((address_space(3)))
typedef unsigned short bf16;
typedef unsigned v4u __attribute__((ext_vector_type(4)));
typedef unsigned v2u __attribute__((ext_vector_type(2)));
typedef float f32x4 __attribute__((ext_vector_type(4)));
typedef short bf16x8 __attribute__((ext_vector_type(8)));
typedef __bf16 bf16x2 __attribute__((ext_vector_type(2)));

constexpr int D = 1024, SEQ = 8192, M = 16384;
constexpr int NIN = 3584, NQ = 2048;
constexpr float EPS = 1e-6f;
constexpr int NWAVES = 8, NTHR = 512;

constexpr size_t MiB = 1u << 20;
constexpr size_t WS_ACH = 1 * MiB;
constexpr size_t WS_MOD = 1 * MiB + 512 * 1024;
constexpr size_t WS_LB = WS_MOD + 64 * 1024;
constexpr size_t WS_WIN = 2 * MiB;
constexpr size_t WS_WOUT = 9 * MiB;
constexpr size_t WS_WQ = 11 * MiB;
constexpr size_t WS_KEYS = 15 * MiB;
constexpr size_t WS_U8 = 16 * MiB, WS_V8 = 32 * MiB;
constexpr size_t WS_SU = WS_MOD + 128 * 1024, WS_SV = WS_MOD + 192 * 1024;
constexpr size_t WS_H1 = 80 * MiB;
constexpr size_t WS_PROJ = 112 * MiB;
constexpr size_t WS_ST = 224 * MiB;
constexpr size_t WS_END = 256 * MiB;
constexpr int LDS_BYTES = 147456, MISC_OFF = 147456 - 256;
constexpr size_t WS_CTL = 0, CTL_ZERO_BYTES = 65536;

__device__ __forceinline__ float bf2f(unsigned h) { return __uint_as_float(h << 16); }
__device__ __forceinline__ unsigned f2bf(float f) { unsigned u = __float_as_uint(f); return (u + 0x7fffu + ((u >> 16) & 1u)) >> 16; }
typedef float f32x2 __attribute__((ext_vector_type(2)));
__device__ __forceinline__ unsigned pk2(float lo, float hi) { const f32x2 v = {lo, hi}; return __builtin_bit_cast(unsigned, __builtin_convertvector(v, bf16x2)); }
__device__ __forceinline__ float dot2(unsigned w, unsigned x, float acc) { return __builtin_amdgcn_fdot2_f32_bf16(__builtin_bit_cast(bf16x2, w), __builtin_bit_cast(bf16x2, x), acc, false); }
__device__ __forceinline__ float wave_sum(float v) {
#pragma unroll
    for (int o = 1; o < 64; o <<= 1) v += __shfl_xor(v, o);
    return v;
}

namespace pg8 {
constexpr int BM = 256, BK = 64, HALF = 128, HTB = HALF * BK * 2, STAGE_BYTES = 8 * HTB, NXCD = 8, WGM = 8;
__host__ __device__ __forceinline__ int lds_byte(int r, int c) { const int st = (r >> 4) * 2 + (c >> 5), rr = r & 15, cc = c & 31, ob = rr * 64 + cc * 2; return st * 1024 + (ob ^ (((ob >> 9) & 1) << 5)); }
__host__ __device__ __forceinline__ void stage_rc(int b, int& R, int& C) { const int st = b / 1024, sb = b % 1024, swz = sb ^ (((sb >> 9) & 1) << 5); R = (st >> 1) * 16 + swz / 64; C = (st & 1) * 32 + (swz % 64) / 2; }
__host__ __device__ __forceinline__ int perm32(int rho) { const int n = rho >> 4, i = rho & 15; return 8 * (i >> 2) + 4 * n + (i & 3); }
struct Unit { int pm, pn; };
struct Gemm { const bf16* A; const bf16* Bt; int M, N, K; };
struct StaticOrder {
    int nM, nN, nwg, G, c;
    __host__ __device__ void init(int M_, int N_, int G_, int c_) { nM = M_ / BM; nN = N_ / BM; nwg = nM * nN; G = G_; c = c_; }
    __host__ __device__ bool next(int i, Unit& u) const {
        const long L = (long)i * G + c; if (L >= nwg) return false;
        int wgid = (int)L; { const int q = nwg / NXCD, r = nwg % NXCD, xcd = wgid % NXCD, off = wgid / NXCD; wgid = (xcd < r ? xcd * (q + 1) : r * (q + 1) + (xcd - r) * q) + off; }
        const int nig = WGM * nN, gid = wgid / nig, fm = gid * WGM, gsz = (nM - fm) < WGM ? (nM - fm) : WGM;
        u.pm = fm + ((wgid % nig) % gsz); u.pn = (wgid % nig) / gsz; return true;
    }
};
struct EpiBf16 {
    static constexpr bool PERM = true;
    bf16* O; int ldc;
    __device__ __forceinline__ void operator()(const f32x4 (&acc)[2][2][4][2], const Unit& u, int wr, int wc, int fr, int fq) const {
        const int row0 = u.pm * BM + wr * 64 + fr; const int col0 = u.pn * BM + wc * 32 + 8 * fq;
#pragma unroll
        for (int ai = 0; ai < 2; ++ai)
#pragma unroll
            for (int m = 0; m < 4; ++m) { bf16* rowp = O + (size_t)(row0 + ai * HALF + m * 16) * ldc + col0;
#pragma unroll
                for (int bj = 0; bj < 2; ++bj) { const f32x4 v0 = acc[ai][bj][m][0], v1 = acc[ai][bj][m][1];
                    v4u w; w.x = pk2(v0[0], v0[1]); w.y = pk2(v0[2], v0[3]); w.z = pk2(v1[0], v1[1]); w.w = pk2(v1[2], v1[3]);
                    *(v4u*)(rowp + bj * HALF) = w; } }
    }
};
struct EpiRes {
    static constexpr bool PERM = false;
    const float* x; float* out; const float* mod;
    __device__ __forceinline__ void operator()(const f32x4 (&acc)[2][2][4][2], const Unit& u, int wr, int wc, int fr, int fq) const {
        const int row0 = u.pm * BM + wr * 64 + fr, col0 = u.pn * BM + wc * 32 + 4 * fq; const int b = u.pm >> 5;
        f32x4 gv[2][2];
#pragma unroll
        for (int bj = 0; bj < 2; ++bj)
#pragma unroll
            for (int n = 0; n < 2; ++n) gv[bj][n] = *(const f32x4*)(mod + b * 6144 + 2048 + col0 + bj * HALF + n * 16);
#pragma unroll
        for (int ai = 0; ai < 2; ++ai)
#pragma unroll
            for (int m = 0; m < 4; ++m) { const size_t off = (size_t)(row0 + ai * HALF + m * 16) * D + col0;
#pragma unroll
                for (int bj = 0; bj < 2; ++bj)
#pragma unroll
                    for (int n = 0; n < 2; ++n) { const f32x4 xv = *(const f32x4*)(x + off + bj * HALF + n * 16);
                        *(f32x4*)(out + off + bj * HALF + n * 16) = xv + gv[bj][n] * acc[ai][bj][m][n]; } }
    }
};

template <class Epi, bool ALIGN_EPI = true>
__device__ __forceinline__ void gemm_phase(LAS unsigned char* lds, const Gemm g, const StaticOrder& S, const Epi& E) {
    const int tid = threadIdx.x, wid = __builtin_amdgcn_readfirstlane(tid >> 6), lane = tid & 63, wr = wid >> 2, wc = wid & 3, fr = lane & 15, fq = lane >> 4;
    const int K = g.K, nt = K / BK;
    unsigned voffA[2], voffB[2];
#pragma unroll
    for (int i = 0; i < 2; ++i) { int R, C; stage_rc(tid * 16 + i * 8192, R, C); const int Rb = Epi::PERM ? ((R & ~31) + perm32(R & 31)) : R;
        voffA[i] = (unsigned)(R * K + C) * 2u; voffB[i] = (unsigned)(Rb * K + C) * 2u; }
    const size_t kstep = (size_t)(BK * 2);
    const size_t hstep = (size_t)HALF * K * 2;
    const size_t tstep = 2 * hstep;
    const unsigned ldsw = (unsigned)wid * 1024u;
    const int aoff = lds_byte(wr * 64 + fr, fq * 8), boff = lds_byte(wc * 32 + fr, fq * 8);
#define PG8_SA(b, h) (((b) * 2 + (h)) * HTB)
#define PG8_SB(b, h) ((4 + (b) * 2 + (h)) * HTB)
#define PG8_STAGE(bufoff, gbase, voff) do { _Pragma("unroll") for (int _i = 0; _i < 2; ++_i) \
        __builtin_amdgcn_global_load_lds((const unsigned*)((const char*)(gbase) + (voff)[_i]), (LAS unsigned*)(lds + (bufoff) + ldsw + _i * 8192), 16, 0, 0); } while (0)
#define PG8_LDA(dst, b, h) do { _Pragma("unroll") for (int m = 0; m < 4; ++m) _Pragma("unroll") for (int k = 0; k < 2; ++k) dst[m][k] = *(const LAS bf16x8*)(lds + PG8_SA(b, h) + aoff + m * 2048 + k * 1024); } while (0)
#define PG8_LDB(dst, b, h) do { _Pragma("unroll") for (int n = 0; n < 2; ++n) _Pragma("unroll") for (int k = 0; k < 2; ++k) dst[n][k] = *(const LAS bf16x8*)(lds + PG8_SB(b, h) + boff + n * 2048 + k * 1024); } while (0)
#define PG8_MMA(ai, bj, At, Bt) do { __builtin_amdgcn_s_setprio(1); _Pragma("unroll") for (int m = 0; m < 4; ++m) _Pragma("unroll") for (int n = 0; n < 2; ++n) _Pragma("unroll") for (int k = 0; k < 2; ++k) \
        acc[ai][bj][m][n] = __builtin_amdgcn_mfma_f32_16x16x32_bf16(Bt[n][k], At[m][k], acc[ai][bj][m][n], 0, 0, 0); __builtin_amdgcn_s_setprio(0); } while (0)
#define PG8_WAIT_V(n) asm volatile("s_waitcnt vmcnt(" #n ")" ::: "memory")
#define PG8_WAIT_L(n) asm volatile("s_waitcnt lgkmcnt(" #n ")" ::: "memory")
#define PG8_BAR __builtin_amdgcn_s_barrier()
#define PG8_SCHED __builtin_amdgcn_sched_barrier(0)
    Unit cur, nxt; int ui = 0;
    if (!S.next(0, cur)) return;
    f32x4 acc[2][2][4][2];
#pragma unroll
    for (int a = 0; a < 2; ++a)
#pragma unroll
        for (int b = 0; b < 2; ++b)
#pragma unroll
            for (int m = 0; m < 4; ++m)
#pragma unroll
                for (int n = 0; n < 2; ++n) acc[a][b][m][n] = (f32x4){0.f, 0.f, 0.f, 0.f};
    bf16x8 At[4][2], B0[2][2], B1[2][2];
    const char* cA = (const char*)g.A + (size_t)cur.pm * tstep; const char* cB = (const char*)g.Bt + (size_t)cur.pn * tstep;
    PG8_STAGE(PG8_SB(0, 0), cB, voffB); PG8_STAGE(PG8_SB(0, 1), cB + hstep, voffB); PG8_STAGE(PG8_SA(0, 0), cA, voffA); PG8_STAGE(PG8_SA(0, 1), cA + hstep, voffA);
    if (wr == 1) PG8_BAR;
    PG8_WAIT_V(2); PG8_BAR;
    PG8_STAGE(PG8_SB(1, 0), cB + kstep, voffB); PG8_STAGE(PG8_SA(1, 0), cA + kstep, voffA); PG8_STAGE(PG8_SB(1, 1), cB + hstep + kstep, voffB);
    PG8_WAIT_V(6); PG8_BAR;
    for (;;) {
        const bool has_next = S.next(ui + 1, nxt);
        const char* nA = has_next ? (const char*)g.A + (size_t)nxt.pm * tstep : cA; const char* nB = has_next ? (const char*)g.Bt + (size_t)nxt.pn * tstep : cB;
        for (int t = 0; t < nt; t += 2) {
            const bool last = (t == nt - 2);
            const char* a1 = cA + (size_t)(t + 1) * kstep;
            const char* a2 = last ? nA : cA + (size_t)(t + 2) * kstep; const char* b2 = last ? nB : cB + (size_t)(t + 2) * kstep;
            const char* a3 = a2 + kstep; const char* b3 = b2 + kstep;
            PG8_LDB(B0, 0, 0); PG8_LDB(B1, 0, 1); PG8_SCHED; PG8_LDA(At, 0, 0); PG8_STAGE(PG8_SA(1, 1), a1 + hstep, voffA);
            PG8_WAIT_V(8); PG8_WAIT_L(0); PG8_BAR; PG8_MMA(0, 0, At, B0); PG8_MMA(0, 1, At, B1); PG8_BAR; PG8_SCHED;
            PG8_LDA(At, 0, 1); PG8_STAGE(PG8_SB(0, 0), b2, voffB); PG8_STAGE(PG8_SB(0, 1), b2 + hstep, voffB); PG8_STAGE(PG8_SA(0, 0), a2, voffA);
            PG8_WAIT_V(8); PG8_WAIT_L(0); PG8_BAR; PG8_MMA(1, 0, At, B0); PG8_MMA(1, 1, At, B1); PG8_BAR; PG8_SCHED;
            PG8_LDB(B0, 1, 0); PG8_LDB(B1, 1, 1); PG8_SCHED; PG8_LDA(At, 1, 0); PG8_STAGE(PG8_SA(0, 1), a2 + hstep, voffA);
            PG8_WAIT_V(8); PG8_WAIT_L(0); PG8_BAR; PG8_MMA(0, 0, At, B0); PG8_MMA(0, 1, At, B1); PG8_BAR; PG8_SCHED;
            PG8_LDA(At, 1, 1); PG8_STAGE(PG8_SB(1, 0), b3, voffB); PG8_STAGE(PG8_SB(1, 1), b3 + hstep, voffB); PG8_STAGE(PG8_SA(1, 0), a3, voffA);
            PG8_WAIT_V(8); PG8_WAIT_L(0); PG8_BAR; PG8_MMA(1, 0, At, B0); PG8_MMA(1, 1, At, B1); PG8_BAR; PG8_SCHED;
        }
        if constexpr (ALIGN_EPI) { if (wr == 0) PG8_BAR; }
        E(acc, cur, wr, wc, fr, fq);
        if (!has_next) break;
#pragma unroll
        for (int a = 0; a < 2; ++a)
#pragma unroll
            for (int b = 0; b < 2; ++b)
#pragma unroll
                for (int m = 0; m < 4; ++m)
#pragma unroll
                    for (int n = 0; n < 2; ++n) acc[a][b][m][n] = (f32x4){0.f, 0.f, 0.f, 0.f};
        cur = nxt; cA = nA; cB = nB; ++ui;
        if constexpr (ALIGN_EPI) { if (wr == 1) PG8_BAR; }
    }
    PG8_WAIT_V(0);
    if constexpr (!ALIGN_EPI) { if (wr == 0) PG8_BAR; }
    PG8_BAR;
#undef PG8_SA
#undef PG8_SB
#undef PG8_STAGE
#undef PG8_LDA
#undef PG8_LDB
#undef PG8_MMA
#undef PG8_WAIT_V
#undef PG8_WAIT_L
#undef PG8_BAR
#undef PG8_SCHED
}
}

struct Args { const float* in[17]; float* out; unsigned char* ws; int ph_lo, ph_hi; };
struct Ctx {
    LAS unsigned char* lds; int tid, lane, wave, G, bid;
    const float *x, *c, *w_ada, *b_ada, *norm1_w, *w_in, *lb_logits, *hgrn_onorm_w, *conv_w, *conv_onorm_w, *w_out, *norm2_w, *w_query, *sub_keys, *peer_u, *peer_v, *final_w;
    float* out; float *ACH, *MOD, *LB;
    bf16 *WIN, *WOUT, *WQ, *KEYS, *H1, *YCAT, *PROJ, *H2, *QP, *ST; unsigned char *U8, *V8; float *SU, *SV;
};

__device__ __forceinline__ void p0_transpose_item(const float* W, int K, int N, bf16* WT, LAS float* scr, int item, int lane) {
    const int nblk = N / 32, kb = item / nblk, nb = item % nblk, k0 = 64 * kb, n0 = 32 * nb;
#pragma unroll 8
    for (int i = 0; i < 32; ++i) { const int kk = 2 * i + (lane >> 5); scr[kk * 33 + (lane & 31)] = W[(size_t)(k0 + kk) * N + n0 + (lane & 31)]; }
    asm volatile("s_waitcnt lgkmcnt(0)" ::: "memory"); __builtin_amdgcn_wave_barrier();
    const int c = lane & 7;
#pragma unroll
    for (int j = 0; j < 4; ++j) { const int n = (lane >> 3) + 8 * j; const LAS float* s = scr + (8 * c) * 33 + n;
        v4u o; o.x = pk2(s[0 * 33], s[1 * 33]); o.y = pk2(s[2 * 33], s[3 * 33]); o.z = pk2(s[4 * 33], s[5 * 33]); o.w = pk2(s[6 * 33], s[7 * 33]);
        *(v4u*)(WT + (size_t)(n0 + n) * K + k0 + 8 * c) = o; }
    asm volatile("s_waitcnt lgkmcnt(0)" ::: "memory"); __builtin_amdgcn_wave_barrier();
}
__device__ __forceinline__ void cvt_stream(const float* src, bf16* dst, size_t n8, size_t gtid, size_t gstride) {
    for (size_t i = gtid; i < n8; i += gstride) {
        const f32x4 a = *(const f32x4*)(src + i * 8), b = *(const f32x4*)(src + i * 8 + 4);
        v4u o; o.x = pk2(a[0], a[1]); o.y = pk2(a[2], a[3]); o.z = pk2(b[0], b[1]); o.w = pk2(b[2], b[3]);
        *(v4u*)(dst + i * 8) = o;
    }
}

__device__ __forceinline__ void p0_prep(Ctx& F) {
    {
        LAS float* sc = (LAS float*)(F.lds);
        LAS float* part = (LAS float*)(F.lds + 8192);
        for (int u = F.bid; u < 96; u += F.G) {
            for (int i = F.tid; i < 2048; i += NTHR) { const float v = F.c[i]; sc[i] = v / (1.f + __expf(-v)); }
            __syncthreads();
            const int cgp = F.tid & 15, kg = F.tid >> 4, n0 = 64 * u + 4 * cgp;
            f32x4 a0 = {0.f, 0.f, 0.f, 0.f}, a1 = {0.f, 0.f, 0.f, 0.f};
#pragma unroll 4
            for (int k = kg; k < 1024; k += 32) { const f32x4 w = *(const f32x4*)(F.w_ada + (size_t)k * 6144 + n0); a0 += w * sc[k]; a1 += w * sc[1024 + k]; }
            *(LAS f32x4*)(part + (kg * 2 + 0) * 64 + 4 * cgp) = a0; *(LAS f32x4*)(part + (kg * 2 + 1) * 64 + 4 * cgp) = a1;
            __syncthreads();
            if (F.tid < 128) { const int b = F.tid >> 6, col = F.tid & 63; float s = F.b_ada[64 * u + col];
#pragma unroll 8
                for (int q = 0; q < 32; ++q) s += part[(q * 2 + b) * 64 + col];
                F.MOD[b * 6144 + 64 * u + col] = s; }
            __syncthreads();
        }
    }
    if (F.bid == (F.G > 100 ? 100 : 0)) { const float l0 = F.lb_logits[F.tid], l1 = F.lb_logits[512 + F.tid]; F.LB[F.tid] = 1.f / (1.f + __expf(l1 - l0)); }
    {
        LAS float* scr = (LAS float*)(F.lds + 32768 + F.wave * 12288);
        const int gw = F.bid * NWAVES + F.wave, NGW = F.G * NWAVES;
        constexpr int I_IN = (D / 64) * (NIN / 32), I_OUT = (D / 64) * (D / 32), I_Q = (D / 64) * (NQ / 32);
        for (int it = gw; it < I_IN + I_OUT + I_Q; it += NGW) {
            int r = it;
            if (r < I_IN) { p0_transpose_item(F.w_in, D, NIN, F.WIN, scr, r, F.lane); continue; } r -= I_IN;
            if (r < I_OUT) { p0_transpose_item(F.w_out, D, D, F.WOUT, scr, r, F.lane); continue; } r -= I_OUT;
            p0_transpose_item(F.w_query, D, NQ, F.WQ, scr, r, F.lane);
        }
    }
    {
        const size_t gtid = (size_t)F.bid * NTHR + F.tid, gs = (size_t)F.G * NTHR;
        cvt_stream(F.sub_keys, F.KEYS, (size_t)16 * 128 * 128 / 8, gtid, gs);
    }
}

__device__ __forceinline__ void convert_experts(Ctx& F, int wg, int nwg) {
    {
        const int gw = wg * NWAVES + F.wave, NGW = nwg * NWAVES;
        for (int r = gw; r < 32768; r += NGW) {
            const bool isv = r >= 16384; const int e = r & 16383;
            const float* srow = (isv ? F.peer_v : F.peer_u) + (size_t)e * D;
            f32x4 v[4]; float am = 0.f;
#pragma unroll
            for (int j = 0; j < 4; ++j) { v[j] = *(const f32x4*)(srow + 4 * F.lane + 256 * j);
                am = fmaxf(am, fmaxf(fmaxf(fabsf(v[j].x), fabsf(v[j].y)), fmaxf(fabsf(v[j].z), fabsf(v[j].w)))); }
#pragma unroll
            for (int o = 1; o < 64; o <<= 1) am = fmaxf(am, __shfl_xor(am, o));
            unsigned* drow = (unsigned*)((isv ? F.V8 : F.U8) + (size_t)e * D);
            if (isv) {
                const float inv = am > 0.f ? 432.f / am : 0.f;
#pragma unroll
                for (int j = 0; j < 4; ++j) { int p = __builtin_amdgcn_cvt_pk_fp8_f32(v[j].x * inv, v[j].y * inv, 0, false); p = __builtin_amdgcn_cvt_pk_fp8_f32(v[j].z * inv, v[j].w * inv, p, true);
                    drow[F.lane + 64 * j] = (unsigned)p; }
                if (F.lane == 0) F.SV[e] = am * (1.f / 432.f);
            } else {
                const float inv = am > 0.f ? 127.f / am : 0.f;
#pragma unroll
                for (int j = 0; j < 4; ++j) {
                    const int q0 = (int)rintf(v[j].x * inv), q1 = (int)rintf(v[j].y * inv), q2 = (int)rintf(v[j].z * inv), q3 = (int)rintf(v[j].w * inv);
                    drow[F.lane + 64 * j] = (unsigned)(q0 & 255) | ((unsigned)(q1 & 255) << 8) | ((unsigned)(q2 & 255) << 16) | ((unsigned)(q3 & 255) << 24); }
                if (F.lane == 0) F.SU[e] = am * (1.f / 127.f);
            }
        }
    }
}

__device__ __forceinline__ void modnorm_row(const float* xrow, const float* w, const float* shift, const float* scale, bf16* orow, int lane) {
    f32x4 v[4]; float s = 0.f;
#pragma unroll
    for (int j = 0; j < 4; ++j) { v[j] = *(const f32x4*)(xrow + 4 * lane + 256 * j); s += (v[j].x * v[j].x + v[j].y * v[j].y) + (v[j].z * v[j].z + v[j].w * v[j].w); }
    const float rstd = 1.f / sqrtf(wave_sum(s) * (1.f / D) + EPS);
#pragma unroll
    for (int j = 0; j < 4; ++j) { const int col = 4 * lane + 256 * j;
        const f32x4 wv = *(const f32x4*)(w + col), sh = *(const f32x4*)(shift + col), sc = *(const f32x4*)(scale + col);
        const f32x4 y = v[j] * rstd * wv * (sc + 1.f) + sh;
        v2u o; o.x = pk2(y.x, y.y); o.y = pk2(y.z, y.w); *(v2u*)(orow + col) = o; }
}

__device__ __forceinline__ void p3_local(Ctx& F) {
    LAS unsigned char* KT = F.lds;
    LAS unsigned char* VT = F.lds + 18432;
    LAS float* QT = (LAS float*)(F.lds + 36864);
    LAS unsigned char* OUT = F.lds + 38912;
    const int tid = F.tid, lane = F.lane, wave = F.wave, fr = lane & 15, fq = lane >> 4;
    for (int u = F.bid; u < 1024; u += F.G) {
        const int bh = u >> 7, c = u & 127, b = bh >> 2, hh = bh & 3;
        const size_t r0 = (size_t)b * SEQ + (size_t)c * 64;
        const int d = tid & 127, tq = tid >> 7;
        const bf16* pf = F.PROJ + (r0 + 16 * tq) * NIN + 512 + hh * 128 + d;
        const bf16* pv = F.PROJ + (r0 + 16 * tq) * NIN + 1024 + hh * 128 + d;
        const float lbv = F.LB[hh * 128 + d], oml = 1.f - lbv;
        unsigned short fraw[16], vraw[16];
#pragma unroll
        for (int j = 0; j < 16; ++j) { fraw[j] = pf[(size_t)j * NIN]; vraw[j] = pv[(size_t)j * NIN]; }
        float cs[16], kk[16]; float run = 0.f;
#pragma unroll
        for (int j = 0; j < 16; ++j) { const float fv = bf2f(fraw[j]); const float e = __expf(-fv); const float sg = 1.f / (1.f + e);
            const float f = lbv + oml * sg; run += __logf(f); cs[j] = run; kk[j] = oml * (e * sg); }
        QT[tq * 128 + d] = run;
        __syncthreads();
        float prefix = 0.f, total = 0.f;
#pragma unroll
        for (int q = 0; q < 4; ++q) { const float t = QT[q * 128 + d]; total += t; if (q < tq) prefix += t; }
        unsigned kp[8], vp[8];
#pragma unroll
        for (int j = 0; j < 8; ++j) { const float k0 = kk[2 * j] * __expf(total - (prefix + cs[2 * j])), k1 = kk[2 * j + 1] * __expf(total - (prefix + cs[2 * j + 1]));
            kp[j] = pk2(k0, k1); vp[j] = (unsigned)vraw[2 * j] | ((unsigned)vraw[2 * j + 1] << 16); }
        *(LAS v4u*)(KT + d * 144 + tq * 32) = (v4u){kp[0], kp[1], kp[2], kp[3]}; *(LAS v4u*)(KT + d * 144 + tq * 32 + 16) = (v4u){kp[4], kp[5], kp[6], kp[7]};
        *(LAS v4u*)(VT + d * 144 + tq * 32) = (v4u){vp[0], vp[1], vp[2], vp[3]}; *(LAS v4u*)(VT + d * 144 + tq * 32 + 16) = (v4u){vp[4], vp[5], vp[6], vp[7]};
        if (tq == 0) F.ACH[u * 128 + d] = __expf(total);
        __syncthreads();
        {
            const int dblk = wave & 3, vh = wave >> 2;
            f32x4 acc[2][4];
#pragma unroll
            for (int a = 0; a < 2; ++a)
#pragma unroll
                for (int n = 0; n < 4; ++n) acc[a][n] = (f32x4){0.f, 0.f, 0.f, 0.f};
#pragma unroll
            for (int k2 = 0; k2 < 2; ++k2) {
                bf16x8 af[2], bfv[4];
#pragma unroll
                for (int a = 0; a < 2; ++a) af[a] = *(const LAS bf16x8*)(KT + (dblk * 32 + a * 16 + fr) * 144 + (k2 * 32 + fq * 8) * 2);
#pragma unroll
                for (int n = 0; n < 4; ++n) bfv[n] = *(const LAS bf16x8*)(VT + (vh * 64 + n * 16 + fr) * 144 + (k2 * 32 + fq * 8) * 2);
#pragma unroll
                for (int a = 0; a < 2; ++a)
#pragma unroll
                    for (int n = 0; n < 4; ++n) acc[a][n] = __builtin_amdgcn_mfma_f32_16x16x32_bf16(af[a], bfv[n], acc[a][n], 0, 0, 0);
            }
#pragma unroll
            for (int a = 0; a < 2; ++a)
#pragma unroll
                for (int n = 0; n < 4; ++n) { const int v = vh * 64 + n * 16 + fr, dd = dblk * 32 + a * 16 + 4 * fq;
                    *(LAS v2u*)(OUT + v * 272 + dd * 2) = (v2u){pk2(acc[a][n][0], acc[a][n][1]), pk2(acc[a][n][2], acc[a][n][3])}; }
        }
        __syncthreads();
        { const int row = tid >> 2, part = tid & 3; bf16* dst = F.ST + (size_t)u * 16384 + row * 128 + part * 32;
#pragma unroll
            for (int i = 0; i < 4; ++i) *(v4u*)(dst + i * 8) = *(const LAS v4u*)(OUT + row * 272 + part * 64 + i * 16); }
        __syncthreads();
    }
    {
        const int gw = F.bid * NWAVES + F.wave, NGW = F.G * NWAVES;
        const int ch = lane * 8;
        float w0[8], w1[8], w2[8], ow[8];
#pragma unroll
        for (int j = 0; j < 8; ++j) { w0[j] = F.conv_w[ch + j]; w1[j] = F.conv_w[512 + ch + j]; w2[j] = F.conv_w[1024 + ch + j]; ow[j] = F.conv_onorm_w[ch + j]; }
        for (int run = gw; run < M / 8; run += NGW) {
            const int rbase = run * 8;
            float u1[8], u2[8];
#pragma unroll
            for (int j = 0; j < 8; ++j) { u1[j] = 0.f; u2[j] = 0.f; }
            const int tpos = rbase & (SEQ - 1);
            if (tpos >= 1) { const bf16* p = F.PROJ + (size_t)(rbase - 1) * NIN + 2048 + ch; const v4u cc = *(const v4u*)(p + 512), xx = *(const v4u*)(p + 1024);
#pragma unroll
                for (int j = 0; j < 4; ++j) { const unsigned cw = cc[j], xw = xx[j]; u1[2 * j] = bf2f(cw & 0xffffu) * bf2f(xw & 0xffffu); u1[2 * j + 1] = bf2f(cw >> 16) * bf2f(xw >> 16); } }
            if (tpos >= 2) { const bf16* p = F.PROJ + (size_t)(rbase - 2) * NIN + 2048 + ch; const v4u cc = *(const v4u*)(p + 512), xx = *(const v4u*)(p + 1024);
#pragma unroll
                for (int j = 0; j < 4; ++j) { const unsigned cw = cc[j], xw = xx[j]; u2[2 * j] = bf2f(cw & 0xffffu) * bf2f(xw & 0xffffu); u2[2 * j + 1] = bf2f(cw >> 16) * bf2f(xw >> 16); } }
            for (int t = 0; t < 8; ++t) {
                const bf16* p = F.PROJ + (size_t)(rbase + t) * NIN + 2048 + ch;
                const v4u bb = *(const v4u*)(p), cc = *(const v4u*)(p + 512), xx = *(const v4u*)(p + 1024);
                float u0[8], y[8]; float ss = 0.f;
#pragma unroll
                for (int j = 0; j < 4; ++j) { const unsigned cw = cc[j], xw = xx[j]; u0[2 * j] = bf2f(cw & 0xffffu) * bf2f(xw & 0xffffu); u0[2 * j + 1] = bf2f(cw >> 16) * bf2f(xw >> 16); }
#pragma unroll
                for (int j = 0; j < 8; ++j) { const float bg = bf2f((j & 1) ? (bb[j >> 1] >> 16) : (bb[j >> 1] & 0xffffu));
                    y[j] = bg * (w0[j] * u2[j] + w1[j] * u1[j] + w2[j] * u0[j]); ss += y[j] * y[j]; }
                ss += __shfl_xor(ss, 1); ss += __shfl_xor(ss, 2); ss += __shfl_xor(ss, 4); ss += __shfl_xor(ss, 8);
                const float rstd = 1.f / sqrtf(ss * (1.f / 128.f) + EPS);
                v4u o; o.x = pk2(y[0] * rstd * ow[0], y[1] * rstd * ow[1]); o.y = pk2(y[2] * rstd * ow[2], y[3] * rstd * ow[3]);
                o.z = pk2(y[4] * rstd * ow[4], y[5] * rstd * ow[5]); o.w = pk2(y[6] * rstd * ow[6], y[7] * rstd * ow[7]);
                *(v4u*)(F.YCAT + (size_t)(rbase + t) * D + 512 + ch) = o;
#pragma unroll
                for (int j = 0; j < 8; ++j) { u2[j] = u1[j]; u1[j] = u0[j]; }
            }
        }
    }
}

__device__ __forceinline__ void p4_scan(Ctx& F) {
    const int gtid = F.bid * NTHR + F.tid;
    if (gtid >= 65536) return;
    const int bh = gtid >> 13, e2 = gtid & 8191, v = e2 >> 6, d = (e2 & 63) * 2;
    unsigned* p = (unsigned*)(F.ST + (size_t)bh * 128 * 16384 + v * 128 + d);
    const float* a = F.ACH + (size_t)bh * 128 * 128 + d;
    float s0 = 0.f, s1 = 0.f;
#pragma unroll 8
    for (int c = 0; c < 128; ++c) {
        const unsigned uu = p[(size_t)c * 8192]; const float a0 = a[c * 128], a1 = a[c * 128 + 1];
        p[(size_t)c * 8192] = pk2(s0, s1);
        s0 = a0 * s0 + bf2f(uu & 0xffffu); s1 = a1 * s1 + bf2f(uu >> 16);
    }
}

__device__ __forceinline__ void p5_out(Ctx& F) {
    LAS unsigned char* QM = F.lds;
    LAS unsigned char* Q0 = F.lds + 17408;
    LAS unsigned char* KM = F.lds + 34816;
    LAS unsigned char* VT = F.lds + 52224;
    LAS unsigned char* STL = F.lds + 70656;
    LAS float* QT = (LAS float*)(F.lds + 105472);
    LAS unsigned char* PB = F.lds + 107520;
    LAS float* NRM = (LAS float*)(F.lds + 125952);
    const int tid = F.tid, lane = F.lane, wave = F.wave, fr = lane & 15, fq = lane >> 4;
    for (int u = F.bid; u < 1024; u += F.G) {
        const int bh = u >> 7, c = u & 127, b = bh >> 2, hh = bh & 3;
        const size_t r0 = (size_t)b * SEQ + (size_t)c * 64;
        const int d = tid & 127, tq = tid >> 7;
        const bf16* pq = F.PROJ + (r0 + 16 * tq) * NIN + hh * 128 + d;
        const float lbv = F.LB[hh * 128 + d], oml = 1.f - lbv;
        unsigned short qraw[16], fraw[16], vraw[16];
#pragma unroll
        for (int j = 0; j < 16; ++j) { qraw[j] = pq[(size_t)j * NIN]; fraw[j] = pq[(size_t)j * NIN + 512]; vraw[j] = pq[(size_t)j * NIN + 1024]; }
        {
            const bf16* src = F.ST + (size_t)u * 16384;
#pragma unroll
            for (int i = 0; i < 4; ++i) { const int row = (tid >> 4) + 32 * i, ck = tid & 15; *(LAS v4u*)(STL + row * 272 + ck * 16) = *(const v4u*)(src + row * 128 + ck * 8); }
        }
        float cs[16], kk[16]; float run = 0.f;
#pragma unroll
        for (int j = 0; j < 16; ++j) { const float fv = bf2f(fraw[j]); const float e = __expf(-fv); const float sg = 1.f / (1.f + e);
            const float f = lbv + oml * sg; run += __logf(f); cs[j] = run; kk[j] = oml * (e * sg); }
        QT[tq * 128 + d] = run;
        __syncthreads();
        float prefix = 0.f; const float q0t = QT[d], q1t = QT[128 + d], q2t = QT[256 + d];
        if (tq >= 1) prefix += q0t; if (tq >= 2) prefix += q1t; if (tq >= 3) prefix += q2t;
        const float bmid = q0t + q1t;
        unsigned vp[8];
#pragma unroll
        for (int j = 0; j < 16; ++j) { const float bj = prefix + cs[j]; const float qv = bf2f(qraw[j]); const int t = 16 * tq + j;
            *(LAS unsigned short*)(QM + t * 272 + d * 2) = (unsigned short)f2bf(qv * __expf(bj - bmid));
            *(LAS unsigned short*)(Q0 + t * 272 + d * 2) = (unsigned short)f2bf(qv * __expf(bj));
            *(LAS unsigned short*)(KM + t * 272 + d * 2) = (unsigned short)f2bf(kk[j] * __expf(bmid - bj)); }
#pragma unroll
        for (int j = 0; j < 8; ++j) vp[j] = (unsigned)vraw[2 * j] | ((unsigned)vraw[2 * j + 1] << 16);
        *(LAS v4u*)(VT + d * 144 + tq * 32) = (v4u){vp[0], vp[1], vp[2], vp[3]}; *(LAS v4u*)(VT + d * 144 + tq * 32 + 16) = (v4u){vp[4], vp[5], vp[6], vp[7]};
        __syncthreads();
        const int rb = wave >> 1, vh = wave & 1;
        LAS unsigned char* P = PB + wave * 2304;
        {
            f32x4 sc[4];
#pragma unroll
            for (int sf = 0; sf < 4; ++sf) sc[sf] = (f32x4){0.f, 0.f, 0.f, 0.f};
#pragma unroll
            for (int k4 = 0; k4 < 4; ++k4) {
                const bf16x8 bq = *(const LAS bf16x8*)(QM + (16 * rb + fr) * 272 + (k4 * 32 + fq * 8) * 2);
#pragma unroll
                for (int sf = 0; sf < 4; ++sf) { const bf16x8 ak = *(const LAS bf16x8*)(KM + (16 * sf + fr) * 272 + (k4 * 32 + fq * 8) * 2);
                    sc[sf] = __builtin_amdgcn_mfma_f32_16x16x32_bf16(ak, bq, sc[sf], 0, 0, 0); }
            }
            const int t = 16 * rb + fr;
#pragma unroll
            for (int sf = 0; sf < 4; ++sf) { const int s0 = 16 * sf + 4 * fq;
                const float p0 = (s0 + 0 <= t) ? sc[sf][0] : 0.f, p1 = (s0 + 1 <= t) ? sc[sf][1] : 0.f, p2 = (s0 + 2 <= t) ? sc[sf][2] : 0.f, p3 = (s0 + 3 <= t) ? sc[sf][3] : 0.f;
                *(LAS v2u*)(P + fr * 144 + s0 * 2) = (v2u){pk2(p0, p1), pk2(p2, p3)}; }
        }
        __syncthreads();
        f32x4 oc[4];
#pragma unroll
        for (int n = 0; n < 4; ++n) oc[n] = (f32x4){0.f, 0.f, 0.f, 0.f};
#pragma unroll
        for (int k2 = 0; k2 < 2; ++k2) {
            const bf16x8 bp = *(const LAS bf16x8*)(P + fr * 144 + (k2 * 32 + fq * 8) * 2);
#pragma unroll
            for (int n = 0; n < 4; ++n) { const bf16x8 av = *(const LAS bf16x8*)(VT + (64 * vh + 16 * n + fr) * 144 + (k2 * 32 + fq * 8) * 2);
                oc[n] = __builtin_amdgcn_mfma_f32_16x16x32_bf16(av, bp, oc[n], 0, 0, 0); }
        }
#pragma unroll
        for (int k4 = 0; k4 < 4; ++k4) {
            const bf16x8 bq = *(const LAS bf16x8*)(Q0 + (16 * rb + fr) * 272 + (k4 * 32 + fq * 8) * 2);
#pragma unroll
            for (int n = 0; n < 4; ++n) { const bf16x8 as = *(const LAS bf16x8*)(STL + (64 * vh + 16 * n + fr) * 272 + (k4 * 32 + fq * 8) * 2);
                oc[n] = __builtin_amdgcn_mfma_f32_16x16x32_bf16(as, bq, oc[n], 0, 0, 0); }
        }
        float ss = 0.f;
#pragma unroll
        for (int n = 0; n < 4; ++n) ss += (oc[n][0] * oc[n][0] + oc[n][1] * oc[n][1]) + (oc[n][2] * oc[n][2] + oc[n][3] * oc[n][3]);
        ss += __shfl_xor(ss, 16); ss += __shfl_xor(ss, 32);
        if (fq == 0) NRM[(16 * rb + fr) * 2 + vh] = ss;
        __syncthreads();
        {
            const int t = 16 * rb + fr; const float tot = NRM[t * 2] + NRM[t * 2 + 1];
            const float rstd = 1.f / sqrtf(tot * (1.f / 128.f) + EPS);
            const bf16* pg = F.PROJ + (r0 + t) * NIN + 1536 + hh * 128;
            bf16* po = F.YCAT + (r0 + t) * D + hh * 128;
#pragma unroll
            for (int n = 0; n < 4; ++n) { const int v = 64 * vh + 16 * n + 4 * fq;
                const v2u gw = *(const v2u*)(pg + v); const f32x4 wv = *(const f32x4*)(F.hgrn_onorm_w + hh * 128 + v);
                float g[4] = {bf2f(gw.x & 0xffffu), bf2f(gw.x >> 16), bf2f(gw.y & 0xffffu), bf2f(gw.y >> 16)}; float o[4];
#pragma unroll
                for (int j = 0; j < 4; ++j) { const float sl = g[j] / (1.f + __expf(-g[j])); o[j] = oc[n][j] * rstd * wv[j] * sl; }
                *(v2u*)(po + v) = (v2u){pk2(o[0], o[1]), pk2(o[2], o[3])}; }
        }
        __syncthreads();
    }
}

__device__ __forceinline__ unsigned f2ord(float f) { const unsigned u = __float_as_uint(f); return (u & 0x80000000u) ? ~u : (u | 0x80000000u); }
__device__ __forceinline__ float ord2f(unsigned o) { return __uint_as_float((o & 0x80000000u) ? (o & 0x7fffffffu) : ~o); }
__device__ __forceinline__ void ce_desc(unsigned& a, unsigned& b) { const unsigned mx = a > b ? a : b, mn = a > b ? b : a; a = mx; b = mn; }
template <int N> __device__ __forceinline__ void bitonic_sort_desc(unsigned (&k)[N]) {
#pragma unroll
    for (int size = 2; size <= N; size <<= 1) {
#pragma unroll
        for (int stride = size >> 1; stride > 0; stride >>= 1) {
#pragma unroll
            for (int i = 0; i < N; ++i) { const int j = i ^ stride; if (j > i) { if ((i & size) == 0) ce_desc(k[i], k[j]); else ce_desc(k[j], k[i]); } }
        }
    }
}
__device__ __forceinline__ void bitonic_merge16_desc(unsigned (&k)[16]) {
#pragma unroll
    for (int stride = 8; stride > 0; stride >>= 1) {
#pragma unroll
        for (int i = 0; i < 16; ++i) { const int j = i ^ stride; if (j > i) ce_desc(k[i], k[j]); }
    }
}
__device__ __forceinline__ void merge_top16(unsigned (&a)[16], const unsigned (&b)[16]) {
#pragma unroll
    for (int i = 0; i < 16; ++i) a[i] = a[i] > b[15 - i] ? a[i] : b[15 - i];
    bitonic_merge16_desc(a);
}
__device__ __forceinline__ float gelu_as(float v) {
    const float av = fabsf(v), t = __builtin_amdgcn_rcpf(av * 0.2316418882f + 1.0f);
    float q = t * 0.5307027145f + (-0.7265760135f); q = q * t + 0.7107068705f; q = q * t + (-0.142248368f); q = q * t + 0.127414796f; q = q * t;
    const float e = __builtin_amdgcn_exp2f((v * v) * (-0.72134752044f));
    const float m = v * (q * e);
    return v < 0.f ? m : v - m;
}
__device__ __forceinline__ float gelu_erf(float x) { return 0.5f * x * (1.f + erff(x * 0.70710678118654752f)); }

__device__ __forceinline__ void p9_peer(Ctx& F) {
    LAS unsigned* TOP = (LAS unsigned*)F.lds;
    LAS v2u* IDXS = (LAS v2u*)(F.lds + 65536);
    LAS v4u* CNT = (LAS v4u*)(F.lds + 131072);
    LAS unsigned char* OFFS = F.lds + 139264;
    LAS float* SH = (LAS float*)(F.lds + 141312);
    LAS unsigned char* HQ = F.lds;
    const int tid = F.tid, lane = F.lane, wave = F.wave, fr = lane & 15, fq = lane >> 4;
    for (int tile = F.bid; tile < M / 64; tile += F.G) {
        const size_t r0 = (size_t)tile * 64;
        for (int rep9 = 0; rep9 < NREP(9); ++rep9) {
            const int p = wave >> 2, tb = wave & 3;
            for (int h = 0; h < 8; ++h) {
                f32x4 sc[8];
#pragma unroll
                for (int nf = 0; nf < 8; ++nf) sc[nf] = (f32x4){0.f, 0.f, 0.f, 0.f};
                const bf16* qrow = F.QP + (r0 + 16 * tb + fr) * NQ + h * 256 + p * 128 + fq * 8;
                const bf16* krow = F.KEYS + (size_t)((h * 2 + p) * 128 + fr) * 128 + fq * 8;
#pragma unroll
                for (int k4 = 0; k4 < 4; ++k4) {
                    const bf16x8 bq = *(const bf16x8*)(qrow + k4 * 32);
#pragma unroll
                    for (int nf = 0; nf < 8; ++nf) { const bf16x8 ak = *(const bf16x8*)(krow + (size_t)nf * 16 * 128 + k4 * 32);
                        sc[nf] = __builtin_amdgcn_mfma_f32_16x16x32_bf16(ak, bq, sc[nf], 0, 0, 0); }
                }
                unsigned ka[16], kb[16];
#pragma unroll
                for (int nf = 0; nf < 4; ++nf)
#pragma unroll
                    for (int r = 0; r < 4; ++r) {
                        ka[nf * 4 + r] = (f2ord(sc[nf][r]) & ~127u) | (unsigned)(127 - (16 * nf + 4 * fq + r));
                        kb[nf * 4 + r] = (f2ord(sc[nf + 4][r]) & ~127u) | (unsigned)(127 - (16 * (nf + 4) + 4 * fq + r)); }
                bitonic_sort_desc<16>(ka); bitonic_sort_desc<16>(kb);
                merge_top16(ka, kb);
                {
                    unsigned o[16];
#pragma unroll
                    for (int i = 0; i < 16; ++i) o[i] = (unsigned)__shfl_xor((int)ka[i], 16);
                    merge_top16(ka, o);
#pragma unroll
                    for (int i = 0; i < 16; ++i) o[i] = (unsigned)__shfl_xor((int)ka[i], 32);
                    merge_top16(ka, o);
                }
                if (fq == 0) { LAS v4u* dst = (LAS v4u*)(TOP + (((16 * tb + fr) * 8 + h) * 2 + p) * 16);
                    dst[0] = (v4u){ka[0], ka[1], ka[2], ka[3]}; dst[1] = (v4u){ka[4], ka[5], ka[6], ka[7]}; dst[2] = (v4u){ka[8], ka[9], ka[10], ka[11]}; dst[3] = (v4u){ka[12], ka[13], ka[14], ka[15]}; }
            }
        }
        __syncthreads();
        {
            const int t = tid >> 3, h = tid & 7;
            const LAS unsigned* pa = TOP + ((t * 8 + h) * 2) * 16; const LAS unsigned* pb = pa + 16;
            float av[16], bv[16];
            { const LAS v4u* qa = (const LAS v4u*)pa; const LAS v4u* qb = (const LAS v4u*)pb;
#pragma unroll
              for (int i = 0; i < 4; ++i) { const v4u x = qa[i], y = qb[i];
#pragma unroll
                  for (int j = 0; j < 4; ++j) { av[4 * i + j] = ord2f(x[j] & ~127u); bv[4 * i + j] = ord2f(y[j] & ~127u); } } }
            unsigned c0[16], c1[16], c2[16], c3[16];
#pragma unroll
            for (int i = 0; i < 16; ++i) { c0[i] = 0u; c1[i] = 0u; c2[i] = 0u; c3[i] = 0u; }
            {
                int n = 0;
#pragma unroll
                for (int i = 0; i < 16; ++i)
#pragma unroll
                    for (int j = 0; j < 16; ++j) if ((i + 1) * (j + 1) <= 16) {
                        const unsigned key = (f2ord(av[i] + bv[j]) & ~255u) | (unsigned)(255 - (i * 16 + j));
                        if (n < 16) c0[n] = key; else if (n < 32) c1[n - 16] = key; else if (n < 48) c2[n - 32] = key; else c3[n - 48] = key;
                        ++n; }
            }
            bitonic_sort_desc<16>(c0); bitonic_sort_desc<16>(c1); bitonic_sort_desc<16>(c2); bitonic_sort_desc<16>(c3);
            merge_top16(c0, c1); merge_top16(c2, c3); merge_top16(c0, c2);
            float sv[16]; unsigned ix[16]; float mx = -3.0e38f;
#pragma unroll
            for (int k = 0; k < 16; ++k) { const unsigned pos = 255u - (c0[k] & 255u); const unsigned ua = pa[pos >> 4], ub = pb[pos & 15];
                sv[k] = ord2f(ua & ~127u) + ord2f(ub & ~127u); ix[k] = (127u - (ua & 127u)) * 128u + (127u - (ub & 127u)); mx = fmaxf(mx, sv[k]); }
            float sum = 0.f;
#pragma unroll
            for (int k = 0; k < 16; ++k) { sv[k] = __expf(sv[k] - mx); sum += sv[k]; }
            const float inv = 1.f / sum;
            unsigned c4[4] = {0u, 0u, 0u, 0u};
#pragma unroll
            for (int k = 0; k < 16; ++k) { const unsigned s = ix[k] >> 11, inc = 1u << ((s & 3u) * 8u);
#pragma unroll
                for (int w = 0; w < 4; ++w) c4[w] += ((s >> 2) == (unsigned)w) ? inc : 0u; }
            CNT[t * 8 + h] = (v4u){c4[0], c4[1], c4[2], c4[3]};
            unsigned e0[16]; float e1[16];
#pragma unroll
            for (int k = 0; k < 16; ++k) { e0[k] = ix[k] | (f2bf(F.SU[ix[k]]) << 16); e1[k] = sv[k] * inv * F.SV[ix[k]]; }
            __syncthreads();
            unsigned A4[4] = {0u, 0u, 0u, 0u}, B4[4] = {0u, 0u, 0u, 0u};
#pragma unroll
            for (int hh = 0; hh < 8; ++hh) { const v4u v = CNT[t * 8 + hh];
#pragma unroll
                for (int w = 0; w < 4; ++w) { A4[w] += v[w]; B4[w] += (hh < h) ? v[w] : 0u; } }
            unsigned off4[4] = {0u, 0u, 0u, 0u}; unsigned run = 0u;
#pragma unroll
            for (int s = 0; s < 16; ++s) { off4[s >> 2] |= run << ((s & 3) * 8); run += (A4[s >> 2] >> ((s & 3) * 8)) & 255u; }
            if (h == 0) { *(LAS v4u*)(OFFS + t * 32) = (v4u){off4[0], off4[1], off4[2], off4[3]}; OFFS[t * 32 + 16] = (unsigned char)128; }
            unsigned base4[4], r4[4] = {0u, 0u, 0u, 0u};
#pragma unroll
            for (int w = 0; w < 4; ++w) base4[w] = off4[w] + B4[w];
#pragma unroll
            for (int k = 0; k < 16; ++k) { const unsigned s = ix[k] >> 11, wsel = s >> 2, sh8 = (s & 3u) * 8u;
                const unsigned bsel = wsel == 0 ? base4[0] : wsel == 1 ? base4[1] : wsel == 2 ? base4[2] : base4[3];
                const unsigned rsel = wsel == 0 ? r4[0] : wsel == 1 ? r4[1] : wsel == 2 ? r4[2] : r4[3];
                const unsigned pos = ((bsel >> sh8) & 255u) + ((rsel >> sh8) & 255u);
                IDXS[t * 128 + pos] = (v2u){e0[k], __float_as_uint(e1[k])};
#pragma unroll
                for (int w = 0; w < 4; ++w) r4[w] += (wsel == (unsigned)w) ? (1u << sh8) : 0u; }
        }
        __syncthreads();
        {
#pragma unroll 2
            for (int tk = 0; tk < 8; ++tk) { const int tl = wave * 8 + tk; const size_t row = r0 + tl;
                const v4u a = *(const v4u*)(F.H2 + row * D + 16 * lane), bq = *(const v4u*)(F.H2 + row * D + 16 * lane + 8);
                float hv[16]; float am = 0.f;
#pragma unroll
                for (int w = 0; w < 4; ++w) { hv[2 * w] = bf2f(a[w] & 0xffffu); hv[2 * w + 1] = __uint_as_float(a[w] & 0xffff0000u); hv[8 + 2 * w] = bf2f(bq[w] & 0xffffu); hv[8 + 2 * w + 1] = __uint_as_float(bq[w] & 0xffff0000u); }
#pragma unroll
                for (int i = 0; i < 16; ++i) am = fmaxf(am, fabsf(hv[i]));
#pragma unroll
                for (int o = 1; o < 64; o <<= 1) am = fmaxf(am, __shfl_xor(am, o));
                const float inv = am > 0.f ? 127.f / am : 0.f; unsigned hq[4];
#pragma unroll
                for (int i = 0; i < 4; ++i) { const int q0 = (int)rintf(hv[4 * i] * inv), q1 = (int)rintf(hv[4 * i + 1] * inv), q2 = (int)rintf(hv[4 * i + 2] * inv), q3 = (int)rintf(hv[4 * i + 3] * inv);
                    hq[i] = (unsigned)(q0 & 255) | ((unsigned)(q1 & 255) << 8) | ((unsigned)(q2 & 255) << 16) | ((unsigned)(q3 & 255) << 24); }
                *(LAS v4u*)(HQ + tl * 1024 + 16 * lane) = (v4u){hq[0], hq[1], hq[2], hq[3]};
                if (lane == 0) SH[tl] = am * (1.f / 127.f); }
        }
        __syncthreads();
        {
            const int c16 = lane & 15, rp = lane >> 4;
            f32x2 acc[8][8];
#pragma unroll
            for (int tk = 0; tk < 8; ++tk) {
#pragma unroll
                for (int i = 0; i < 8; ++i) acc[tk][i] = (f32x2){0.f, 0.f}; }
#pragma unroll 1
            for (int s = 0; s < 16; ++s) {
#pragma unroll
                for (int tk = 0; tk < 8; ++tk) {
                    const int tl = wave * 8 + tk;
                    const int n0 = OFFS[tl * 32 + s], n1 = OFFS[tl * 32 + s + 1];
                    const float sh = SH[tl];
                    const LAS v2u* ent = IDXS + tl * 128;
                    const LAS unsigned char* hrow = HQ + tl * 1024 + c16 * 16;
#pragma unroll 1
                    for (int i = n0; i < n1; i += 4) {
                        const int last = n1 - 1;
                        const int iu = (i + rp) < last ? (i + rp) : last;
                        const v2u eu = ent[iu];
                        const unsigned char* up = F.U8 + (size_t)(eu.x & 0x3fffu) * D + c16 * 16;
                        v4u uu[4], vv[4]; float gsv[4];
#pragma unroll
                        for (int S = 0; S < 4; ++S) uu[S] = *(const v4u*)(up + S * 256);
#pragma unroll
                        for (int j = 0; j < 4; ++j) { const int ij = (i + j) < last ? (i + j) : last; const v2u ev = ent[ij];
                            vv[j] = *(const v4u*)(F.V8 + (size_t)(ev.x & 0x3fffu) * D + lane * 16); gsv[j] = (i + j) <= last ? __uint_as_float(ev.y) : 0.f; }
                        int dt = 0;
#pragma unroll
                        for (int S = 0; S < 4; ++S) { const v4u hq = *(const LAS v4u*)(hrow + S * 256);
#pragma unroll
                            for (int w = 0; w < 4; ++w) dt = __builtin_amdgcn_sdot4((int)uu[S][w], (int)hq[w], dt, false); }
                        dt += __shfl_xor(dt, 1); dt += __shfl_xor(dt, 2); dt += __shfl_xor(dt, 4); dt += __shfl_xor(dt, 8);
                        const float gl = gelu_as((float)dt * (__uint_as_float(eu.x & 0xffff0000u) * sh));
#pragma unroll
                        for (int j = 0; j < 4; ++j) {
                            const float cj = __uint_as_float(__builtin_amdgcn_readlane(__float_as_uint(gl), 16 * j)) * gsv[j];
                            const f32x2 c2 = {cj, cj};
#pragma unroll
                            for (int w = 0; w < 4; ++w) { const int x = (int)vv[j][w];
                                acc[tk][2 * w] += c2 * __builtin_amdgcn_cvt_pk_f32_fp8(x, false);
                                acc[tk][2 * w + 1] += c2 * __builtin_amdgcn_cvt_pk_f32_fp8(x, true); }
                        }
                    }
                }
            }
#pragma unroll
            for (int tk = 0; tk < 8; ++tk) {
                const int tl = wave * 8 + tk; const size_t row = r0 + tl; const int b = (int)(row >> 13);
                float x2[16]; float ss = 0.f; const int d0i = 16 * lane;
#pragma unroll
                for (int q = 0; q < 4; ++q) { const f32x4 xa = *(const f32x4*)(F.out + row * D + d0i + 4 * q), ga = *(const f32x4*)(F.MOD + b * 6144 + 5120 + d0i + 4 * q);
#pragma unroll
                    for (int j = 0; j < 4; ++j) { const float a = acc[tk][2 * q + (j >> 1)][j & 1]; const float pv = a; x2[4 * q + j] = xa[j] + ga[j] * pv; ss += x2[4 * q + j] * x2[4 * q + j]; } }
                const float rstd = 1.f / sqrtf(wave_sum(ss) * (1.f / D) + EPS);
#pragma unroll
                for (int q = 0; q < 4; ++q) { const f32x4 wa = *(const f32x4*)(F.final_w + d0i + 4 * q); f32x4 oa;
#pragma unroll
                    for (int j = 0; j < 4; ++j) oa[j] = x2[4 * q + j] * rstd * wa[j];
                    *(f32x4*)(F.out + row * D + d0i + 4 * q) = oa; }
            }
        }
        __syncthreads();
    }
}

#define XB_TMO      128
#define XB_XCNT(j)  (256  + 64 * (j))
#define XB_XSUB(j)  (1280 + 64 * (j))
#define XB_XGEN(j)  (2304 + 64 * (j))
#define XB_TOP      3328
#define XB_TOPGEN   3392
#define XCD_BAR_WORDS 3456
#define XB_SPIN_CAP (1u << 20)
__device__ __forceinline__ unsigned xb_ld(unsigned* p)              { return __hip_atomic_load(p, __ATOMIC_RELAXED, __HIP_MEMORY_SCOPE_AGENT); }
__device__ __forceinline__ unsigned xb_add(unsigned* p, unsigned v) { return __hip_atomic_fetch_add(p, v, __ATOMIC_RELAXED, __HIP_MEMORY_SCOPE_AGENT); }
__device__ __forceinline__ unsigned xb_xcc_id() { return (unsigned)__builtin_amdgcn_s_getreg((3 << 11) | 20) & 0xFu; }
#define XB_SPIN(cond, bar) do { unsigned _sp = 0; while (cond) { __builtin_amdgcn_s_sleep(1); \
    if ((++_sp & 255u) == 0u) { if (xb_ld(&(bar)[XB_TMO])) break; if (_sp > XB_SPIN_CAP) { atomicAdd(&(bar)[XB_TMO], 1u); break; } } } } while (0)
struct XcdBarrier { unsigned* bar; unsigned x; volatile LAS unsigned* st; };
__device__ __forceinline__ XcdBarrier xcd_barrier_post(unsigned* bar, volatile LAS unsigned* st) {
    XcdBarrier b; b.bar = bar; b.x = xb_xcc_id(); b.st = st;
    if (threadIdx.x == 0) (void)xb_add(&bar[XB_XCNT(b.x)], 1u);
    return b;
}
__device__ __forceinline__ void xcd_barrier_complete(unsigned* bar, unsigned x, unsigned& nloc, unsigned& nx) {
    const unsigned G = gridDim.x * gridDim.y * gridDim.z;
    unsigned sum, cnt, mine, sp = 0u;
    for (;;) {
        sum = 0u; cnt = 0u; mine = 0u;
#pragma unroll
        for (unsigned j = 0; j < 16; ++j) { const unsigned c = xb_ld(&bar[XB_XCNT(j)]); sum += c; cnt += (c > 0u) ? 1u : 0u; mine = (j == x) ? c : mine; }
        if (sum == G) break;
        __builtin_amdgcn_s_sleep(1);
        if ((++sp & 255u) == 0u) { if (xb_ld(&bar[XB_TMO])) break; if (sp > XB_SPIN_CAP) { atomicAdd(&bar[XB_TMO], 1u); break; } }
    }
    nloc = mine > 0u ? mine : 1u; nx = cnt > 0u ? cnt : 1u;
}
__device__ __forceinline__ void xcd_barrier(const XcdBarrier& b) {
    asm volatile("s_waitcnt vmcnt(0)" ::: "memory");
    __syncthreads();
    if (threadIdx.x == 0) {
        unsigned* bar = b.bar;
        __builtin_amdgcn_s_waitcnt(0);
        unsigned nloc = b.st[0], nx = b.st[1];
        if (nloc == 0u) { xcd_barrier_complete(bar, b.x, nloc, nx); b.st[0] = nloc; b.st[1] = nx; }
        const unsigned old = xb_add(&bar[XB_XSUB(b.x)], 1u);
        const unsigned gen = old / nloc;
        if (old + 1u == (gen + 1u) * nloc) {
            __builtin_amdgcn_fence(__ATOMIC_RELEASE, "agent");
            asm volatile("s_waitcnt vmcnt(0)" ::: "memory");
            const unsigned og = xb_add(&bar[XB_TOP], 1u);
            const unsigned tg = og / nx;
            if (og + 1u == (tg + 1u) * nx) xb_add(&bar[XB_TOPGEN], 1u);
            else XB_SPIN(xb_ld(&bar[XB_TOPGEN]) == tg, bar);
            __builtin_amdgcn_fence(__ATOMIC_ACQUIRE, "agent");
            xb_add(&bar[XB_XGEN(b.x)], 1u);
            asm volatile("s_waitcnt vmcnt(0)" ::: "memory");
        } else {
            XB_SPIN(xb_ld(&bar[XB_XGEN(b.x)]) == gen, bar);
            __builtin_amdgcn_fence(__ATOMIC_ACQUIRE, "agent");
            asm volatile("s_waitcnt vmcnt(0)" ::: "memory");
        }
    }
    __syncthreads();
}

__global__ void __launch_bounds__(NTHR, 2) mk_fwd(Args args) {
    extern __shared__ __attribute__((aligned(16))) unsigned char lds_raw[];
    Ctx F;
    F.lds = (LAS unsigned char*)lds_raw;
    F.tid = threadIdx.x; F.lane = F.tid & 63; F.wave = __builtin_amdgcn_readfirstlane(F.tid >> 6); F.G = gridDim.x; F.bid = blockIdx.x;
    F.x = args.in[0]; F.c = args.in[1]; F.w_ada = args.in[2]; F.b_ada = args.in[3]; F.norm1_w = args.in[4]; F.w_in = args.in[5]; F.lb_logits = args.in[6];
    F.hgrn_onorm_w = args.in[7]; F.conv_w = args.in[8]; F.conv_onorm_w = args.in[9]; F.w_out = args.in[10]; F.norm2_w = args.in[11]; F.w_query = args.in[12];
    F.sub_keys = args.in[13]; F.peer_u = args.in[14]; F.peer_v = args.in[15]; F.final_w = args.in[16];
    F.out = args.out;
    unsigned char* ws = args.ws;
    F.ACH = (float*)(ws + WS_ACH); F.MOD = (float*)(ws + WS_MOD); F.LB = (float*)(ws + WS_LB);
    F.WIN = (bf16*)(ws + WS_WIN); F.WOUT = (bf16*)(ws + WS_WOUT); F.WQ = (bf16*)(ws + WS_WQ); F.KEYS = (bf16*)(ws + WS_KEYS);
    F.U8 = ws + WS_U8; F.V8 = ws + WS_V8; F.SU = (float*)(ws + WS_SU); F.SV = (float*)(ws + WS_SV); F.H1 = (bf16*)(ws + WS_H1); F.YCAT = (bf16*)(ws + WS_H1);
    F.PROJ = (bf16*)(ws + WS_PROJ); F.H2 = (bf16*)(ws + WS_PROJ); F.QP = (bf16*)(ws + WS_PROJ + 32 * MiB); F.ST = (bf16*)(ws + WS_ST);
    const int lo = args.ph_lo, hi = args.ph_hi;
    volatile LAS unsigned* MISC = (volatile LAS unsigned*)(F.lds + MISC_OFF);
    if (F.tid < 16) MISC[F.tid] = 0u;
    __syncthreads();
    XcdBarrier bar = xcd_barrier_post((unsigned*)(ws + WS_CTL), MISC);
#define IN(k) (lo <= (k) && (k) < hi)
#define SEAM(k) do { if (IN(k) && IN((k) + 1)) { xcd_barrier(bar); } } while (0)
    if (IN(0)) { for (int rep = 0; rep < NREP(0); ++rep) p0_prep(F); } SEAM(0);
    if (IN(1)) for (int rep = 0; rep < NREP(1); ++rep) { const int gw = F.bid * NWAVES + F.wave, NGW = F.G * NWAVES;
        for (int m = gw; m < M; m += NGW) { const float* md = F.MOD + (m >> 13) * 6144; modnorm_row(F.x + (size_t)m * D, F.norm1_w, md, md + 1024, F.H1 + (size_t)m * D, F.lane); } } SEAM(1);
    if (IN(2)) for (int rep = 0; rep < NREP(2); ++rep) { pg8::Gemm g{F.H1, F.WIN, M, NIN, D}; pg8::StaticOrder S; S.init(M, NIN, F.G, F.bid); pg8::EpiBf16 E{F.PROJ, NIN}; pg8::gemm_phase<pg8::EpiBf16>(F.lds, g, S, E); } SEAM(2);
    if (IN(3)) { for (int rep = 0; rep < NREP(3); ++rep) p3_local(F); } SEAM(3);
    if (IN(4)) { p4_scan(F); if (F.G >= 256) { if (F.bid >= 128) convert_experts(F, F.bid - 128, F.G - 128); } else convert_experts(F, F.bid, F.G); } SEAM(4);
    if (IN(5)) { for (int rep = 0; rep < NREP(5); ++rep) p5_out(F); } SEAM(5);
    if (IN(6)) for (int rep = 0; rep < NREP(6); ++rep) { pg8::Gemm g{F.YCAT, F.WOUT, M, D, D}; pg8::StaticOrder S; S.init(M, D, F.G, F.bid); pg8::EpiRes E{F.x, F.out, F.MOD}; pg8::gemm_phase<pg8::EpiRes>(F.lds, g, S, E); } SEAM(6);
    if (IN(7)) for (int rep = 0; rep < NREP(7); ++rep) { const int gw = F.bid * NWAVES + F.wave, NGW = F.G * NWAVES;
        for (int m = gw; m < M; m += NGW) { const float* md = F.MOD + (m >> 13) * 6144; modnorm_row(F.out + (size_t)m * D, F.norm2_w, md + 3072, md + 4096, F.H2 + (size_t)m * D, F.lane); } } SEAM(7);
    if (IN(8)) for (int rep = 0; rep < NREP(8); ++rep) { pg8::Gemm g{F.H2, F.WQ, M, NQ, D}; pg8::StaticOrder S; S.init(M, NQ, F.G, F.bid); pg8::EpiBf16 E{F.QP, NQ}; pg8::gemm_phase<pg8::EpiBf16>(F.lds, g, S, E); } SEAM(8);
#ifndef DBG_STOP
    if (IN(9)) { p9_peer(F); }
#else
    xcd_barrier(bar);
    {
        const size_t gt = (size_t)F.bid * NTHR + F.tid, gs = (size_t)F.G * NTHR;
        for (size_t i = gt; i < (size_t)M * D; i += gs) { const size_t r = i >> 10, c = i & 1023; float v = 0.f;
            if (DBG_STOP == 2) { const bf16* p = F.PROJ + r * NIN + c; v = bf2f(p[0]) + bf2f(p[1024]) + bf2f(p[2048]) + (c < 512 ? bf2f(p[3072]) : 0.f); }
            else if (DBG_STOP == 5) { v = bf2f(F.YCAT[r * D + c]); }
            else if (DBG_STOP == 6) { v = F.out[i]; }
            else if (DBG_STOP == 8) { v = bf2f(F.QP[r * NQ + c]) + bf2f(F.QP[r * NQ + c + 1024]); }
            else if (DBG_STOP == 4 || DBG_STOP == 3) { v = bf2f(F.ST[i]); }
            else if (DBG_STOP == 1) { v = bf2f(F.H1[i]); }
            F.out[i] = v; }
    }
#endif
#undef IN
#undef SEAM
}

extern "C" void kernel_launch(void* const* d_in, const int* in_sizes, int n_in, void* d_out, int out_size, void* d_ws, size_t ws_size, hipStream_t stream) {
    static int grid = 0;
    if (grid == 0) {
        if (n_in != 17 || out_size != M * D || ws_size < WS_END) { fprintf(stderr, "kernel_launch: unexpected shapes (n_in %d out %d ws %zu)\n", n_in, out_size, ws_size); grid = -1; return; }
        int dev = 0, cus = 0, per_cu = 0;
        (void)hipGetDevice(&dev); (void)hipDeviceGetAttribute(&cus, hipDeviceAttributeMultiprocessorCount, dev);
        if (hipFuncSetAttribute((const void*)mk_fwd, hipFuncAttributeMaxDynamicSharedMemorySize, LDS_BYTES) != hipSuccess) { fprintf(stderr, "kernel_launch: hipFuncSetAttribute failed\n"); grid = -1; return; }
        if (hipOccupancyMaxActiveBlocksPerMultiprocessor(&per_cu, (const void*)mk_fwd, NTHR, LDS_BYTES) != hipSuccess || per_cu < 1) { fprintf(stderr, "kernel_launch: occupancy query gives %d\n", per_cu); per_cu = 1; }
        (void)hipGetLastError();
        grid = cus;
    }
    if (grid < 0) return;
    if (hipMemsetAsync((char*)d_ws + WS_CTL, 0, CTL_ZERO_BYTES, stream) != hipSuccess) { fprintf(stderr, "kernel_launch: memset failed\n"); return; }
    Args a{};
    for (int i = 0; i < 17; ++i) a.in[i] = (const float*)d_in[i];
    a.out = (float*)d_out; a.ws = (unsigned char*)d_ws;
#if MK_LAUNCHES == 1
#ifdef DBG_STOP
    a.ph_lo = 0; a.ph_hi = DBG_STOP + 1;
#else
    a.ph_lo = 0; a.ph_hi = 10;
#endif
    void* kargs[] = {&a};
    hipError_t e = hipLaunchCooperativeKernel((const void*)mk_fwd, dim3(grid), dim3(NTHR), kargs, LDS_BYTES, stream);
    if (e != hipSuccess) fprintf(stderr, "kernel_launch: cooperative launch failed: %s (grid %d)\n", hipGetErrorString(e), grid);
#else
    for (int ph = 0; ph < 10; ++ph) { a.ph_lo = ph; a.ph_hi = ph + 1; hipLaunchKernelGGL(mk_fwd, dim3(grid), dim3(NTHR), LDS_BYTES, stream, a); }
#endif
}
```

```cpp
#include <hip/hip_runtime.h>
#include <hip/hip_cooperative_groups.h>
#include <cstdio>
#include <cstdint>
namespace cg = cooperative_groups;

#ifndef REP_MASK
#define REP_MASK 0
#endif
#define NREP(k) (((REP_MASK) >> (k)) & 1 ? 2 : 1)
#ifndef MK_LAUNCHES
#define MK_LAUNCHES 1
#endif

#define LAS __attribute__((address_space(3)))
typedef unsigned short bf16;
typedef unsigned v4u __attribute__((ext_vector_type(4)));
typedef unsigned v2u __attribute__((ext_vector_type(2)));
typedef float f32x4 __attribute__((ext_vector_type(4)));
typedef short bf16x8 __attribute__((ext_vector_type(8)));
typedef __bf16 bf16x2 __attribute__((ext_vector_type(2)));

constexpr int D = 1024, SEQ = 8192, M = 16384;
constexpr int NIN = 3584, NQ = 2048;
constexpr float EPS = 1e-6f;
constexpr int NWAVES = 8, NTHR = 512;

constexpr size_t MiB = 1u << 20;
constexpr size_t WS_ACH = 1 * MiB;
constexpr size_t WS_MOD = 1 * MiB + 512 * 1024;
constexpr size_t WS_LB = WS_MOD + 64 * 1024;
constexpr size_t WS_WIN = 2 * MiB;
constexpr size_t WS_WOUT = 9 * MiB;
constexpr size_t WS_WQ = 11 * MiB;
constexpr size_t WS_KEYS = 15 * MiB;
constexpr size_t WS_U8 = 16 * MiB, WS_V8 = 32 * MiB;
constexpr size_t WS_SU = WS_MOD + 128 * 1024, WS_SV = WS_MOD + 192 * 1024;
constexpr size_t WS_H1 = 80 * MiB;
constexpr size_t WS_PROJ = 112 * MiB;
constexpr size_t WS_ST = 224 * MiB;
constexpr size_t WS_END = 256 * MiB;
constexpr int LDS_BYTES = 147456, MISC_OFF = 147456 - 256;
constexpr size_t WS_CTL = 0, CTL_ZERO_BYTES = 65536;

__device__ __forceinline__ float bf2f(unsigned h) { return __uint_as_float(h << 16); }
__device__ __forceinline__ unsigned f2bf(float f) { unsigned u = __float_as_uint(f); return (u + 0x7fffu + ((u >> 16) & 1u)) >> 16; }
typedef float f32x2 __attribute__((ext_vector_type(2)));
__device__ __forceinline__ unsigned pk2(float lo, float hi) { const f32x2 v = {lo, hi}; return __builtin_bit_cast(unsigned, __builtin_convertvector(v, bf16x2)); }
__device__ __forceinline__ float dot2(unsigned w, unsigned x, float acc) { return __builtin_amdgcn_fdot2_f32_bf16(__builtin_bit_cast(bf16x2, w), __builtin_bit_cast(bf16x2, x), acc, false); }
__device__ __forceinline__ float wave_sum(float v) {
#pragma unroll
    for (int o = 1; o < 64; o <<= 1) v += __shfl_xor(v, o);
    return v;
}

namespace pg8 {
constexpr int BM = 256, BK = 64, HALF = 128, HTB = HALF * BK * 2, STAGE_BYTES = 8 * HTB, NXCD = 8, WGM = 8;
__host__ __device__ __forceinline__ int lds_byte(int r, int c) { const int st = (r >> 4) * 2 + (c >> 5), rr = r & 15, cc = c & 31, ob = rr * 64 + cc * 2; return st * 1024 + (ob ^ (((ob >> 9) & 1) << 5)); }
__host__ __device__ __forceinline__ void stage_rc(int b, int& R, int& C) { const int st = b / 1024, sb = b % 1024, swz = sb ^ (((sb >> 9) & 1) << 5); R = (st >> 1) * 16 + swz / 64; C = (st & 1) * 32 + (swz % 64) / 2; }
__host__ __device__ __forceinline__ int perm32(int rho) { const int n = rho >> 4, i = rho & 15; return 8 * (i >> 2) + 4 * n + (i & 3); }
struct Unit { int pm, pn; };
struct Gemm { const bf16* A; const bf16* Bt; int M, N, K; };
struct StaticOrder {
    int nM, nN, nwg, G, c;
    __host__ __device__ void init(int M_, int N_, int G_, int c_) { nM = M_ / BM; nN = N_ / BM; nwg = nM * nN; G = G_; c = c_; }
    __host__ __device__ bool next(int i, Unit& u) const {
        const long L = (long)i * G + c; if (L >= nwg) return false;
        int wgid = (int)L; { const int q = nwg / NXCD, r = nwg % NXCD, xcd = wgid % NXCD, off = wgid / NXCD; wgid = (xcd < r ? xcd * (q + 1) : r * (q + 1) + (xcd - r) * q) + off; }
        const int nig = WGM * nN, gid = wgid / nig, fm = gid * WGM, gsz = (nM - fm) < WGM ? (nM - fm) : WGM;
        u.pm = fm + ((wgid % nig) % gsz); u.pn = (wgid % nig) / gsz; return true;
    }
};
struct EpiBf16 {
    static constexpr bool PERM = true;
    bf16* O; int ldc;
    __device__ __forceinline__ void operator()(const f32x4 (&acc)[2][2][4][2], const Unit& u, int wr, int wc, int fr, int fq) const {
        const int row0 = u.pm * BM + wr * 64 + fr; const int col0 = u.pn * BM + wc * 32 + 8 * fq;
#pragma unroll
        for (int ai = 0; ai < 2; ++ai)
#pragma unroll
            for (int m = 0; m < 4; ++m) { bf16* rowp = O + (size_t)(row0 + ai * HALF + m * 16) * ldc + col0;
#pragma unroll
                for (int bj = 0; bj < 2; ++bj) { const f32x4 v0 = acc[ai][bj][m][0], v1 = acc[ai][bj][m][1];
                    v4u w; w.x = pk2(v0[0], v0[1]); w.y = pk2(v0[2], v0[3]); w.z = pk2(v1[0], v1[1]); w.w = pk2(v1[2], v1[3]);
                    *(v4u*)(rowp + bj * HALF) = w; } }
    }
};
struct EpiRes {
    static constexpr bool PERM = false;
    const float* x; float* out; const float* mod;
    __device__ __forceinline__ void operator()(const f32x4 (&acc)[2][2][4][2], const Unit& u, int wr, int wc, int fr, int fq) const {
        const int row0 = u.pm * BM + wr * 64 + fr, col0 = u.pn * BM + wc * 32 + 4 * fq; const int b = u.pm >> 5;
        f32x4 gv[2][2];
#pragma unroll
        for (int bj = 0; bj < 2; ++bj)
#pragma unroll
            for (int n = 0; n < 2; ++n) gv[bj][n] = *(const f32x4*)(mod + b * 6144 + 2048 + col0 + bj * HALF + n * 16);
#pragma unroll
        for (int ai = 0; ai < 2; ++ai)
#pragma unroll
            for (int m = 0; m < 4; ++m) { const size_t off = (size_t)(row0 + ai * HALF + m * 16) * D + col0;
#pragma unroll
                for (int bj = 0; bj < 2; ++bj)
#pragma unroll
                    for (int n = 0; n < 2; ++n) { const f32x4 xv = *(const f32x4*)(x + off + bj * HALF + n * 16);
                        *(f32x4*)(out + off + bj * HALF + n * 16) = xv + gv[bj][n] * acc[ai][bj][m][n]; } }
    }
};

template <class Epi, bool ALIGN_EPI = true>
__device__ __forceinline__ void gemm_phase(LAS unsigned char* lds, const Gemm g, const StaticOrder& S, const Epi& E) {
    const int tid = threadIdx.x, wid = __builtin_amdgcn_readfirstlane(tid >> 6), lane = tid & 63, wr = wid >> 2, wc = wid & 3, fr = lane & 15, fq = lane >> 4;
    const int K = g.K, nt = K / BK;
    unsigned voffA[2], voffB[2];
#pragma unroll
    for (int i = 0; i < 2; ++i) { int R, C; stage_rc(tid * 16 + i * 8192, R, C); const int Rb = Epi::PERM ? ((R & ~31) + perm32(R & 31)) : R;
        voffA[i] = (unsigned)(R * K + C) * 2u; voffB[i] = (unsigned)(Rb * K + C) * 2u; }
    const size_t kstep = (size_t)(BK * 2);
    const size_t hstep = (size_t)HALF * K * 2;
    const size_t tstep = 2 * hstep;
    const unsigned ldsw = (unsigned)wid * 1024u;
    const int aoff = lds_byte(wr * 64 + fr, fq * 8), boff = lds_byte(wc * 32 + fr, fq * 8);
#define PG8_SA(b, h) (((b) * 2 + (h)) * HTB)
#define PG8_SB(b, h) ((4 + (b) * 2 + (h)) * HTB)
#define PG8_STAGE(bufoff, gbase, voff) do { _Pragma("unroll") for (int _i = 0; _i < 2; ++_i) \
        __builtin_amdgcn_global_load_lds((const unsigned*)((const char*)(gbase) + (voff)[_i]), (LAS unsigned*)(lds + (bufoff) + ldsw + _i * 8192), 16, 0, 0); } while (0)
#define PG8_LDA(dst, b, h) do { _Pragma("unroll") for (int m = 0; m < 4; ++m) _Pragma("unroll") for (int k = 0; k < 2; ++k) dst[m][k] = *(const LAS bf16x8*)(lds + PG8_SA(b, h) + aoff + m * 2048 + k * 1024); } while (0)
#define PG8_LDB(dst, b, h) do { _Pragma("unroll") for (int n = 0; n < 2; ++n) _Pragma("unroll") for (int k = 0; k < 2; ++k) dst[n][k] = *(const LAS bf16x8*)(lds + PG8_SB(b, h) + boff + n * 2048 + k * 1024); } while (0)
#define PG8_MMA(ai, bj, At, Bt) do { __builtin_amdgcn_s_setprio(1); _Pragma("unroll") for (int m = 0; m < 4; ++m) _Pragma("unroll") for (int n = 0; n < 2; ++n) _Pragma("unroll") for (int k = 0; k < 2; ++k) \
        acc[ai][bj][m][n] = __builtin_amdgcn_mfma_f32_16x16x32_bf16(Bt[n][k], At[m][k], acc[ai][bj][m][n], 0, 0, 0); __builtin_amdgcn_s_setprio(0); } while (0)
#define PG8_WAIT_V(n) asm volatile("s_waitcnt vmcnt(" #n ")" ::: "memory")
#define PG8_WAIT_L(n) asm volatile("s_waitcnt lgkmcnt(" #n ")" ::: "memory")
#define PG8_BAR __builtin_amdgcn_s_barrier()
#define PG8_SCHED __builtin_amdgcn_sched_barrier(0)
    Unit cur, nxt; int ui = 0;
    if (!S.next(0, cur)) return;
    f32x4 acc[2][2][4][2];
#pragma unroll
    for (int a = 0; a < 2; ++a)
#pragma unroll
        for (int b = 0; b < 2; ++b)
#pragma unroll
            for (int m = 0; m < 4; ++m)
#pragma unroll
                for (int n = 0; n < 2; ++n) acc[a][b][m][n] = (f32x4){0.f, 0.f, 0.f, 0.f};
    bf16x8 At[4][2], B0[2][2], B1[2][2];
    const char* cA = (const char*)g.A + (size_t)cur.pm * tstep; const char* cB = (const char*)g.Bt + (size_t)cur.pn * tstep;
    PG8_STAGE(PG8_SB(0, 0), cB, voffB); PG8_STAGE(PG8_SB(0, 1), cB + hstep, voffB); PG8_STAGE(PG8_SA(0, 0), cA, voffA); PG8_STAGE(PG8_SA(0, 1), cA + hstep, voffA);
    if (wr == 1) PG8_BAR;
    PG8_WAIT_V(2); PG8_BAR;
    PG8_STAGE(PG8_SB(1, 0), cB + kstep, voffB); PG8_STAGE(PG8_SA(1, 0), cA + kstep, voffA); PG8_STAGE(PG8_SB(1, 1), cB + hstep + kstep, voffB);
    PG8_WAIT_V(6); PG8_BAR;
    for (;;) {
        const bool has_next = S.next(ui + 1, nxt);
        const char* nA = has_next ? (const char*)g.A + (size_t)nxt.pm * tstep : cA; const char* nB = has_next ? (const char*)g.Bt + (size_t)nxt.pn * tstep : cB;
        for (int t = 0; t < nt; t += 2) {
            const bool last = (t == nt - 2);
            const char* a1 = cA + (size_t)(t + 1) * kstep;
            const char* a2 = last ? nA : cA + (size_t)(t + 2) * kstep; const char* b2 = last ? nB : cB + (size_t)(t + 2) * kstep;
            const char* a3 = a2 + kstep; const char* b3 = b2 + kstep;
            PG8_LDB(B0, 0, 0); PG8_LDB(B1, 0, 1); PG8_SCHED; PG8_LDA(At, 0, 0); PG8_STAGE(PG8_SA(1, 1), a1 + hstep, voffA);
            PG8_WAIT_V(8); PG8_WAIT_L(0); PG8_BAR; PG8_MMA(0, 0, At, B0); PG8_MMA(0, 1, At, B1); PG8_BAR; PG8_SCHED;
            PG8_LDA(At, 0, 1); PG8_STAGE(PG8_SB(0, 0), b2, voffB); PG8_STAGE(PG8_SB(0, 1), b2 + hstep, voffB); PG8_STAGE(PG8_SA(0, 0), a2, voffA);
            PG8_WAIT_V(8); PG8_WAIT_L(0); PG8_BAR; PG8_MMA(1, 0, At, B0); PG8_MMA(1, 1, At, B1); PG8_BAR; PG8_SCHED;
            PG8_LDB(B0, 1, 0); PG8_LDB(B1, 1, 1); PG8_SCHED; PG8_LDA(At, 1, 0); PG8_STAGE(PG8_SA(0, 1), a2 + hstep, voffA);
            PG8_WAIT_V(8); PG8_WAIT_L(0); PG8_BAR; PG8_MMA(0, 0, At, B0); PG8_MMA(0, 1, At, B1); PG8_BAR; PG8_SCHED;
            PG8_LDA(At, 1, 1); PG8_STAGE(PG8_SB(1, 0), b3, voffB); PG8_STAGE(PG8_SB(1, 1), b3 + hstep, voffB); PG8_STAGE(PG8_SA(1, 0), a3, voffA);
            PG8_WAIT_V(8); PG8_WAIT_L(0); PG8_BAR; PG8_MMA(1, 0, At, B0); PG8_MMA(1, 1, At, B1); PG8_BAR; PG8_SCHED;
        }
        if constexpr (ALIGN_EPI) { if (wr == 0) PG8_BAR; }
        E(acc, cur, wr, wc, fr, fq);
        if (!has_next) break;
#pragma unroll
        for (int a = 0; a < 2; ++a)
#pragma unroll
            for (int b = 0; b < 2; ++b)
#pragma unroll
                for (int m = 0; m < 4; ++m)
#pragma unroll
                    for (int n = 0; n < 2; ++n) acc[a][b][m][n] = (f32x4){0.f, 0.f, 0.f, 0.f};
        cur = nxt; cA = nA; cB = nB; ++ui;
        if constexpr (ALIGN_EPI) { if (wr == 1) PG8_BAR; }
    }
    PG8_WAIT_V(0);
    if constexpr (!ALIGN_EPI) { if (wr == 0) PG8_BAR; }
    PG8_BAR;
#undef PG8_SA
#undef PG8_SB
#undef PG8_STAGE
#undef PG8_LDA
#undef PG8_LDB
#undef PG8_MMA
#undef PG8_WAIT_V
#undef PG8_WAIT_L
#undef PG8_BAR
#undef PG8_SCHED
}
}

struct Args { const float* in[17]; float* out; unsigned char* ws; int ph_lo, ph_hi; };
struct Ctx {
    LAS unsigned char* lds; int tid, lane, wave, G, bid;
    const float *x, *c, *w_ada, *b_ada, *norm1_w, *w_in, *lb_logits, *hgrn_onorm_w, *conv_w, *conv_onorm_w, *w_out, *norm2_w, *w_query, *sub_keys, *peer_u, *peer_v, *final_w;
    float* out; float *ACH, *MOD, *LB;
    bf16 *WIN, *WOUT, *WQ, *KEYS, *H1, *YCAT, *PROJ, *H2, *QP, *ST; unsigned char *U8, *V8; float *SU, *SV;
};

__device__ __forceinline__ void p0_transpose_item(const float* W, int K, int N, bf16* WT, LAS float* scr, int item, int lane) {
    const int nblk = N / 32, kb = item / nblk, nb = item % nblk, k0 = 64 * kb, n0 = 32 * nb;
#pragma unroll 8
    for (int i = 0; i < 32; ++i) { const int kk = 2 * i + (lane >> 5); scr[kk * 33 + (lane & 31)] = W[(size_t)(k0 + kk) * N + n0 + (lane & 31)]; }
    asm volatile("s_waitcnt lgkmcnt(0)" ::: "memory"); __builtin_amdgcn_wave_barrier();
    const int c = lane & 7;
#pragma unroll
    for (int j = 0; j < 4; ++j) { const int n = (lane >> 3) + 8 * j; const LAS float* s = scr + (8 * c) * 33 + n;
        v4u o; o.x = pk2(s[0 * 33], s[1 * 33]); o.y = pk2(s[2 * 33], s[3 * 33]); o.z = pk2(s[4 * 33], s[5 * 33]); o.w = pk2(s[6 * 33], s[7 * 33]);
        *(v4u*)(WT + (size_t)(n0 + n) * K + k0 + 8 * c) = o; }
    asm volatile("s_waitcnt lgkmcnt(0)" ::: "memory"); __builtin_amdgcn_wave_barrier();
}
__device__ __forceinline__ void cvt_stream(const float* src, bf16* dst, size_t n8, size_t gtid, size_t gstride) {
    for (size_t i = gtid; i < n8; i += gstride) {
        const f32x4 a = *(const f32x4*)(src + i * 8), b = *(const f32x4*)(src + i * 8 + 4);
        v4u o; o.x = pk2(a[0], a[1]); o.y = pk2(a[2], a[3]); o.z = pk2(b[0], b[1]); o.w = pk2(b[2], b[3]);
        *(v4u*)(dst + i * 8) = o;
    }
}

__device__ __forceinline__ void p0_prep(Ctx& F) {
    {
        LAS float* sc = (LAS float*)(F.lds);
        LAS float* part = (LAS float*)(F.lds + 8192);
        for (int u = F.bid; u < 96; u += F.G) {
            for (int i = F.tid; i < 2048; i += NTHR) { const float v = F.c[i]; sc[i] = v / (1.f + __expf(-v)); }
            __syncthreads();
            const int cgp = F.tid & 15, kg = F.tid >> 4, n0 = 64 * u + 4 * cgp;
            f32x4 a0 = {0.f, 0.f, 0.f, 0.f}, a1 = {0.f, 0.f, 0.f, 0.f};
#pragma unroll 4
            for (int k = kg; k < 1024; k += 32) { const f32x4 w = *(const f32x4*)(F.w_ada + (size_t)k * 6144 + n0); a0 += w * sc[k]; a1 += w * sc[1024 + k]; }
            *(LAS f32x4*)(part + (kg * 2 + 0) * 64 + 4 * cgp) = a0; *(LAS f32x4*)(part + (kg * 2 + 1) * 64 + 4 * cgp) = a1;
            __syncthreads();
            if (F.tid < 128) { const int b = F.tid >> 6, col = F.tid & 63; float s = F.b_ada[64 * u + col];
#pragma unroll 8
                for (int q = 0; q < 32; ++q) s += part[(q * 2 + b) * 64 + col];
                F.MOD[b * 6144 + 64 * u + col] = s; }
            __syncthreads();
        }
    }
    if (F.bid == (F.G > 100 ? 100 : 0)) { const float l0 = F.lb_logits[F.tid], l1 = F.lb_logits[512 + F.tid]; F.LB[F.tid] = 1.f / (1.f + __expf(l1 - l0)); }
    {
        LAS float* scr = (LAS float*)(F.lds + 32768 + F.wave * 12288);
        const int gw = F.bid * NWAVES + F.wave, NGW = F.G * NWAVES;
        constexpr int I_IN = (D / 64) * (NIN / 32), I_OUT = (D / 64) * (D / 32), I_Q = (D / 64) * (NQ / 32);
        for (int it = gw; it < I_IN + I_OUT + I_Q; it += NGW) {
            int r = it;
            if (r < I_IN) { p0_transpose_item(F.w_in, D, NIN, F.WIN, scr, r, F.lane); continue; } r -= I_IN;
            if (r < I_OUT) { p0_transpose_item(F.w_out, D, D, F.WOUT, scr, r, F.lane); continue; } r -= I_OUT;
            p0_transpose_item(F.w_query, D, NQ, F.WQ, scr, r, F.lane);
        }
    }
    {
        const size_t gtid = (size_t)F.bid * NTHR + F.tid, gs = (size_t)F.G * NTHR;
        cvt_stream(F.sub_keys, F.KEYS, (size_t)16 * 128 * 128 / 8, gtid, gs);
    }
}

__device__ __forceinline__ void convert_experts(Ctx& F, int wg, int nwg) {
    {
        const int gw = wg * NWAVES + F.wave, NGW = nwg * NWAVES;
        for (int r = gw; r < 32768; r += NGW) {
            const bool isv = r >= 16384; const int e = r & 16383;
            const float* srow = (isv ? F.peer_v : F.peer_u) + (size_t)e * D;
            f32x4 v[4]; float am = 0.f;
#pragma unroll
            for (int j = 0; j < 4; ++j) { v[j] = *(const f32x4*)(srow + 4 * F.lane + 256 * j);
                am = fmaxf(am, fmaxf(fmaxf(fabsf(v[j].x), fabsf(v[j].y)), fmaxf(fabsf(v[j].z), fabsf(v[j].w)))); }
#pragma unroll
            for (int o = 1; o < 64; o <<= 1) am = fmaxf(am, __shfl_xor(am, o));
            unsigned* drow = (unsigned*)((isv ? F.V8 : F.U8) + (size_t)e * D);
            if (isv) {
                const float inv = am > 0.f ? 432.f / am : 0.f;
#pragma unroll
                for (int j = 0; j < 4; ++j) { int p = __builtin_amdgcn_cvt_pk_fp8_f32(v[j].x * inv, v[j].y * inv, 0, false); p = __builtin_amdgcn_cvt_pk_fp8_f32(v[j].z * inv, v[j].w * inv, p, true);
                    drow[F.lane + 64 * j] = (unsigned)p; }
                if (F.lane == 0) F.SV[e] = am * (1.f / 432.f);
            } else {
                const float inv = am > 0.f ? 127.f / am : 0.f;
#pragma unroll
                for (int j = 0; j < 4; ++j) {
                    const int q0 = (int)rintf(v[j].x * inv), q1 = (int)rintf(v[j].y * inv), q2 = (int)rintf(v[j].z * inv), q3 = (int)rintf(v[j].w * inv);
                    drow[F.lane + 64 * j] = (unsigned)(q0 & 255) | ((unsigned)(q1 & 255) << 8) | ((unsigned)(q2 & 255) << 16) | ((unsigned)(q3 & 255) << 24); }
                if (F.lane == 0) F.SU[e] = am * (1.f / 127.f);
            }
        }
    }
}

__device__ __forceinline__ void modnorm_row(const float* xrow, const float* w, const float* shift, const float* scale, bf16* orow, int lane) {
    f32x4 v[4]; float s = 0.f;
#pragma unroll
    for (int j = 0; j < 4; ++j) { v[j] = *(const f32x4*)(xrow + 4 * lane + 256 * j); s += (v[j].x * v[j].x + v[j].y * v[j].y) + (v[j].z * v[j].z + v[j].w * v[j].w); }
    const float rstd = 1.f / sqrtf(wave_sum(s) * (1.f / D) + EPS);
#pragma unroll
    for (int j = 0; j < 4; ++j) { const int col = 4 * lane + 256 * j;
        const f32x4 wv = *(const f32x4*)(w + col), sh = *(const f32x4*)(shift + col), sc = *(const f32x4*)(scale + col);
        const f32x4 y = v[j] * rstd * wv * (sc + 1.f) + sh;
        v2u o; o.x = pk2(y.x, y.y); o.y = pk2(y.z, y.w); *(v2u*)(orow + col) = o; }
}

__device__ __forceinline__ void p3_local(Ctx& F) {
    LAS unsigned char* KT = F.lds;
    LAS unsigned char* VT = F.lds + 18432;
    LAS float* QT = (LAS float*)(F.lds + 36864);
    LAS unsigned char* OUT = F.lds + 38912;
    const int tid = F.tid, lane = F.lane, wave = F.wave, fr = lane & 15, fq = lane >> 4;
    for (int u = F.bid; u < 1024; u += F.G) {
        const int bh = u >> 7, c = u & 127, b = bh >> 2, hh = bh & 3;
        const size_t r0 = (size_t)b * SEQ + (size_t)c * 64;
        const int d = tid & 127, tq = tid >> 7;
        const bf16* pf = F.PROJ + (r0 + 16 * tq) * NIN + 512 + hh * 128 + d;
        const bf16* pv = F.PROJ + (r0 + 16 * tq) * NIN + 1024 + hh * 128 + d;
        const float lbv = F.LB[hh * 128 + d], oml = 1.f - lbv;
        unsigned short fraw[16], vraw[16];
#pragma unroll
        for (int j = 0; j < 16; ++j) { fraw[j] = pf[(size_t)j * NIN]; vraw[j] = pv[(size_t)j * NIN]; }
        float cs[16], kk[16]; float run = 0.f;
#pragma unroll
        for (int j = 0; j < 16; ++j) { const float fv = bf2f(fraw[j]); const float e = __expf(-fv); const float sg = 1.f / (1.f + e);
            const float f = lbv + oml * sg; run += __logf(f); cs[j] = run; kk[j] = oml * (e * sg); }
        QT[tq * 128 + d] = run;
        __syncthreads();
        float prefix = 0.f, total = 0.f;
#pragma unroll
        for (int q = 0; q < 4; ++q) { const float t = QT[q * 128 + d]; total += t; if (q < tq) prefix += t; }
        unsigned kp[8], vp[8];
#pragma unroll
        for (int j = 0; j < 8; ++j) { const float k0 = kk[2 * j] * __expf(total - (prefix + cs[2 * j])), k1 = kk[2 * j + 1] * __expf(total - (prefix + cs[2 * j + 1]));
            kp[j] = pk2(k0, k1); vp[j] = (unsigned)vraw[2 * j] | ((unsigned)vraw[2 * j + 1] << 16); }
        *(LAS v4u*)(KT + d * 144 + tq * 32) = (v4u){kp[0], kp[1], kp[2], kp[3]}; *(LAS v4u*)(KT + d * 144 + tq * 32 + 16) = (v4u){kp[4], kp[5], kp[6], kp[7]};
        *(LAS v4u*)(VT + d * 144 + tq * 32) = (v4u){vp[0], vp[1], vp[2], vp[3]}; *(LAS v4u*)(VT + d * 144 + tq * 32 + 16) = (v4u){vp[4], vp[5], vp[6], vp[7]};
        if (tq == 0) F.ACH[u * 128 + d] = __expf(total);
        __syncthreads();
        {
            const int dblk = wave & 3, vh = wave >> 2;
            f32x4 acc[2][4];
#pragma unroll
            for (int a = 0; a < 2; ++a)
#pragma unroll
                for (int n = 0; n < 4; ++n) acc[a][n] = (f32x4){0.f, 0.f, 0.f, 0.f};
#pragma unroll
            for (int k2 = 0; k2 < 2; ++k2) {
                bf16x8 af[2], bfv[4];
#pragma unroll
                for (int a = 0; a < 2; ++a) af[a] = *(const LAS bf16x8*)(KT + (dblk * 32 + a * 16 + fr) * 144 + (k2 * 32 + fq * 8) * 2);
#pragma unroll
                for (int n = 0; n < 4; ++n) bfv[n] = *(const LAS bf16x8*)(VT + (vh * 64 + n * 16 + fr) * 144 + (k2 * 32 + fq * 8) * 2);
#pragma unroll
                for (int a = 0; a < 2; ++a)
#pragma unroll
                    for (int n = 0; n < 4; ++n) acc[a][n] = __builtin_amdgcn_mfma_f32_16x16x32_bf16(af[a], bfv[n], acc[a][n], 0, 0, 0);
            }
#pragma unroll
            for (int a = 0; a < 2; ++a)
#pragma unroll
                for (int n = 0; n < 4; ++n) { const int v = vh * 64 + n * 16 + fr, dd = dblk * 32 + a * 16 + 4 * fq;
                    *(LAS v2u*)(OUT + v * 272 + dd * 2) = (v2u){pk2(acc[a][n][0], acc[a][n][1]), pk2(acc[a][n][2], acc[a][n][3])}; }
        }
        __syncthreads();
        { const int row = tid >> 2, part = tid & 3; bf16* dst = F.ST + (size_t)u * 16384 + row * 128 + part * 32;
#pragma unroll
            for (int i = 0; i < 4; ++i) *(v4u*)(dst + i * 8) = *(const LAS v4u*)(OUT + row * 272 + part * 64 + i * 16); }
        __syncthreads();
    }
    {
        const int gw = F.bid * NWAVES + F.wave, NGW = F.G * NWAVES;
        const int ch = lane * 8;
        float w0[8], w1[8], w2[8], ow[8];
#pragma unroll
        for (int j = 0; j < 8; ++j) { w0[j] = F.conv_w[ch + j]; w1[j] = F.conv_w[512 + ch + j]; w2[j] = F.conv_w[1024 + ch + j]; ow[j] = F.conv_onorm_w[ch + j]; }
        for (int run = gw; run < M / 8; run += NGW) {
            const int rbase = run * 8;
            float u1[8], u2[8];
#pragma unroll
            for (int j = 0; j < 8; ++j) { u1[j] = 0.f; u2[j] = 0.f; }
            const int tpos = rbase & (SEQ - 1);
            if (tpos >= 1) { const bf16* p = F.PROJ + (size_t)(rbase - 1) * NIN + 2048 + ch; const v4u cc = *(const v4u*)(p + 512), xx = *(const v4u*)(p + 1024);
#pragma unroll
                for (int j = 0; j < 4; ++j) { const unsigned cw = cc[j], xw = xx[j]; u1[2 * j] = bf2f(cw & 0xffffu) * bf2f(xw & 0xffffu); u1[2 * j + 1] = bf2f(cw >> 16) * bf2f(xw >> 16); } }
            if (tpos >= 2) { const bf16* p = F.PROJ + (size_t)(rbase - 2) * NIN + 2048 + ch; const v4u cc = *(const v4u*)(p + 512), xx = *(const v4u*)(p + 1024);
#pragma unroll
                for (int j = 0; j < 4; ++j) { const unsigned cw = cc[j], xw = xx[j]; u2[2 * j] = bf2f(cw & 0xffffu) * bf2f(xw & 0xffffu); u2[2 * j + 1] = bf2f(cw >> 16) * bf2f(xw >> 16); } }
            for (int t = 0; t < 8; ++t) {
                const bf16* p = F.PROJ + (size_t)(rbase + t) * NIN + 2048 + ch;
                const v4u bb = *(const v4u*)(p), cc = *(const v4u*)(p + 512), xx = *(const v4u*)(p + 1024);
                float u0[8], y[8]; float ss = 0.f;
#pragma unroll
                for (int j = 0; j < 4; ++j) { const unsigned cw = cc[j], xw = xx[j]; u0[2 * j] = bf2f(cw & 0xffffu) * bf2f(xw & 0xffffu); u0[2 * j + 1] = bf2f(cw >> 16) * bf2f(xw >> 16); }
#pragma unroll
                for (int j = 0; j < 8; ++j) { const float bg = bf2f((j & 1) ? (bb[j >> 1] >> 16) : (bb[j >> 1] & 0xffffu));
                    y[j] = bg * (w0[j] * u2[j] + w1[j] * u1[j] + w2[j] * u0[j]); ss += y[j] * y[j]; }
                ss += __shfl_xor(ss, 1); ss += __shfl_xor(ss, 2); ss += __shfl_xor(ss, 4); ss += __shfl_xor(ss, 8);
                const float rstd = 1.f / sqrtf(ss * (1.f / 128.f) + EPS);
                v4u o; o.x = pk2(y[0] * rstd * ow[0], y[1] * rstd * ow[1]); o.y = pk2(y[2] * rstd * ow[2], y[3] * rstd * ow[3]);
                o.z = pk2(y[4] * rstd * ow[4], y[5] * rstd * ow[5]); o.w = pk2(y[6] * rstd * ow[6], y[7] * rstd * ow[7]);
                *(v4u*)(F.YCAT + (size_t)(rbase + t) * D + 512 + ch) = o;
#pragma unroll
                for (int j = 0; j < 8; ++j) { u2[j] = u1[j]; u1[j] = u0[j]; }
            }
        }
    }
}

__device__ __forceinline__ void p4_scan(Ctx& F) {
    const int gtid = F.bid * NTHR + F.tid;
    if (gtid >= 65536) return;
    const int bh = gtid >> 13, e2 = gtid & 8191, v = e2 >> 6, d = (e2 & 63) * 2;
    unsigned* p = (unsigned*)(F.ST + (size_t)bh * 128 * 16384 + v * 128 + d);
    const float* a = F.ACH + (size_t)bh * 128 * 128 + d;
    float s0 = 0.f, s1 = 0.f;
#pragma unroll 8
    for (int c = 0; c < 128; ++c) {
        const unsigned uu = p[(size_t)c * 8192]; const float a0 = a[c * 128], a1 = a[c * 128 + 1];
        p[(size_t)c * 8192] = pk2(s0, s1);
        s0 = a0 * s0 + bf2f(uu & 0xffffu); s1 = a1 * s1 + bf2f(uu >> 16);
    }
}

__device__ __forceinline__ void p5_out(Ctx& F) {
    LAS unsigned char* QM = F.lds;
    LAS unsigned char* Q0 = F.lds + 17408;
    LAS unsigned char* KM = F.lds + 34816;
    LAS unsigned char* VT = F.lds + 52224;
    LAS unsigned char* STL = F.lds + 70656;
    LAS float* QT = (LAS float*)(F.lds + 105472);
    LAS unsigned char* PB = F.lds + 107520;
    LAS float* NRM = (LAS float*)(F.lds + 125952);
    const int tid = F.tid, lane = F.lane, wave = F.wave, fr = lane & 15, fq = lane >> 4;
    for (int u = F.bid; u < 1024; u += F.G) {
        const int bh = u >> 7, c = u & 127, b = bh >> 2, hh = bh & 3;
        const size_t r0 = (size_t)b * SEQ + (size_t)c * 64;
        const int d = tid & 127, tq = tid >> 7;
        const bf16* pq = F.PROJ + (r0 + 16 * tq) * NIN + hh * 128 + d;
        const float lbv = F.LB[hh * 128 + d], oml = 1.f - lbv;
        unsigned short qraw[16], fraw[16], vraw[16];
#pragma unroll
        for (int j = 0; j < 16; ++j) { qraw[j] = pq[(size_t)j * NIN]; fraw[j] = pq[(size_t)j * NIN + 512]; vraw[j] = pq[(size_t)j * NIN + 1024]; }
        {
            const bf16* src = F.ST + (size_t)u * 16384;
#pragma unroll
            for (int i = 0; i < 4; ++i) { const int row = (tid >> 4) + 32 * i, ck = tid & 15; *(LAS v4u*)(STL + row * 272 + ck * 16) = *(const v4u*)(src + row * 128 + ck * 8); }
        }
        float cs[16], kk[16]; float run = 0.f;
#pragma unroll
        for (int j = 0; j < 16; ++j) { const float fv = bf2f(fraw[j]); const float e = __expf(-fv); const float sg = 1.f / (1.f + e);
            const float f = lbv + oml * sg; run += __logf(f); cs[j] = run; kk[j] = oml * (e * sg); }
        QT[tq * 128 + d] = run;
        __syncthreads();
        float prefix = 0.f; const float q0t = QT[d], q1t = QT[128 + d], q2t = QT[256 + d];
        if (tq >= 1) prefix += q0t; if (tq >= 2) prefix += q1t; if (tq >= 3) prefix += q2t;
        const float bmid = q0t + q1t;
        unsigned vp[8];
#pragma unroll
        for (int j = 0; j < 16; ++j) { const float bj = prefix + cs[j]; const float qv = bf2f(qraw[j]); const int t = 16 * tq + j;
            *(LAS unsigned short*)(QM + t * 272 + d * 2) = (unsigned short)f2bf(qv * __expf(bj - bmid));
            *(LAS unsigned short*)(Q0 + t * 272 + d * 2) = (unsigned short)f2bf(qv * __expf(bj));
            *(LAS unsigned short*)(KM + t * 272 + d * 2) = (unsigned short)f2bf(kk[j] * __expf(bmid - bj)); }
#pragma unroll
        for (int j = 0; j < 8; ++j) vp[j] = (unsigned)vraw[2 * j] | ((unsigned)vraw[2 * j + 1] << 16);
        *(LAS v4u*)(VT + d * 144 + tq * 32) = (v4u){vp[0], vp[1], vp[2], vp[3]}; *(LAS v4u*)(VT + d * 144 + tq * 32 + 16) = (v4u){vp[4], vp[5], vp[6], vp[7]};
        __syncthreads();
        const int rb = wave >> 1, vh = wave & 1;
        LAS unsigned char* P = PB + wave * 2304;
        {
            f32x4 sc[4];
#pragma unroll
            for (int sf = 0; sf < 4; ++sf) sc[sf] = (f32x4){0.f, 0.f, 0.f, 0.f};
#pragma unroll
            for (int k4 = 0; k4 < 4; ++k4) {
                const bf16x8 bq = *(const LAS bf16x8*)(QM + (16 * rb + fr) * 272 + (k4 * 32 + fq * 8) * 2);
#pragma unroll
                for (int sf = 0; sf < 4; ++sf) { const bf16x8 ak = *(const LAS bf16x8*)(KM + (16 * sf + fr) * 272 + (k4 * 32 + fq * 8) * 2);
                    sc[sf] = __builtin_amdgcn_mfma_f32_16x16x32_bf16(ak, bq, sc[sf], 0, 0, 0); }
            }
            const int t = 16 * rb + fr;
#pragma unroll
            for (int sf = 0; sf < 4; ++sf) { const int s0 = 16 * sf + 4 * fq;
                const float p0 = (s0 + 0 <= t) ? sc[sf][0] : 0.f, p1 = (s0 + 1 <= t) ? sc[sf][1] : 0.f, p2 = (s0 + 2 <= t) ? sc[sf][2] : 0.f, p3 = (s0 + 3 <= t) ? sc[sf][3] : 0.f;
                *(LAS v2u*)(P + fr * 144 + s0 * 2) = (v2u){pk2(p0, p1), pk2(p2, p3)}; }
        }
        __syncthreads();
        f32x4 oc[4];
#pragma unroll
        for (int n = 0; n < 4; ++n) oc[n] = (f32x4){0.f, 0.f, 0.f, 0.f};
#pragma unroll
        for (int k2 = 0; k2 < 2; ++k2) {
            const bf16x8 bp = *(const LAS bf16x8*)(P + fr * 144 + (k2 * 32 + fq * 8) * 2);
#pragma unroll
            for (int n = 0; n < 4; ++n) { const bf16x8 av = *(const LAS bf16x8*)(VT + (64 * vh + 16 * n + fr) * 144 + (k2 * 32 + fq * 8) * 2);
                oc[n] = __builtin_amdgcn_mfma_f32_16x16x32_bf16(av, bp, oc[n], 0, 0, 0); }
        }
#pragma unroll
        for (int k4 = 0; k4 < 4; ++k4) {
            const bf16x8 bq = *(const LAS bf16x8*)(Q0 + (16 * rb + fr) * 272 + (k4 * 32 + fq * 8) * 2);
#pragma unroll
            for (int n = 0; n < 4; ++n) { const bf16x8 as = *(const LAS bf16x8*)(STL + (64 * vh + 16 * n + fr) * 272 + (k4 * 32 + fq * 8) * 2);
                oc[n] = __builtin_amdgcn_mfma_f32_16x16x32_bf16(as, bq, oc[n], 0, 0, 0); }
        }
        float ss = 0.f;
#pragma unroll
        for (int n = 0; n < 4; ++n) ss += (oc[n][0] * oc[n][0] + oc[n][1] * oc[n][1]) + (oc[n][2] * oc[n][2] + oc[n][3] * oc[n][3]);
        ss += __shfl_xor(ss, 16); ss += __shfl_xor(ss, 32);
        if (fq == 0) NRM[(16 * rb + fr) * 2 + vh] = ss;
        __syncthreads();
        {
            const int t = 16 * rb + fr; const float tot = NRM[t * 2] + NRM[t * 2 + 1];
            const float rstd = 1.f / sqrtf(tot * (1.f / 128.f) + EPS);
            const bf16* pg = F.PROJ + (r0 + t) * NIN + 1536 + hh * 128;
            bf16* po = F.YCAT + (r0 + t) * D + hh * 128;
#pragma unroll
            for (int n = 0; n < 4; ++n) { const int v = 64 * vh + 16 * n + 4 * fq;
                const v2u gw = *(const v2u*)(pg + v); const f32x4 wv = *(const f32x4*)(F.hgrn_onorm_w + hh * 128 + v);
                float g[4] = {bf2f(gw.x & 0xffffu), bf2f(gw.x >> 16), bf2f(gw.y & 0xffffu), bf2f(gw.y >> 16)}; float o[4];
#pragma unroll
                for (int j = 0; j < 4; ++j) { const float sl = g[j] / (1.f + __expf(-g[j])); o[j] = oc[n][j] * rstd * wv[j] * sl; }
                *(v2u*)(po + v) = (v2u){pk2(o[0], o[1]), pk2(o[2], o[3])}; }
        }
        __syncthreads();
    }
}

__device__ __forceinline__ unsigned f2ord(float f) { const unsigned u = __float_as_uint(f); return (u & 0x80000000u) ? ~u : (u | 0x80000000u); }
__device__ __forceinline__ float ord2f(unsigned o) { return __uint_as_float((o & 0x80000000u) ? (o & 0x7fffffffu) : ~o); }
__device__ __forceinline__ void ce_desc(unsigned& a, unsigned& b) { const unsigned mx = a > b ? a : b, mn = a > b ? b : a; a = mx; b = mn; }
template <int N> __device__ __forceinline__ void bitonic_sort_desc(unsigned (&k)[N]) {
#pragma unroll
    for (int size = 2; size <= N; size <<= 1) {
#pragma unroll
        for (int stride = size >> 1; stride > 0; stride >>= 1) {
#pragma unroll
            for (int i = 0; i < N; ++i) { const int j = i ^ stride; if (j > i) { if ((i & size) == 0) ce_desc(k[i], k[j]); else ce_desc(k[j], k[i]); } }
        }
    }
}
__device__ __forceinline__ void bitonic_merge16_desc(unsigned (&k)[16]) {
#pragma unroll
    for (int stride = 8; stride > 0; stride >>= 1) {
#pragma unroll
        for (int i = 0; i < 16; ++i) { const int j = i ^ stride; if (j > i) ce_desc(k[i], k[j]); }
    }
}
__device__ __forceinline__ void merge_top16(unsigned (&a)[16], const unsigned (&b)[16]) {
#pragma unroll
    for (int i = 0; i < 16; ++i) a[i] = a[i] > b[15 - i] ? a[i] : b[15 - i];
    bitonic_merge16_desc(a);
}
__device__ __forceinline__ float gelu_as(float v) {
    const float av = fabsf(v), t = __builtin_amdgcn_rcpf(av * 0.2316418882f + 1.0f);
    float q = t * 0.5307027145f + (-0.7265760135f); q = q * t + 0.7107068705f; q = q * t + (-0.142248368f); q = q * t + 0.127414796f; q = q * t;
    const float e = __builtin_amdgcn_exp2f((v * v) * (-0.72134752044f));
    const float m = v * (q * e);
    return v < 0.f ? m : v - m;
}
__device__ __forceinline__ float gelu_erf(float x) { return 0.5f * x * (1.f + erff(x * 0.70710678118654752f)); }

__device__ __forceinline__ int row16_sum_i32(int v) {
    v += __builtin_amdgcn_update_dpp(0, v, 0xB1, 0xf, 0xf, true);
    v += __builtin_amdgcn_update_dpp(0, v, 0x4E, 0xf, 0xf, true);
    v += __builtin_amdgcn_update_dpp(0, v, 0x141, 0xf, 0xf, true);
    v += __builtin_amdgcn_update_dpp(0, v, 0x140, 0xf, 0xf, true);
    return v;
}
__device__ __forceinline__ void p9_peer(Ctx& F) {
    LAS unsigned* TOP = (LAS unsigned*)F.lds;
    LAS v2u* IDXS = (LAS v2u*)(F.lds + 65536);
    LAS v4u* CNT = (LAS v4u*)(F.lds + 131072);
    LAS unsigned char* OFFS = F.lds + 139264;
    LAS float* SH = (LAS float*)(F.lds + 141312);
    LAS unsigned char* HQ = F.lds;
    const int tid = F.tid, lane = F.lane, wave = F.wave, fr = lane & 15, fq = lane >> 4;
    for (int tile = F.bid; tile < M / 64; tile += F.G) {
        const size_t r0 = (size_t)tile * 64;
        {
            const int p = wave >> 2, tb = wave & 3;
            LAS unsigned char* KL = F.lds + 65536;
            v4u kpre[8]; bf16x8 qpre[4];
            const bf16* qbase = F.QP + (r0 + 16 * tb + fr) * NQ + p * 128 + fq * 8;
#pragma unroll
            for (int i = 0; i < 8; ++i) kpre[i] = *(const v4u*)(F.KEYS + (size_t)(tid + 512 * i) * 8);
#pragma unroll
            for (int k4 = 0; k4 < 4; ++k4) qpre[k4] = *(const bf16x8*)(qbase + k4 * 32);
#pragma unroll 1
            for (int h = 0; h < 8; ++h) {
#pragma unroll
                for (int i = 0; i < 8; ++i) { const int c = tid + 512 * i; *(LAS v4u*)(KL + (c >> 4) * 272 + (c & 15) * 16) = kpre[i]; }
                bf16x8 bq[4];
#pragma unroll
                for (int k4 = 0; k4 < 4; ++k4) bq[k4] = qpre[k4];
                __syncthreads();
                if (h < 7) {
#pragma unroll
                    for (int i = 0; i < 8; ++i) kpre[i] = *(const v4u*)(F.KEYS + (size_t)(h + 1) * 32768 + (size_t)(tid + 512 * i) * 8);
#pragma unroll
                    for (int k4 = 0; k4 < 4; ++k4) qpre[k4] = *(const bf16x8*)(qbase + (h + 1) * 256 + k4 * 32);
                }
                f32x4 sc[8];
#pragma unroll
                for (int nf = 0; nf < 8; ++nf) sc[nf] = (f32x4){0.f, 0.f, 0.f, 0.f};
                const LAS unsigned char* krow = KL + (p * 128 + fr) * 272 + fq * 16;
#pragma unroll
                for (int k4 = 0; k4 < 4; ++k4) {
#pragma unroll
                    for (int nf = 0; nf < 8; ++nf) { const bf16x8 ak = *(const LAS bf16x8*)(krow + nf * 16 * 272 + k4 * 64);
                        sc[nf] = __builtin_amdgcn_mfma_f32_16x16x32_bf16(ak, bq[k4], sc[nf], 0, 0, 0); }
                }
                unsigned ka[16], kb[16];
#pragma unroll
                for (int nf = 0; nf < 4; ++nf)
#pragma unroll
                    for (int r = 0; r < 4; ++r) {
                        ka[nf * 4 + r] = (f2ord(sc[nf][r]) & ~127u) | (unsigned)(127 - (16 * nf + 4 * fq + r));
                        kb[nf * 4 + r] = (f2ord(sc[nf + 4][r]) & ~127u) | (unsigned)(127 - (16 * (nf + 4) + 4 * fq + r)); }
                bitonic_sort_desc<16>(ka); bitonic_sort_desc<16>(kb);
                merge_top16(ka, kb);
                {
                    unsigned o[16];
#pragma unroll
                    for (int i = 0; i < 16; ++i) o[i] = (unsigned)__shfl_xor((int)ka[i], 16);
                    merge_top16(ka, o);
#pragma unroll
                    for (int i = 0; i < 16; ++i) o[i] = (unsigned)__shfl_xor((int)ka[i], 32);
                    merge_top16(ka, o);
                }
                if (fq == 0) { LAS v4u* dst = (LAS v4u*)(TOP + (((16 * tb + fr) * 8 + h) * 2 + p) * 16);
                    dst[0] = (v4u){ka[0], ka[1], ka[2], ka[3]}; dst[1] = (v4u){ka[4], ka[5], ka[6], ka[7]}; dst[2] = (v4u){ka[8], ka[9], ka[10], ka[11]}; dst[3] = (v4u){ka[12], ka[13], ka[14], ka[15]}; }
                __syncthreads();
            }
        }
        __syncthreads();
        {
            const int t = tid >> 3, h = tid & 7;
            const LAS unsigned* pa = TOP + ((t * 8 + h) * 2) * 16; const LAS unsigned* pb = pa + 16;
            float av[16], bv[16];
            { const LAS v4u* qa = (const LAS v4u*)pa; const LAS v4u* qb = (const LAS v4u*)pb;
#pragma unroll
              for (int i = 0; i < 4; ++i) { const v4u x = qa[i], y = qb[i];
#pragma unroll
                  for (int j = 0; j < 4; ++j) { av[4 * i + j] = ord2f(x[j] & ~127u); bv[4 * i + j] = ord2f(y[j] & ~127u); } } }
            unsigned c0[16], c1[16], c2[16], c3[16];
#pragma unroll
            for (int i = 0; i < 16; ++i) { c0[i] = 0u; c1[i] = 0u; c2[i] = 0u; c3[i] = 0u; }
            {
                int n = 0;
#pragma unroll
                for (int i = 0; i < 16; ++i)
#pragma unroll
                    for (int j = 0; j < 16; ++j) if ((i + 1) * (j + 1) <= 16) {
                        const unsigned key = (f2ord(av[i] + bv[j]) & ~255u) | (unsigned)(255 - (i * 16 + j));
                        if (n < 16) c0[n] = key; else if (n < 32) c1[n - 16] = key; else if (n < 48) c2[n - 32] = key; else c3[n - 48] = key;
                        ++n; }
            }
            bitonic_sort_desc<16>(c0); bitonic_sort_desc<16>(c1); bitonic_sort_desc<16>(c2); bitonic_sort_desc<16>(c3);
            merge_top16(c0, c1); merge_top16(c2, c3); merge_top16(c0, c2);
            float sv[16]; unsigned ix[16]; float mx = -3.0e38f;
#pragma unroll
            for (int k = 0; k < 16; ++k) { const unsigned pos = 255u - (c0[k] & 255u); const unsigned ua = pa[pos >> 4], ub = pb[pos & 15];
                sv[k] = ord2f(ua & ~127u) + ord2f(ub & ~127u); ix[k] = (127u - (ua & 127u)) * 128u + (127u - (ub & 127u)); mx = fmaxf(mx, sv[k]); }
            float sum = 0.f;
#pragma unroll
            for (int k = 0; k < 16; ++k) { sv[k] = __expf(sv[k] - mx); sum += sv[k]; }
            const float inv = 1.f / sum;
            unsigned c4[4] = {0u, 0u, 0u, 0u};
#pragma unroll
            for (int k = 0; k < 16; ++k) { const unsigned s = ix[k] >> 11, inc = 1u << ((s & 3u) * 8u);
#pragma unroll
                for (int w = 0; w < 4; ++w) c4[w] += ((s >> 2) == (unsigned)w) ? inc : 0u; }
            CNT[t * 8 + h] = (v4u){c4[0], c4[1], c4[2], c4[3]};
            unsigned e0[16]; float e1[16];
#pragma unroll
            for (int k = 0; k < 16; ++k) { e0[k] = ix[k] << 10; e1[k] = __uint_as_float((f2bf(sv[k] * inv * F.SV[ix[k]]) << 16) | f2bf(F.SU[ix[k]])); }
            __syncthreads();
            unsigned A4[4] = {0u, 0u, 0u, 0u}, B4[4] = {0u, 0u, 0u, 0u};
#pragma unroll
            for (int hh = 0; hh < 8; ++hh) { const v4u v = CNT[t * 8 + hh];
#pragma unroll
                for (int w = 0; w < 4; ++w) { A4[w] += v[w]; B4[w] += (hh < h) ? v[w] : 0u; } }
            unsigned off4[4] = {0u, 0u, 0u, 0u}; unsigned run = 0u;
#pragma unroll
            for (int s = 0; s < 16; ++s) { off4[s >> 2] |= run << ((s & 3) * 8); run += (A4[s >> 2] >> ((s & 3) * 8)) & 255u; }
            if (h == 0) { *(LAS v4u*)(OFFS + t * 32) = (v4u){off4[0], off4[1], off4[2], off4[3]}; OFFS[t * 32 + 16] = (unsigned char)128; }
            unsigned base4[4], r4[4] = {0u, 0u, 0u, 0u};
#pragma unroll
            for (int w = 0; w < 4; ++w) base4[w] = off4[w] + B4[w];
#pragma unroll
            for (int k = 0; k < 16; ++k) { const unsigned s = ix[k] >> 11, wsel = s >> 2, sh8 = (s & 3u) * 8u;
                const unsigned bsel = wsel == 0 ? base4[0] : wsel == 1 ? base4[1] : wsel == 2 ? base4[2] : base4[3];
                const unsigned rsel = wsel == 0 ? r4[0] : wsel == 1 ? r4[1] : wsel == 2 ? r4[2] : r4[3];
                const unsigned pos = ((bsel >> sh8) & 255u) + ((rsel >> sh8) & 255u);
                IDXS[t * 128 + pos] = (v2u){e0[k], __float_as_uint(e1[k])};
#pragma unroll
                for (int w = 0; w < 4; ++w) r4[w] += (wsel == (unsigned)w) ? (1u << sh8) : 0u; }
        }
        __syncthreads();
        {
#pragma unroll 2
            for (int tk = 0; tk < 8; ++tk) { const int tl = wave * 8 + tk; const size_t row = r0 + tl;
                const v4u a = *(const v4u*)(F.H2 + row * D + 16 * lane), bq = *(const v4u*)(F.H2 + row * D + 16 * lane + 8);
                float hv[16]; float am = 0.f;
#pragma unroll
                for (int w = 0; w < 4; ++w) { hv[2 * w] = bf2f(a[w] & 0xffffu); hv[2 * w + 1] = __uint_as_float(a[w] & 0xffff0000u); hv[8 + 2 * w] = bf2f(bq[w] & 0xffffu); hv[8 + 2 * w + 1] = __uint_as_float(bq[w] & 0xffff0000u); }
#pragma unroll
                for (int i = 0; i < 16; ++i) am = fmaxf(am, fabsf(hv[i]));
#pragma unroll
                for (int o = 1; o < 64; o <<= 1) am = fmaxf(am, __shfl_xor(am, o));
                const float inv = am > 0.f ? 127.f / am : 0.f; unsigned hq[4];
#pragma unroll
                for (int i = 0; i < 4; ++i) { const int q0 = (int)rintf(hv[4 * i] * inv), q1 = (int)rintf(hv[4 * i + 1] * inv), q2 = (int)rintf(hv[4 * i + 2] * inv), q3 = (int)rintf(hv[4 * i + 3] * inv);
                    hq[i] = (unsigned)(q0 & 255) | ((unsigned)(q1 & 255) << 8) | ((unsigned)(q2 & 255) << 16) | ((unsigned)(q3 & 255) << 24); }
                *(LAS v4u*)(HQ + tl * 1024 + 16 * lane) = (v4u){hq[0], hq[1], hq[2], hq[3]};
                if (lane == 0) SH[tl] = am * (1.f / 127.f); }
        }
        __syncthreads();
        {
            const int c16 = lane & 15, rp = lane >> 4;
            f32x2 acc[8][8];
#pragma unroll
            for (int tk = 0; tk < 8; ++tk) {
#pragma unroll
                for (int i = 0; i < 8; ++i) acc[tk][i] = (f32x2){0.f, 0.f}; }
#pragma unroll 1
            for (int s = 0; s < 16; ++s) {
#pragma unroll
                for (int tk = 0; tk < 8; ++tk) {
                    const int tl = wave * 8 + tk;
                    const int n0 = OFFS[tl * 32 + s], n1 = OFFS[tl * 32 + s + 1];
                    if (n0 >= n1) continue;
                    const float sh = SH[tl];
                    const LAS v2u* ent = IDXS + tl * 128;
                    v4u hq[4];
#pragma unroll
                    for (int S = 0; S < 4; ++S) hq[S] = *(const LAS v4u*)(HQ + tl * 1024 + c16 * 16 + S * 256);
                    const unsigned uoff = (unsigned)c16 * 16u, voff = (unsigned)lane * 16u;
#pragma unroll 1
                    for (int i = n0; i < n1; i += 4) {
                        const int last = n1 - 1;
                        const int iu = (i + rp) < last ? (i + rp) : last;
                        const v2u eu = ent[iu];
                        v4u uu[4], vv[4]; float gsv[4];
#pragma unroll
                        for (int S = 0; S < 4; ++S) uu[S] = *(const v4u*)(F.U8 + (eu.x + uoff + (unsigned)S * 256u));
#pragma unroll
                        for (int j = 0; j < 4; ++j) { const int ij = (i + j) < last ? (i + j) : last; const v2u ev = ent[ij];
                            vv[j] = *(const v4u*)(F.V8 + (ev.x + voff)); gsv[j] = (i + j) <= last ? __uint_as_float(ev.y & 0xffff0000u) : 0.f; }
                        int dt = 0;
#pragma unroll
                        for (int S = 0; S < 4; ++S)
#pragma unroll
                            for (int w = 0; w < 4; ++w) dt = __builtin_amdgcn_sdot4((int)uu[S][w], (int)hq[S][w], dt, false);
                        dt = row16_sum_i32(dt);
                        const float gl = gelu_as((float)dt * (__uint_as_float(eu.y << 16) * sh));
#pragma unroll
                        for (int j = 0; j < 4; ++j) {
                            const float cj = __uint_as_float(__builtin_amdgcn_readlane(__float_as_uint(gl), 16 * j)) * gsv[j];
                            const f32x2 c2 = {cj, cj};
#pragma unroll
                            for (int w = 0; w < 4; ++w) { const int x = (int)vv[j][w];
                                acc[tk][2 * w] += c2 * __builtin_amdgcn_cvt_pk_f32_fp8(x, false);
                                acc[tk][2 * w + 1] += c2 * __builtin_amdgcn_cvt_pk_f32_fp8(x, true); }
                        }
                    }
                }
            }
#pragma unroll
            for (int tk = 0; tk < 8; ++tk) {
                const int tl = wave * 8 + tk; const size_t row = r0 + tl; const int b = (int)(row >> 13);
                float x2[16]; float ss = 0.f; const int d0i = 16 * lane;
#pragma unroll
                for (int q = 0; q < 4; ++q) { const f32x4 xa = *(const f32x4*)(F.out + row * D + d0i + 4 * q), ga = *(const f32x4*)(F.MOD + b * 6144 + 5120 + d0i + 4 * q);
#pragma unroll
                    for (int j = 0; j < 4; ++j) { const float a = acc[tk][2 * q + (j >> 1)][j & 1]; const float pv = a; x2[4 * q + j] = xa[j] + ga[j] * pv; ss += x2[4 * q + j] * x2[4 * q + j]; } }
                const float rstd = 1.f / sqrtf(wave_sum(ss) * (1.f / D) + EPS);
#pragma unroll
                for (int q = 0; q < 4; ++q) { const f32x4 wa = *(const f32x4*)(F.final_w + d0i + 4 * q); f32x4 oa;
#pragma unroll
                    for (int j = 0; j < 4; ++j) oa[j] = x2[4 * q + j] * rstd * wa[j];
                    *(f32x4*)(F.out + row * D + d0i + 4 * q) = oa; }
            }
        }
        __syncthreads();
    }
}

#define XB_TMO      128
#define XB_XCNT(j)  (256  + 64 * (j))
#define XB_XSUB(j)  (1280 + 64 * (j))
#define XB_XGEN(j)  (2304 + 64 * (j))
#define XB_TOP      3328
#define XB_TOPGEN   3392
#define XCD_BAR_WORDS 3456
#define XB_SPIN_CAP (1u << 20)
__device__ __forceinline__ unsigned xb_ld(unsigned* p)              { return __hip_atomic_load(p, __ATOMIC_RELAXED, __HIP_MEMORY_SCOPE_AGENT); }
__device__ __forceinline__ unsigned xb_add(unsigned* p, unsigned v) { return __hip_atomic_fetch_add(p, v, __ATOMIC_RELAXED, __HIP_MEMORY_SCOPE_AGENT); }
__device__ __forceinline__ unsigned xb_xcc_id() { return (unsigned)__builtin_amdgcn_s_getreg((3 << 11) | 20) & 0xFu; }
#define XB_SPIN(cond, bar) do { unsigned _sp = 0; while (cond) { __builtin_amdgcn_s_sleep(1); \
    if ((++_sp & 255u) == 0u) { if (xb_ld(&(bar)[XB_TMO])) break; if (_sp > XB_SPIN_CAP) { atomicAdd(&(bar)[XB_TMO], 1u); break; } } } } while (0)
struct XcdBarrier { unsigned* bar; unsigned x; volatile LAS unsigned* st; };
__device__ __forceinline__ XcdBarrier xcd_barrier_post(unsigned* bar, volatile LAS unsigned* st) {
    XcdBarrier b; b.bar = bar; b.x = xb_xcc_id(); b.st = st;
    if (threadIdx.x == 0) (void)xb_add(&bar[XB_XCNT(b.x)], 1u);
    return b;
}
__device__ __forceinline__ void xcd_barrier_complete(unsigned* bar, unsigned x, unsigned& nloc, unsigned& nx) {
    const unsigned G = gridDim.x * gridDim.y * gridDim.z;
    unsigned sum, cnt, mine, sp = 0u;
    for (;;) {
        sum = 0u; cnt = 0u; mine = 0u;
#pragma unroll
        for (unsigned j = 0; j < 16; ++j) { const unsigned c = xb_ld(&bar[XB_XCNT(j)]); sum += c; cnt += (c > 0u) ? 1u : 0u; mine = (j == x) ? c : mine; }
        if (sum == G) break;
        __builtin_amdgcn_s_sleep(1);
        if ((++sp & 255u) == 0u) { if (xb_ld(&bar[XB_TMO])) break; if (sp > XB_SPIN_CAP) { atomicAdd(&bar[XB_TMO], 1u); break; } }
    }
    nloc = mine > 0u ? mine : 1u; nx = cnt > 0u ? cnt : 1u;
}
__device__ __forceinline__ void xcd_barrier(const XcdBarrier& b) {
    asm volatile("s_waitcnt vmcnt(0)" ::: "memory");
    __syncthreads();
    if (threadIdx.x == 0) {
        unsigned* bar = b.bar;
        __builtin_amdgcn_s_waitcnt(0);
        unsigned nloc = b.st[0], nx = b.st[1];
        if (nloc == 0u) { xcd_barrier_complete(bar, b.x, nloc, nx); b.st[0] = nloc; b.st[1] = nx; }
        const unsigned old = xb_add(&bar[XB_XSUB(b.x)], 1u);
        const unsigned gen = old / nloc;
        if (old + 1u == (gen + 1u) * nloc) {
            __builtin_amdgcn_fence(__ATOMIC_RELEASE, "agent");
            asm volatile("s_waitcnt vmcnt(0)" ::: "memory");
            const unsigned og = xb_add(&bar[XB_TOP], 1u);
            const unsigned tg = og / nx;
            if (og + 1u == (tg + 1u) * nx) xb_add(&bar[XB_TOPGEN], 1u);
            else XB_SPIN(xb_ld(&bar[XB_TOPGEN]) == tg, bar);
            __builtin_amdgcn_fence(__ATOMIC_ACQUIRE, "agent");
            xb_add(&bar[XB_XGEN(b.x)], 1u);
            asm volatile("s_waitcnt vmcnt(0)" ::: "memory");
        } else {
            XB_SPIN(xb_ld(&bar[XB_XGEN(b.x)]) == gen, bar);
            __builtin_amdgcn_fence(__ATOMIC_ACQUIRE, "agent");
            asm volatile("s_waitcnt vmcnt(0)" ::: "memory");
        }
    }
    __syncthreads();
}

__global__ void __launch_bounds__(NTHR, 2) mk_fwd(Args args) {
    extern __shared__ __attribute__((aligned(16))) unsigned char lds_raw[];
    Ctx F;
    F.lds = (LAS unsigned char*)lds_raw;
    F.tid = threadIdx.x; F.lane = F.tid & 63; F.wave = __builtin_amdgcn_readfirstlane(F.tid >> 6); F.G = gridDim.x; F.bid = blockIdx.x;
    F.x = args.in[0]; F.c = args.in[1]; F.w_ada = args.in[2]; F.b_ada = args.in[3]; F.norm1_w = args.in[4]; F.w_in = args.in[5]; F.lb_logits = args.in[6];
    F.hgrn_onorm_w = args.in[7]; F.conv_w = args.in[8]; F.conv_onorm_w = args.in[9]; F.w_out = args.in[10]; F.norm2_w = args.in[11]; F.w_query = args.in[12];
    F.sub_keys = args.in[13]; F.peer_u = args.in[14]; F.peer_v = args.in[15]; F.final_w = args.in[16];
    F.out = args.out;
    unsigned char* ws = args.ws;
    F.ACH = (float*)(ws + WS_ACH); F.MOD = (float*)(ws + WS_MOD); F.LB = (float*)(ws + WS_LB);
    F.WIN = (bf16*)(ws + WS_WIN); F.WOUT = (bf16*)(ws + WS_WOUT); F.WQ = (bf16*)(ws + WS_WQ); F.KEYS = (bf16*)(ws + WS_KEYS);
    F.U8 = ws + WS_U8; F.V8 = ws + WS_V8; F.SU = (float*)(ws + WS_SU); F.SV = (float*)(ws + WS_SV); F.H1 = (bf16*)(ws + WS_H1); F.YCAT = (bf16*)(ws + WS_H1);
    F.PROJ = (bf16*)(ws + WS_PROJ); F.H2 = (bf16*)(ws + WS_PROJ); F.QP = (bf16*)(ws + WS_PROJ + 32 * MiB); F.ST = (bf16*)(ws + WS_ST);
    const int lo = args.ph_lo, hi = args.ph_hi;
    volatile LAS unsigned* MISC = (volatile LAS unsigned*)(F.lds + MISC_OFF);
    if (F.tid < 16) MISC[F.tid] = 0u;
    __syncthreads();
    XcdBarrier bar = xcd_barrier_post((unsigned*)(ws + WS_CTL), MISC);
#define IN(k) (lo <= (k) && (k) < hi)
#define SEAM(k) do { if (IN(k) && IN((k) + 1)) { xcd_barrier(bar); } } while (0)
    if (IN(0)) { for (int rep = 0; rep < NREP(0); ++rep) p0_prep(F); } SEAM(0);
    if (IN(1)) for (int rep = 0; rep < NREP(1); ++rep) { const int gw = F.bid * NWAVES + F.wave, NGW = F.G * NWAVES;
        for (int m = gw; m < M; m += NGW) { const float* md = F.MOD + (m >> 13) * 6144; modnorm_row(F.x + (size_t)m * D, F.norm1_w, md, md + 1024, F.H1 + (size_t)m * D, F.lane); } } SEAM(1);
    if (IN(2)) for (int rep = 0; rep < NREP(2); ++rep) { pg8::Gemm g{F.H1, F.WIN, M, NIN, D}; pg8::StaticOrder S; S.init(M, NIN, F.G, F.bid); pg8::EpiBf16 E{F.PROJ, NIN}; pg8::gemm_phase<pg8::EpiBf16>(F.lds, g, S, E); } SEAM(2);
    if (IN(3)) { for (int rep = 0; rep < NREP(3); ++rep) p3_local(F); } SEAM(3);
    if (IN(4)) { p4_scan(F); if (F.G >= 256) { if (F.bid >= 128) convert_experts(F, F.bid - 128, F.G - 128); } else convert_experts(F, F.bid, F.G); } SEAM(4);
    if (IN(5)) { for (int rep = 0; rep < NREP(5); ++rep) p5_out(F); } SEAM(5);
    if (IN(6)) for (int rep = 0; rep < NREP(6); ++rep) { pg8::Gemm g{F.YCAT, F.WOUT, M, D, D}; pg8::StaticOrder S; S.init(M, D, F.G, F.bid); pg8::EpiRes E{F.x, F.out, F.MOD}; pg8::gemm_phase<pg8::EpiRes>(F.lds, g, S, E); } SEAM(6);
    if (IN(7)) for (int rep = 0; rep < NREP(7); ++rep) { const int gw = F.bid * NWAVES + F.wave, NGW = F.G * NWAVES;
        for (int m = gw; m < M; m += NGW) { const float* md = F.MOD + (m >> 13) * 6144; modnorm_row(F.out + (size_t)m * D, F.norm2_w, md + 3072, md + 4096, F.H2 + (size_t)m * D, F.lane); } } SEAM(7);
    if (IN(8)) for (int rep = 0; rep < NREP(8); ++rep) { pg8::Gemm g{F.H2, F.WQ, M, NQ, D}; pg8::StaticOrder S; S.init(M, NQ, F.G, F.bid); pg8::EpiBf16 E{F.QP, NQ}; pg8::gemm_phase<pg8::EpiBf16>(F.lds, g, S, E); } SEAM(8);
#ifndef DBG_STOP
    if (IN(9)) { p9_peer(F); }
#else
    xcd_barrier(bar);
    {
        const size_t gt = (size_t)F.bid * NTHR + F.tid, gs = (size_t)F.G * NTHR;
        for (size_t i = gt; i < (size_t)M * D; i += gs) { const size_t r = i >> 10, c = i & 1023; float v = 0.f;
            if (DBG_STOP == 2) { const bf16* p = F.PROJ + r * NIN + c; v = bf2f(p[0]) + bf2f(p[1024]) + bf2f(p[2048]) + (c < 512 ? bf2f(p[3072]) : 0.f); }
            else if (DBG_STOP == 5) { v = bf2f(F.YCAT[r * D + c]); }
            else if (DBG_STOP == 6) { v = F.out[i]; }
            else if (DBG_STOP == 8) { v = bf2f(F.QP[r * NQ + c]) + bf2f(F.QP[r * NQ + c + 1024]); }
            else if (DBG_STOP == 4 || DBG_STOP == 3) { v = bf2f(F.ST[i]); }
            else if (DBG_STOP == 1) { v = bf2f(F.H1[i]); }
            F.out[i] = v; }
    }
#endif
#undef IN
#undef SEAM
}

extern "C" void kernel_launch(void* const* d_in, const int* in_sizes, int n_in, void* d_out, int out_size, void* d_ws, size_t ws_size, hipStream_t stream) {
    static int grid = 0;
    if (grid == 0) {
        if (n_in != 17 || out_size != M * D || ws_size < WS_END) { fprintf(stderr, "kernel_launch: unexpected shapes (n_in %d out %d ws %zu)\n", n_in, out_size, ws_size); grid = -1; return; }
        int dev = 0, cus = 0, per_cu = 0;
        (void)hipGetDevice(&dev); (void)hipDeviceGetAttribute(&cus, hipDeviceAttributeMultiprocessorCount, dev);
        if (hipFuncSetAttribute((const void*)mk_fwd, hipFuncAttributeMaxDynamicSharedMemorySize, LDS_BYTES) != hipSuccess) { fprintf(stderr, "kernel_launch: hipFuncSetAttribute failed\n"); grid = -1; return; }
        if (hipOccupancyMaxActiveBlocksPerMultiprocessor(&per_cu, (const void*)mk_fwd, NTHR, LDS_BYTES) != hipSuccess || per_cu < 1) { fprintf(stderr, "kernel_launch: occupancy query gives %d\n", per_cu); per_cu = 1; }
        (void)hipGetLastError();
        grid = cus;
    }
    if (grid < 0) return;
    if (hipMemsetAsync((char*)d_ws + WS_CTL, 0, CTL_ZERO_BYTES, stream) != hipSuccess) { fprintf(stderr, "kernel_launch: memset failed\n"); return; }
    Args a{};
    for (int i = 0; i < 17; ++i) a.in[i] = (const float*)d_in[i];
    a.out = (float*)d_out; a.ws = (unsigned char*)d_ws;
#if MK_LAUNCHES == 1
#ifdef DBG_STOP
    a.ph_lo = 0; a.ph_hi = DBG_STOP + 1;
#else
    a.ph_lo = 0; a.ph_hi = 10;
#endif
    void* kargs[] = {&a};
    hipError_t e = hipLaunchCooperativeKernel((const void*)mk_fwd, dim3(grid), dim3(NTHR), kargs, LDS_BYTES, stream);
    if (e != hipSuccess) fprintf(stderr, "kernel_launch: cooperative launch failed: %s (grid %d)\n", hipGetErrorString(e), grid);
#else
    for (int ph = 0; ph < 10; ++ph) { a.ph_lo = ph; a.ph_hi = ph + 1; hipLaunchKernelGGL(mk_fwd, dim3(grid), dim3(NTHR), LDS_BYTES, stream, a); }
#endif
}
```

```cpp
#include <hip/hip_runtime.h>
#include <hip/hip_cooperative_groups.h>
#include <cstdio>
#include <cstdint>
namespace cg = cooperative_groups;

#ifndef REP_MASK
#define REP_MASK 0
#endif
#define NREP(k) (((REP_MASK) >> (k)) & 1 ? 2 : 1)
#ifndef MK_LAUNCHES
#define MK_LAUNCHES 1
#endif

#define LAS __attribute__((address_space(3)))
typedef unsigned short bf16;
typedef unsigned v4u __attribute__((ext_vector_type(4)));
typedef unsigned v2u __attribute__((ext_vector_type(2)));
typedef float f32x4 __attribute__((ext_vector_type(4)));
typedef short bf16x8 __attribute__((ext_vector_type(8)));
typedef __bf16 bf16x2 __attribute__((ext_vector_type(2)));

constexpr int D = 1024, SEQ = 8192, M = 16384;
constexpr int NIN = 3584, NQ = 2048;
constexpr float EPS = 1e-6f;
constexpr int NWAVES = 8, NTHR = 512;

constexpr size_t MiB = 1u << 20;
constexpr size_t WS_ACH = 1 * MiB;
constexpr size_t WS_MOD = 1 * MiB + 512 * 1024;
constexpr size_t WS_LB = WS_MOD + 64 * 1024;
constexpr size_t WS_WIN = 2 * MiB;
constexpr size_t WS_WOUT = 9 * MiB;
constexpr size_t WS_WQ = 11 * MiB;
constexpr size_t WS_KEYS = 15 * MiB;
constexpr size_t WS_U8 = 16 * MiB, WS_V8 = 32 * MiB;
constexpr size_t WS_SUV = WS_MOD + 128 * 1024;
constexpr size_t WS_H1 = 80 * MiB;
constexpr size_t WS_PROJ = 112 * MiB;
constexpr size_t WS_ST = 224 * MiB;
constexpr size_t WS_END = 256 * MiB;
constexpr int LDS_BYTES = 147456, MISC_OFF = 147456 - 256;
constexpr size_t WS_CTL = 0, CTL_ZERO_BYTES = 65536;

__device__ __forceinline__ float bf2f(unsigned h) { return __uint_as_float(h << 16); }
__device__ __forceinline__ unsigned f2bf(float f) { unsigned u = __float_as_uint(f); return (u + 0x7fffu + ((u >> 16) & 1u)) >> 16; }
typedef float f32x2 __attribute__((ext_vector_type(2)));
__device__ __forceinline__ unsigned pk2(float lo, float hi) { const f32x2 v = {lo, hi}; return __builtin_bit_cast(unsigned, __builtin_convertvector(v, bf16x2)); }
__device__ __forceinline__ float dot2(unsigned w, unsigned x, float acc) { return __builtin_amdgcn_fdot2_f32_bf16(__builtin_bit_cast(bf16x2, w), __builtin_bit_cast(bf16x2, x), acc, false); }
__device__ __forceinline__ float wave_sum(float v) {
#pragma unroll
    for (int o = 1; o < 64; o <<= 1) v += __shfl_xor(v, o);
    return v;
}

namespace pg8 {
constexpr int BM = 256, BK = 64, HALF = 128, HTB = HALF * BK * 2, STAGE_BYTES = 8 * HTB, NXCD = 8, WGM = 8;
__host__ __device__ __forceinline__ int lds_byte(int r, int c) { const int st = (r >> 4) * 2 + (c >> 5), rr = r & 15, cc = c & 31, ob = rr * 64 + cc * 2; return st * 1024 + (ob ^ (((ob >> 9) & 1) << 5)); }
__host__ __device__ __forceinline__ void stage_rc(int b, int& R, int& C) { const int st = b / 1024, sb = b % 1024, swz = sb ^ (((sb >> 9) & 1) << 5); R = (st >> 1) * 16 + swz / 64; C = (st & 1) * 32 + (swz % 64) / 2; }
__host__ __device__ __forceinline__ int perm32(int rho) { const int n = rho >> 4, i = rho & 15; return 8 * (i >> 2) + 4 * n + (i & 3); }
struct Unit { int pm, pn; };
struct Gemm { const bf16* A; const bf16* Bt; int M, N, K; };
struct StaticOrder {
    int nM, nN, nwg, G, c;
    __host__ __device__ void init(int M_, int N_, int G_, int c_) { nM = M_ / BM; nN = N_ / BM; nwg = nM * nN; G = G_; c = c_; }
    __host__ __device__ bool next(int i, Unit& u) const {
        const long L = (long)i * G + c; if (L >= nwg) return false;
        int wgid = (int)L; { const int q = nwg / NXCD, r = nwg % NXCD, xcd = wgid % NXCD, off = wgid / NXCD; wgid = (xcd < r ? xcd * (q + 1) : r * (q + 1) + (xcd - r) * q) + off; }
        const int nig = WGM * nN, gid = wgid / nig, fm = gid * WGM, gsz = (nM - fm) < WGM ? (nM - fm) : WGM;
        u.pm = fm + ((wgid % nig) % gsz); u.pn = (wgid % nig) / gsz; return true;
    }
};
struct EpiBf16 {
    static constexpr bool PERM = true;
    bf16* O; int ldc;
    __device__ __forceinline__ void operator()(const f32x4 (&acc)[2][2][4][2], const Unit& u, int wr, int wc, int fr, int fq) const {
        const int row0 = u.pm * BM + wr * 64 + fr; const int col0 = u.pn * BM + wc * 32 + 8 * fq;
#pragma unroll
        for (int ai = 0; ai < 2; ++ai)
#pragma unroll
            for (int m = 0; m < 4; ++m) { bf16* rowp = O + (size_t)(row0 + ai * HALF + m * 16) * ldc + col0;
#pragma unroll
                for (int bj = 0; bj < 2; ++bj) { const f32x4 v0 = acc[ai][bj][m][0], v1 = acc[ai][bj][m][1];
                    v4u w; w.x = pk2(v0[0], v0[1]); w.y = pk2(v0[2], v0[3]); w.z = pk2(v1[0], v1[1]); w.w = pk2(v1[2], v1[3]);
                    *(v4u*)(rowp + bj * HALF) = w; } }
    }
};
struct EpiRes {
    static constexpr bool PERM = false;
    const float* x; float* out; const float* mod;
    __device__ __forceinline__ void operator()(const f32x4 (&acc)[2][2][4][2], const Unit& u, int wr, int wc, int fr, int fq) const {
        const int row0 = u.pm * BM + wr * 64 + fr, col0 = u.pn * BM + wc * 32 + 4 * fq; const int b = u.pm >> 5;
        f32x4 gv[2][2];
#pragma unroll
        for (int bj = 0; bj < 2; ++bj)
#pragma unroll
            for (int n = 0; n < 2; ++n) gv[bj][n] = *(const f32x4*)(mod + b * 6144 + 2048 + col0 + bj * HALF + n * 16);
#pragma unroll
        for (int ai = 0; ai < 2; ++ai)
#pragma unroll
            for (int m = 0; m < 4; ++m) { const size_t off = (size_t)(row0 + ai * HALF + m * 16) * D + col0;
#pragma unroll
                for (int bj = 0; bj < 2; ++bj)
#pragma unroll
                    for (int n = 0; n < 2; ++n) { const f32x4 xv = *(const f32x4*)(x + off + bj * HALF + n * 16);
                        *(f32x4*)(out + off + bj * HALF + n * 16) = xv + gv[bj][n] * acc[ai][bj][m][n]; } }
    }
};

template <class Epi, bool ALIGN_EPI = true>
__device__ __forceinline__ void gemm_phase(LAS unsigned char* lds, const Gemm g, const StaticOrder& S, const Epi& E) {
    const int tid = threadIdx.x, wid = __builtin_amdgcn_readfirstlane(tid >> 6), lane = tid & 63, wr = wid >> 2, wc = wid & 3, fr = lane & 15, fq = lane >> 4;
    const int K = g.K, nt = K / BK;
    unsigned voffA[2], voffB[2];
#pragma unroll
    for (int i = 0; i < 2; ++i) { int R, C; stage_rc(tid * 16 + i * 8192, R, C); const int Rb = Epi::PERM ? ((R & ~31) + perm32(R & 31)) : R;
        voffA[i] = (unsigned)(R * K + C) * 2u; voffB[i] = (unsigned)(Rb * K + C) * 2u; }
    const size_t kstep = (size_t)(BK * 2);
    const size_t hstep = (size_t)HALF * K * 2;
    const size_t tstep = 2 * hstep;
    const unsigned ldsw = (unsigned)wid * 1024u;
    const int aoff = lds_byte(wr * 64 + fr, fq * 8), boff = lds_byte(wc * 32 + fr, fq * 8);
#define PG8_SA(b, h) (((b) * 2 + (h)) * HTB)
#define PG8_SB(b, h) ((4 + (b) * 2 + (h)) * HTB)
#define PG8_STAGE(bufoff, gbase, voff) do { _Pragma("unroll") for (int _i = 0; _i < 2; ++_i) \
        __builtin_amdgcn_global_load_lds((const unsigned*)((const char*)(gbase) + (voff)[_i]), (LAS unsigned*)(lds + (bufoff) + ldsw + _i * 8192), 16, 0, 0); } while (0)
#define PG8_LDA(dst, b, h) do { _Pragma("unroll") for (int m = 0; m < 4; ++m) _Pragma("unroll") for (int k = 0; k < 2; ++k) dst[m][k] = *(const LAS bf16x8*)(lds + PG8_SA(b, h) + aoff + m * 2048 + k * 1024); } while (0)
#define PG8_LDB(dst, b, h) do { _Pragma("unroll") for (int n = 0; n < 2; ++n) _Pragma("unroll") for (int k = 0; k < 2; ++k) dst[n][k] = *(const LAS bf16x8*)(lds + PG8_SB(b, h) + boff + n * 2048 + k * 1024); } while (0)
#define PG8_MMA(ai, bj, At, Bt) do { __builtin_amdgcn_s_setprio(1); _Pragma("unroll") for (int m = 0; m < 4; ++m) _Pragma("unroll") for (int n = 0; n < 2; ++n) _Pragma("unroll") for (int k = 0; k < 2; ++k) \
        acc[ai][bj][m][n] = __builtin_amdgcn_mfma_f32_16x16x32_bf16(Bt[n][k], At[m][k], acc[ai][bj][m][n], 0, 0, 0); __builtin_amdgcn_s_setprio(0); } while (0)
#define PG8_WAIT_V(n) asm volatile("s_waitcnt vmcnt(" #n ")" ::: "memory")
#define PG8_WAIT_L(n) asm volatile("s_waitcnt lgkmcnt(" #n ")" ::: "memory")
#define PG8_BAR __builtin_amdgcn_s_barrier()
#define PG8_SCHED __builtin_amdgcn_sched_barrier(0)
    Unit cur, nxt; int ui = 0;
    if (!S.next(0, cur)) return;
    f32x4 acc[2][2][4][2];
#pragma unroll
    for (int a = 0; a < 2; ++a)
#pragma unroll
        for (int b = 0; b < 2; ++b)
#pragma unroll
            for (int m = 0; m < 4; ++m)
#pragma unroll
                for (int n = 0; n < 2; ++n) acc[a][b][m][n] = (f32x4){0.f, 0.f, 0.f, 0.f};
    bf16x8 At[4][2], B0[2][2], B1[2][2];
    const char* cA = (const char*)g.A + (size_t)cur.pm * tstep; const char* cB = (const char*)g.Bt + (size_t)cur.pn * tstep;
    PG8_STAGE(PG8_SB(0, 0), cB, voffB); PG8_STAGE(PG8_SB(0, 1), cB + hstep, voffB); PG8_STAGE(PG8_SA(0, 0), cA, voffA); PG8_STAGE(PG8_SA(0, 1), cA + hstep, voffA);
    if (wr == 1) PG8_BAR;
    PG8_WAIT_V(2); PG8_BAR;
    PG8_STAGE(PG8_SB(1, 0), cB + kstep, voffB); PG8_STAGE(PG8_SA(1, 0), cA + kstep, voffA); PG8_STAGE(PG8_SB(1, 1), cB + hstep + kstep, voffB);
    PG8_WAIT_V(6); PG8_BAR;
    for (;;) {
        const bool has_next = S.next(ui + 1, nxt);
        const char* nA = has_next ? (const char*)g.A + (size_t)nxt.pm * tstep : cA; const char* nB = has_next ? (const char*)g.Bt + (size_t)nxt.pn * tstep : cB;
        for (int t = 0; t < nt; t += 2) {
            const bool last = (t == nt - 2);
            const char* a1 = cA + (size_t)(t + 1) * kstep;
            const char* a2 = last ? nA : cA + (size_t)(t + 2) * kstep; const char* b2 = last ? nB : cB + (size_t)(t + 2) * kstep;
            const char* a3 = a2 + kstep; const char* b3 = b2 + kstep;
            PG8_LDB(B0, 0, 0); PG8_LDB(B1, 0, 1); PG8_SCHED; PG8_LDA(At, 0, 0); PG8_STAGE(PG8_SA(1, 1), a1 + hstep, voffA);
            PG8_WAIT_V(8); PG8_WAIT_L(0); PG8_BAR; PG8_MMA(0, 0, At, B0); PG8_MMA(0, 1, At, B1); PG8_BAR; PG8_SCHED;
            PG8_LDA(At, 0, 1); PG8_STAGE(PG8_SB(0, 0), b2, voffB); PG8_STAGE(PG8_SB(0, 1), b2 + hstep, voffB); PG8_STAGE(PG8_SA(0, 0), a2, voffA);
            PG8_WAIT_V(8); PG8_WAIT_L(0); PG8_BAR; PG8_MMA(1, 0, At, B0); PG8_MMA(1, 1, At, B1); PG8_BAR; PG8_SCHED;
            PG8_LDB(B0, 1, 0); PG8_LDB(B1, 1, 1); PG8_SCHED; PG8_LDA(At, 1, 0); PG8_STAGE(PG8_SA(0, 1), a2 + hstep, voffA);
            PG8_WAIT_V(8); PG8_WAIT_L(0); PG8_BAR; PG8_MMA(0, 0, At, B0); PG8_MMA(0, 1, At, B1); PG8_BAR; PG8_SCHED;
            PG8_LDA(At, 1, 1); PG8_STAGE(PG8_SB(1, 0), b3, voffB); PG8_STAGE(PG8_SB(1, 1), b3 + hstep, voffB); PG8_STAGE(PG8_SA(1, 0), a3, voffA);
            PG8_WAIT_V(8); PG8_WAIT_L(0); PG8_BAR; PG8_MMA(1, 0, At, B0); PG8_MMA(1, 1, At, B1); PG8_BAR; PG8_SCHED;
        }
        if constexpr (ALIGN_EPI) { if (wr == 0) PG8_BAR; }
        E(acc, cur, wr, wc, fr, fq);
        if (!has_next) break;
#pragma unroll
        for (int a = 0; a < 2; ++a)
#pragma unroll
            for (int b = 0; b < 2; ++b)
#pragma unroll
                for (int m = 0; m < 4; ++m)
#pragma unroll
                    for (int n = 0; n < 2; ++n) acc[a][b][m][n] = (f32x4){0.f, 0.f, 0.f, 0.f};
        cur = nxt; cA = nA; cB = nB; ++ui;
        if constexpr (ALIGN_EPI) { if (wr == 1) PG8_BAR; }
    }
    PG8_WAIT_V(0);
    if constexpr (!ALIGN_EPI) { if (wr == 0) PG8_BAR; }
    PG8_BAR;
#undef PG8_SA
#undef PG8_SB
#undef PG8_STAGE
#undef PG8_LDA
#undef PG8_LDB
#undef PG8_MMA
#undef PG8_WAIT_V
#undef PG8_WAIT_L
#undef PG8_BAR
#undef PG8_SCHED
}
}

struct Args { const float* in[17]; float* out; unsigned char* ws; int ph_lo, ph_hi; };
struct Ctx {
    LAS unsigned char* lds; int tid, lane, wave, G, bid;
    const float *x, *c, *w_ada, *b_ada, *norm1_w, *w_in, *lb_logits, *hgrn_onorm_w, *conv_w, *conv_onorm_w, *w_out, *norm2_w, *w_query, *sub_keys, *peer_u, *peer_v, *final_w;
    float* out; float *ACH, *MOD, *LB;
    bf16 *WIN, *WOUT, *WQ, *KEYS, *H1, *YCAT, *PROJ, *H2, *QP, *ST; unsigned char *U8, *V8; float *SUV;
};

__device__ __forceinline__ void p0_transpose_item(const float* W, int K, int N, bf16* WT, LAS float* scr, int item, int lane) {
    const int nblk = N / 32, kb = item / nblk, nb = item % nblk, k0 = 64 * kb, n0 = 32 * nb;
#pragma unroll 8
    for (int i = 0; i < 32; ++i) { const int kk = 2 * i + (lane >> 5); scr[kk * 33 + (lane & 31)] = W[(size_t)(k0 + kk) * N + n0 + (lane & 31)]; }
    asm volatile("s_waitcnt lgkmcnt(0)" ::: "memory"); __builtin_amdgcn_wave_barrier();
    const int c = lane & 7;
#pragma unroll
    for (int j = 0; j < 4; ++j) { const int n = (lane >> 3) + 8 * j; const LAS float* s = scr + (8 * c) * 33 + n;
        v4u o; o.x = pk2(s[0 * 33], s[1 * 33]); o.y = pk2(s[2 * 33], s[3 * 33]); o.z = pk2(s[4 * 33], s[5 * 33]); o.w = pk2(s[6 * 33], s[7 * 33]);
        *(v4u*)(WT + (size_t)(n0 + n) * K + k0 + 8 * c) = o; }
    asm volatile("s_waitcnt lgkmcnt(0)" ::: "memory"); __builtin_amdgcn_wave_barrier();
}
__device__ __forceinline__ void cvt_stream(const float* src, bf16* dst, size_t n8, size_t gtid, size_t gstride) {
    for (size_t i = gtid; i < n8; i += gstride) {
        const f32x4 a = *(const f32x4*)(src + i * 8), b = *(const f32x4*)(src + i * 8 + 4);
        v4u o; o.x = pk2(a[0], a[1]); o.y = pk2(a[2], a[3]); o.z = pk2(b[0], b[1]); o.w = pk2(b[2], b[3]);
        *(v4u*)(dst + i * 8) = o;
    }
}

__device__ __forceinline__ void p0_prep(Ctx& F) {
    {
        LAS float* sc = (LAS float*)(F.lds);
        LAS float* part = (LAS float*)(F.lds + 8192);
        for (int u = F.bid; u < 192; u += F.G) {
            for (int i = F.tid; i < 2048; i += NTHR) { const float v = F.c[i]; sc[i] = v / (1.f + __expf(-v)); }
            __syncthreads();
            const int cgp = F.tid & 7, kg = F.tid >> 3, n0 = 32 * u + 4 * cgp;
            f32x4 a0 = {0.f, 0.f, 0.f, 0.f}, a1 = {0.f, 0.f, 0.f, 0.f};
#pragma unroll 8
            for (int k = kg; k < 1024; k += 64) { const f32x4 w = *(const f32x4*)(F.w_ada + (size_t)k * 6144 + n0); a0 += w * sc[k]; a1 += w * sc[1024 + k]; }
            *(LAS f32x4*)(part + (kg * 2 + 0) * 32 + 4 * cgp) = a0; *(LAS f32x4*)(part + (kg * 2 + 1) * 32 + 4 * cgp) = a1;
            __syncthreads();
            if (F.tid < 64) { const int b = F.tid >> 5, col = F.tid & 31; float s = F.b_ada[32 * u + col];
#pragma unroll 8
                for (int q = 0; q < 64; ++q) s += part[(q * 2 + b) * 32 + col];
                F.MOD[b * 6144 + 32 * u + col] = s; }
            __syncthreads();
        }
    }
}

__device__ __forceinline__ void p0_prep2(Ctx& F) {
    if (F.bid == (F.G > 100 ? 100 : 0)) { const float l0 = F.lb_logits[F.tid], l1 = F.lb_logits[512 + F.tid]; F.LB[F.tid] = 1.f / (1.f + __expf(l1 - l0)); }
    {
        LAS float* scr = (LAS float*)(F.lds + 32768 + F.wave * 12288);
        const int gw = F.bid * NWAVES + F.wave, NGW = F.G * NWAVES;
        constexpr int I_IN = (D / 64) * (NIN / 32), I_OUT = (D / 64) * (D / 32), I_Q = (D / 64) * (NQ / 32);
        for (int it = gw; it < I_IN + I_OUT + I_Q; it += NGW) {
            int r = it;
            if (r < I_IN) { p0_transpose_item(F.w_in, D, NIN, F.WIN, scr, r, F.lane); continue; } r -= I_IN;
            if (r < I_OUT) { p0_transpose_item(F.w_out, D, D, F.WOUT, scr, r, F.lane); continue; } r -= I_OUT;
            p0_transpose_item(F.w_query, D, NQ, F.WQ, scr, r, F.lane);
        }
    }
    {
        const size_t gtid = (size_t)F.bid * NTHR + F.tid, gs = (size_t)F.G * NTHR;
        cvt_stream(F.sub_keys, F.KEYS, (size_t)16 * 128 * 128 / 8, gtid, gs);
    }
}

__device__ __forceinline__ void convert_experts(Ctx& F, int wg, int nwg) {
    {
        const int gw = wg * NWAVES + F.wave, NGW = nwg * NWAVES;
        for (int r = gw; r < 32768; r += NGW) {
            const bool isv = r >= 16384; const int e = r & 16383;
            const float* srow = (isv ? F.peer_v : F.peer_u) + (size_t)e * D;
            f32x4 v[4]; float am = 0.f;
#pragma unroll
            for (int j = 0; j < 4; ++j) { v[j] = *(const f32x4*)(srow + 4 * F.lane + 256 * j);
                am = fmaxf(am, fmaxf(fmaxf(fabsf(v[j].x), fabsf(v[j].y)), fmaxf(fabsf(v[j].z), fabsf(v[j].w)))); }
#pragma unroll
            for (int o = 1; o < 64; o <<= 1) am = fmaxf(am, __shfl_xor(am, o));
            unsigned* drow = (unsigned*)((isv ? F.V8 : F.U8) + (size_t)e * D);
            if (isv) {
                const float inv = am > 0.f ? 432.f / am : 0.f;
#pragma unroll
                for (int j = 0; j < 4; ++j) { int p = __builtin_amdgcn_cvt_pk_fp8_f32(v[j].x * inv, v[j].y * inv, 0, false); p = __builtin_amdgcn_cvt_pk_fp8_f32(v[j].z * inv, v[j].w * inv, p, true);
                    drow[F.lane + 64 * j] = (unsigned)p; }
                if (F.lane == 0) F.SUV[2 * e + 1] = am * (1.f / 432.f);
            } else {
                const float inv = am > 0.f ? 127.f / am : 0.f;
#pragma unroll
                for (int j = 0; j < 4; ++j) {
                    const int q0 = (int)rintf(v[j].x * inv), q1 = (int)rintf(v[j].y * inv), q2 = (int)rintf(v[j].z * inv), q3 = (int)rintf(v[j].w * inv);
                    drow[F.lane + 64 * j] = (unsigned)(q0 & 255) | ((unsigned)(q1 & 255) << 8) | ((unsigned)(q2 & 255) << 16) | ((unsigned)(q3 & 255) << 24); }
                if (F.lane == 0) F.SUV[2 * e] = am * (1.f / 127.f);
            }
        }
    }
}

__device__ __forceinline__ void modnorm_row(const float* xrow, const float* w, const float* shift, const float* scale, bf16* orow, int lane) {
    f32x4 v[4]; float s = 0.f;
#pragma unroll
    for (int j = 0; j < 4; ++j) { v[j] = *(const f32x4*)(xrow + 4 * lane + 256 * j); s += (v[j].x * v[j].x + v[j].y * v[j].y) + (v[j].z * v[j].z + v[j].w * v[j].w); }
    const float rstd = 1.f / sqrtf(wave_sum(s) * (1.f / D) + EPS);
#pragma unroll
    for (int j = 0; j < 4; ++j) { const int col = 4 * lane + 256 * j;
        const f32x4 wv = *(const f32x4*)(w + col), sh = *(const f32x4*)(shift + col), sc = *(const f32x4*)(scale + col);
        const f32x4 y = v[j] * rstd * wv * (sc + 1.f) + sh;
        v2u o; o.x = pk2(y.x, y.y); o.y = pk2(y.z, y.w); *(v2u*)(orow + col) = o; }
}

__device__ __forceinline__ void p3_local(Ctx& F) {
    LAS unsigned char* KT = F.lds;
    LAS unsigned char* VT = F.lds + 18432;
    LAS float* QT = (LAS float*)(F.lds + 36864);
    LAS unsigned char* OUT = F.lds + 38912;
    const int tid = F.tid, lane = F.lane, wave = F.wave, fr = lane & 15, fq = lane >> 4;
    for (int u = F.bid; u < 1024; u += F.G) {
        const int bh = u >> 7, c = u & 127, b = bh >> 2, hh = bh & 3;
        const size_t r0 = (size_t)b * SEQ + (size_t)c * 64;
        const int d = tid & 127, tq = tid >> 7;
        const bf16* pf = F.PROJ + (r0 + 16 * tq) * NIN + 512 + hh * 128 + d;
        const bf16* pv = F.PROJ + (r0 + 16 * tq) * NIN + 1024 + hh * 128 + d;
        const float lbv = F.LB[hh * 128 + d], oml = 1.f - lbv;
        unsigned short fraw[16], vraw[16];
#pragma unroll
        for (int j = 0; j < 16; ++j) { fraw[j] = pf[(size_t)j * NIN]; vraw[j] = pv[(size_t)j * NIN]; }
        float cs[16], kk[16]; float run = 0.f;
#pragma unroll
        for (int j = 0; j < 16; ++j) { const float fv = bf2f(fraw[j]); const float e = __expf(-fv); const float sg = 1.f / (1.f + e);
            const float f = lbv + oml * sg; run += __logf(f); cs[j] = run; kk[j] = oml * (e * sg); }
        QT[tq * 128 + d] = run;
        __syncthreads();
        float prefix = 0.f, total = 0.f;
#pragma unroll
        for (int q = 0; q < 4; ++q) { const float t = QT[q * 128 + d]; total += t; if (q < tq) prefix += t; }
        unsigned kp[8], vp[8];
#pragma unroll
        for (int j = 0; j < 8; ++j) { const float k0 = kk[2 * j] * __expf(total - (prefix + cs[2 * j])), k1 = kk[2 * j + 1] * __expf(total - (prefix + cs[2 * j + 1]));
            kp[j] = pk2(k0, k1); vp[j] = (unsigned)vraw[2 * j] | ((unsigned)vraw[2 * j + 1] << 16); }
        *(LAS v4u*)(KT + d * 144 + tq * 32) = (v4u){kp[0], kp[1], kp[2], kp[3]}; *(LAS v4u*)(KT + d * 144 + tq * 32 + 16) = (v4u){kp[4], kp[5], kp[6], kp[7]};
        *(LAS v4u*)(VT + d * 144 + tq * 32) = (v4u){vp[0], vp[1], vp[2], vp[3]}; *(LAS v4u*)(VT + d * 144 + tq * 32 + 16) = (v4u){vp[4], vp[5], vp[6], vp[7]};
        if (tq == 0) F.ACH[u * 128 + d] = __expf(total);
        __syncthreads();
        {
            const int dblk = wave & 3, vh = wave >> 2;
            f32x4 acc[2][4];
#pragma unroll
            for (int a = 0; a < 2; ++a)
#pragma unroll
                for (int n = 0; n < 4; ++n) acc[a][n] = (f32x4){0.f, 0.f, 0.f, 0.f};
#pragma unroll
            for (int k2 = 0; k2 < 2; ++k2) {
                bf16x8 af[2], bfv[4];
#pragma unroll
                for (int a = 0; a < 2; ++a) af[a] = *(const LAS bf16x8*)(KT + (dblk * 32 + a * 16 + fr) * 144 + (k2 * 32 + fq * 8) * 2);
#pragma unroll
                for (int n = 0; n < 4; ++n) bfv[n] = *(const LAS bf16x8*)(VT + (vh * 64 + n * 16 + fr) * 144 + (k2 * 32 + fq * 8) * 2);
#pragma unroll
                for (int a = 0; a < 2; ++a)
#pragma unroll
                    for (int n = 0; n < 4; ++n) acc[a][n] = __builtin_amdgcn_mfma_f32_16x16x32_bf16(af[a], bfv[n], acc[a][n], 0, 0, 0);
            }
#pragma unroll
            for (int a = 0; a < 2; ++a)
#pragma unroll
                for (int n = 0; n < 4; ++n) { const int v = vh * 64 + n * 16 + fr, dd = dblk * 32 + a * 16 + 4 * fq;
                    *(LAS v2u*)(OUT + v * 272 + dd * 2) = (v2u){pk2(acc[a][n][0], acc[a][n][1]), pk2(acc[a][n][2], acc[a][n][3])}; }
        }
        __syncthreads();
        { const int row = tid >> 2, part = tid & 3; bf16* dst = F.ST + (size_t)u * 16384 + row * 128 + part * 32;
#pragma unroll
            for (int i = 0; i < 4; ++i) *(v4u*)(dst + i * 8) = *(const LAS v4u*)(OUT + row * 272 + part * 64 + i * 16); }
        __syncthreads();
    }
    {
        const int gw = F.bid * NWAVES + F.wave, NGW = F.G * NWAVES;
        const int ch = lane * 8;
        float w0[8], w1[8], w2[8], ow[8];
#pragma unroll
        for (int j = 0; j < 8; ++j) { w0[j] = F.conv_w[ch + j]; w1[j] = F.conv_w[512 + ch + j]; w2[j] = F.conv_w[1024 + ch + j]; ow[j] = F.conv_onorm_w[ch + j]; }
        for (int run = gw; run < M / 8; run += NGW) {
            const int rbase = run * 8;
            float u1[8], u2[8];
#pragma unroll
            for (int j = 0; j < 8; ++j) { u1[j] = 0.f; u2[j] = 0.f; }
            const int tpos = rbase & (SEQ - 1);
            if (tpos >= 1) { const bf16* p = F.PROJ + (size_t)(rbase - 1) * NIN + 2048 + ch; const v4u cc = *(const v4u*)(p + 512), xx = *(const v4u*)(p + 1024);
#pragma unroll
                for (int j = 0; j < 4; ++j) { const unsigned cw = cc[j], xw = xx[j]; u1[2 * j] = bf2f(cw & 0xffffu) * bf2f(xw & 0xffffu); u1[2 * j + 1] = bf2f(cw >> 16) * bf2f(xw >> 16); } }
            if (tpos >= 2) { const bf16* p = F.PROJ + (size_t)(rbase - 2) * NIN + 2048 + ch; const v4u cc = *(const v4u*)(p + 512), xx = *(const v4u*)(p + 1024);
#pragma unroll
                for (int j = 0; j < 4; ++j) { const unsigned cw = cc[j], xw = xx[j]; u2[2 * j] = bf2f(cw & 0xffffu) * bf2f(xw & 0xffffu); u2[2 * j + 1] = bf2f(cw >> 16) * bf2f(xw >> 16); } }
            for (int t = 0; t < 8; ++t) {
                const bf16* p = F.PROJ + (size_t)(rbase + t) * NIN + 2048 + ch;
                const v4u bb = *(const v4u*)(p), cc = *(const v4u*)(p + 512), xx = *(const v4u*)(p + 1024);
                float u0[8], y[8]; float ss = 0.f;
#pragma unroll
                for (int j = 0; j < 4; ++j) { const unsigned cw = cc[j], xw = xx[j]; u0[2 * j] = bf2f(cw & 0xffffu) * bf2f(xw & 0xffffu); u0[2 * j + 1] = bf2f(cw >> 16) * bf2f(xw >> 16); }
#pragma unroll
                for (int j = 0; j < 8; ++j) { const float bg = bf2f((j & 1) ? (bb[j >> 1] >> 16) : (bb[j >> 1] & 0xffffu));
                    y[j] = bg * (w0[j] * u2[j] + w1[j] * u1[j] + w2[j] * u0[j]); ss += y[j] * y[j]; }
                ss += __shfl_xor(ss, 1); ss += __shfl_xor(ss, 2); ss += __shfl_xor(ss, 4); ss += __shfl_xor(ss, 8);
                const float rstd = 1.f / sqrtf(ss * (1.f / 128.f) + EPS);
                v4u o; o.x = pk2(y[0] * rstd * ow[0], y[1] * rstd * ow[1]); o.y = pk2(y[2] * rstd * ow[2], y[3] * rstd * ow[3]);
                o.z = pk2(y[4] * rstd * ow[4], y[5] * rstd * ow[5]); o.w = pk2(y[6] * rstd * ow[6], y[7] * rstd * ow[7]);
                *(v4u*)(F.YCAT + (size_t)(rbase + t) * D + 512 + ch) = o;
#pragma unroll
                for (int j = 0; j < 8; ++j) { u2[j] = u1[j]; u1[j] = u0[j]; }
            }
        }
    }
}

__device__ __forceinline__ void p4_scan(Ctx& F) {
    const int gtid = F.bid * NTHR + F.tid;
    if (gtid >= 65536) return;
    const int bh = gtid >> 13, e2 = gtid & 8191, v = e2 >> 6, d = (e2 & 63) * 2;
    unsigned* p = (unsigned*)(F.ST + (size_t)bh * 128 * 16384 + v * 128 + d);
    const float* a = F.ACH + (size_t)bh * 128 * 128 + d;
    float s0 = 0.f, s1 = 0.f;
#pragma unroll 8
    for (int c = 0; c < 128; ++c) {
        const unsigned uu = p[(size_t)c * 8192]; const float a0 = a[c * 128], a1 = a[c * 128 + 1];
        p[(size_t)c * 8192] = pk2(s0, s1);
        s0 = a0 * s0 + bf2f(uu & 0xffffu); s1 = a1 * s1 + bf2f(uu >> 16);
    }
}

__device__ __forceinline__ void p5_out(Ctx& F) {
    LAS unsigned char* QM = F.lds;
    LAS unsigned char* Q0 = F.lds + 17408;
    LAS unsigned char* KM = F.lds + 34816;
    LAS unsigned char* VT = F.lds + 52224;
    LAS unsigned char* STL = F.lds + 70656;
    LAS float* QT = (LAS float*)(F.lds + 105472);
    LAS unsigned char* PB = F.lds + 107520;
    LAS float* NRM = (LAS float*)(F.lds + 125952);
    const int tid = F.tid, lane = F.lane, wave = F.wave, fr = lane & 15, fq = lane >> 4;
    for (int u = F.bid; u < 1024; u += F.G) {
        const int bh = u >> 7, c = u & 127, b = bh >> 2, hh = bh & 3;
        const size_t r0 = (size_t)b * SEQ + (size_t)c * 64;
        const int d = tid & 127, tq = tid >> 7;
        const bf16* pq = F.PROJ + (r0 + 16 * tq) * NIN + hh * 128 + d;
        const float lbv = F.LB[hh * 128 + d], oml = 1.f - lbv;
        unsigned short qraw[16], fraw[16], vraw[16];
#pragma unroll
        for (int j = 0; j < 16; ++j) { qraw[j] = pq[(size_t)j * NIN]; fraw[j] = pq[(size_t)j * NIN + 512]; vraw[j] = pq[(size_t)j * NIN + 1024]; }
        {
            const bf16* src = F.ST + (size_t)u * 16384;
#pragma unroll
            for (int i = 0; i < 4; ++i) { const int row = (tid >> 4) + 32 * i, ck = tid & 15; *(LAS v4u*)(STL + row * 272 + ck * 16) = *(const v4u*)(src + row * 128 + ck * 8); }
        }
        float cs[16], kk[16]; float run = 0.f;
#pragma unroll
        for (int j = 0; j < 16; ++j) { const float fv = bf2f(fraw[j]); const float e = __expf(-fv); const float sg = 1.f / (1.f + e);
            const float f = lbv + oml * sg; run += __logf(f); cs[j] = run; kk[j] = oml * (e * sg); }
        QT[tq * 128 + d] = run;
        __syncthreads();
        float prefix = 0.f; const float q0t = QT[d], q1t = QT[128 + d], q2t = QT[256 + d];
        if (tq >= 1) prefix += q0t; if (tq >= 2) prefix += q1t; if (tq >= 3) prefix += q2t;
        const float bmid = q0t + q1t;
        unsigned vp[8];
#pragma unroll
        for (int j = 0; j < 16; ++j) { const float bj = prefix + cs[j]; const float qv = bf2f(qraw[j]); const int t = 16 * tq + j;
            *(LAS unsigned short*)(QM + t * 272 + d * 2) = (unsigned short)f2bf(qv * __expf(bj - bmid));
            *(LAS unsigned short*)(Q0 + t * 272 + d * 2) = (unsigned short)f2bf(qv * __expf(bj));
            *(LAS unsigned short*)(KM + t * 272 + d * 2) = (unsigned short)f2bf(kk[j] * __expf(bmid - bj)); }
#pragma unroll
        for (int j = 0; j < 8; ++j) vp[j] = (unsigned)vraw[2 * j] | ((unsigned)vraw[2 * j + 1] << 16);
        *(LAS v4u*)(VT + d * 144 + tq * 32) = (v4u){vp[0], vp[1], vp[2], vp[3]}; *(LAS v4u*)(VT + d * 144 + tq * 32 + 16) = (v4u){vp[4], vp[5], vp[6], vp[7]};
        __syncthreads();
        const int rb = wave >> 1, vh = wave & 1;
        LAS unsigned char* P = PB + wave * 2304;
        {
            f32x4 sc[4];
#pragma unroll
            for (int sf = 0; sf < 4; ++sf) sc[sf] = (f32x4){0.f, 0.f, 0.f, 0.f};
#pragma unroll
            for (int k4 = 0; k4 < 4; ++k4) {
                const bf16x8 bq = *(const LAS bf16x8*)(QM + (16 * rb + fr) * 272 + (k4 * 32 + fq * 8) * 2);
#pragma unroll
                for (int sf = 0; sf < 4; ++sf) { const bf16x8 ak = *(const LAS bf16x8*)(KM + (16 * sf + fr) * 272 + (k4 * 32 + fq * 8) * 2);
                    sc[sf] = __builtin_amdgcn_mfma_f32_16x16x32_bf16(ak, bq, sc[sf], 0, 0, 0); }
            }
            const int t = 16 * rb + fr;
#pragma unroll
            for (int sf = 0; sf < 4; ++sf) { const int s0 = 16 * sf + 4 * fq;
                const float p0 = (s0 + 0 <= t) ? sc[sf][0] : 0.f, p1 = (s0 + 1 <= t) ? sc[sf][1] : 0.f, p2 = (s0 + 2 <= t) ? sc[sf][2] : 0.f, p3 = (s0 + 3 <= t) ? sc[sf][3] : 0.f;
                *(LAS v2u*)(P + fr * 144 + s0 * 2) = (v2u){pk2(p0, p1), pk2(p2, p3)}; }
        }
        __syncthreads();
        f32x4 oc[4];
#pragma unroll
        for (int n = 0; n < 4; ++n) oc[n] = (f32x4){0.f, 0.f, 0.f, 0.f};
#pragma unroll
        for (int k2 = 0; k2 < 2; ++k2) {
            const bf16x8 bp = *(const LAS bf16x8*)(P + fr * 144 + (k2 * 32 + fq * 8) * 2);
#pragma unroll
            for (int n = 0; n < 4; ++n) { const bf16x8 av = *(const LAS bf16x8*)(VT + (64 * vh + 16 * n + fr) * 144 + (k2 * 32 + fq * 8) * 2);
                oc[n] = __builtin_amdgcn_mfma_f32_16x16x32_bf16(av, bp, oc[n], 0, 0, 0); }
        }
#pragma unroll
        for (int k4 = 0; k4 < 4; ++k4) {
            const bf16x8 bq = *(const LAS bf16x8*)(Q0 + (16 * rb + fr) * 272 + (k4 * 32 + fq * 8) * 2);
#pragma unroll
            for (int n = 0; n < 4; ++n) { const bf16x8 as = *(const LAS bf16x8*)(STL + (64 * vh + 16 * n + fr) * 272 + (k4 * 32 + fq * 8) * 2);
                oc[n] = __builtin_amdgcn_mfma_f32_16x16x32_bf16(as, bq, oc[n], 0, 0, 0); }
        }
        float ss = 0.f;
#pragma unroll
        for (int n = 0; n < 4; ++n) ss += (oc[n][0] * oc[n][0] + oc[n][1] * oc[n][1]) + (oc[n][2] * oc[n][2] + oc[n][3] * oc[n][3]);
        ss += __shfl_xor(ss, 16); ss += __shfl_xor(ss, 32);
        if (fq == 0) NRM[(16 * rb + fr) * 2 + vh] = ss;
        __syncthreads();
        {
            const int t = 16 * rb + fr; const float tot = NRM[t * 2] + NRM[t * 2 + 1];
            const float rstd = 1.f / sqrtf(tot * (1.f / 128.f) + EPS);
            const bf16* pg = F.PROJ + (r0 + t) * NIN + 1536 + hh * 128;
            bf16* po = F.YCAT + (r0 + t) * D + hh * 128;
#pragma unroll
            for (int n = 0; n < 4; ++n) { const int v = 64 * vh + 16 * n + 4 * fq;
                const v2u gw = *(const v2u*)(pg + v); const f32x4 wv = *(const f32x4*)(F.hgrn_onorm_w + hh * 128 + v);
                float g[4] = {bf2f(gw.x & 0xffffu), bf2f(gw.x >> 16), bf2f(gw.y & 0xffffu), bf2f(gw.y >> 16)}; float o[4];
#pragma unroll
                for (int j = 0; j < 4; ++j) { const float sl = g[j] / (1.f + __expf(-g[j])); o[j] = oc[n][j] * rstd * wv[j] * sl; }
                *(v2u*)(po + v) = (v2u){pk2(o[0], o[1]), pk2(o[2], o[3])}; }
        }
        __syncthreads();
    }
}

__device__ __forceinline__ unsigned f2ord(float f) { const unsigned u = __float_as_uint(f); return (u & 0x80000000u) ? ~u : (u | 0x80000000u); }
__device__ __forceinline__ float ord2f(unsigned o) { return __uint_as_float((o & 0x80000000u) ? (o & 0x7fffffffu) : ~o); }
__device__ __forceinline__ void ce_desc(unsigned& a, unsigned& b) { const unsigned mx = a > b ? a : b, mn = a > b ? b : a; a = mx; b = mn; }
template <int N> __device__ __forceinline__ void bitonic_sort_desc(unsigned (&k)[N]) {
#pragma unroll
    for (int size = 2; size <= N; size <<= 1) {
#pragma unroll
        for (int stride = size >> 1; stride > 0; stride >>= 1) {
#pragma unroll
            for (int i = 0; i < N; ++i) { const int j = i ^ stride; if (j > i) { if ((i & size) == 0) ce_desc(k[i], k[j]); else ce_desc(k[j], k[i]); } }
        }
    }
}
__device__ __forceinline__ void bitonic_merge16_desc(unsigned (&k)[16]) {
#pragma unroll
    for (int stride = 8; stride > 0; stride >>= 1) {
#pragma unroll
        for (int i = 0; i < 16; ++i) { const int j = i ^ stride; if (j > i) ce_desc(k[i], k[j]); }
    }
}
__device__ __forceinline__ void merge_top16(unsigned (&a)[16], const unsigned (&b)[16]) {
#pragma unroll
    for (int i = 0; i < 16; ++i) a[i] = a[i] > b[15 - i] ? a[i] : b[15 - i];
    bitonic_merge16_desc(a);
}
__device__ __forceinline__ float gelu_as(float v) {
    const float av = fabsf(v), t = __builtin_amdgcn_rcpf(av * 0.2316418882f + 1.0f);
    float q = t * 0.5307027145f + (-0.7265760135f); q = q * t + 0.7107068705f; q = q * t + (-0.142248368f); q = q * t + 0.127414796f; q = q * t;
    const float e = __builtin_amdgcn_exp2f((v * v) * (-0.72134752044f));
    const float m = v * (q * e);
    return v < 0.f ? m : v - m;
}
__device__ __forceinline__ float gelu_erf(float x) { return 0.5f * x * (1.f + erff(x * 0.70710678118654752f)); }

__device__ __forceinline__ int row16_sum_i32(int v) {
    v += __builtin_amdgcn_update_dpp(0, v, 0xB1, 0xf, 0xf, true);
    v += __builtin_amdgcn_update_dpp(0, v, 0x4E, 0xf, 0xf, true);
    v += __builtin_amdgcn_update_dpp(0, v, 0x141, 0xf, 0xf, true);
    v += __builtin_amdgcn_update_dpp(0, v, 0x140, 0xf, 0xf, true);
    return v;
}
__device__ __forceinline__ void p9_peer(Ctx& F) {
    LAS unsigned* TOP = (LAS unsigned*)F.lds;
    LAS v2u* IDXS = (LAS v2u*)(F.lds + 65536);
    LAS v4u* CNT = (LAS v4u*)(F.lds + 132096);
    LAS unsigned char* OFFS = F.lds + 140288;
    LAS float* SH = (LAS float*)(F.lds + 142336);
    LAS unsigned char* HQ = F.lds;
    const int tid = F.tid, lane = F.lane, wave = F.wave, fr = lane & 15, fq = lane >> 4;
    for (int tile = F.bid; tile < M / 64; tile += F.G) {
        const size_t r0 = (size_t)tile * 64;
        {
            const int p = wave >> 2, tb = wave & 3;
            LAS unsigned char* KL = F.lds + 73728;
            v4u kpre[8]; bf16x8 qpre[4];
            const bf16* qbase = F.QP + (r0 + 16 * tb + fr) * NQ + p * 128 + fq * 8;
#pragma unroll
            for (int i = 0; i < 8; ++i) kpre[i] = *(const v4u*)(F.KEYS + (size_t)(tid + 512 * i) * 8);
#pragma unroll
            for (int k4 = 0; k4 < 4; ++k4) qpre[k4] = *(const bf16x8*)(qbase + k4 * 32);
#pragma unroll 1
            for (int h = 0; h < 8; ++h) {
#pragma unroll
                for (int i = 0; i < 8; ++i) { const int c = tid + 512 * i; *(LAS v4u*)(KL + (c >> 4) * 272 + (c & 15) * 16) = kpre[i]; }
                bf16x8 bq[4];
#pragma unroll
                for (int k4 = 0; k4 < 4; ++k4) bq[k4] = qpre[k4];
                __syncthreads();
                if (h < 7) {
#pragma unroll
                    for (int i = 0; i < 8; ++i) kpre[i] = *(const v4u*)(F.KEYS + (size_t)(h + 1) * 32768 + (size_t)(tid + 512 * i) * 8);
#pragma unroll
                    for (int k4 = 0; k4 < 4; ++k4) qpre[k4] = *(const bf16x8*)(qbase + (h + 1) * 256 + k4 * 32);
                }
                f32x4 sc[8];
#pragma unroll
                for (int nf = 0; nf < 8; ++nf) sc[nf] = (f32x4){0.f, 0.f, 0.f, 0.f};
                const LAS unsigned char* krow = KL + (p * 128 + fr) * 272 + fq * 16;
#pragma unroll
                for (int k4 = 0; k4 < 4; ++k4) {
#pragma unroll
                    for (int nf = 0; nf < 8; ++nf) { const bf16x8 ak = *(const LAS bf16x8*)(krow + nf * 16 * 272 + k4 * 64);
                        sc[nf] = __builtin_amdgcn_mfma_f32_16x16x32_bf16(ak, bq[k4], sc[nf], 0, 0, 0); }
                }
                unsigned ka[16], kb[16];
#pragma unroll
                for (int nf = 0; nf < 4; ++nf)
#pragma unroll
                    for (int r = 0; r < 4; ++r) {
                        ka[nf * 4 + r] = (f2ord(sc[nf][r]) & ~127u) | (unsigned)(127 - (16 * nf + 4 * fq + r));
                        kb[nf * 4 + r] = (f2ord(sc[nf + 4][r]) & ~127u) | (unsigned)(127 - (16 * (nf + 4) + 4 * fq + r)); }
                bitonic_sort_desc<16>(ka); bitonic_sort_desc<16>(kb);
                merge_top16(ka, kb);
                {
                    unsigned o[16];
#pragma unroll
                    for (int i = 0; i < 16; ++i) o[i] = (unsigned)__shfl_xor((int)ka[i], 16);
                    merge_top16(ka, o);
#pragma unroll
                    for (int i = 0; i < 16; ++i) o[i] = (unsigned)__shfl_xor((int)ka[i], 32);
                    merge_top16(ka, o);
                }
                if (fq == 0) { LAS v4u* dst = (LAS v4u*)(TOP + (h * 64 + 16 * tb + fr) * 36 + p * 16);
                    dst[0] = (v4u){ka[0], ka[1], ka[2], ka[3]}; dst[1] = (v4u){ka[4], ka[5], ka[6], ka[7]}; dst[2] = (v4u){ka[8], ka[9], ka[10], ka[11]}; dst[3] = (v4u){ka[12], ka[13], ka[14], ka[15]}; }
                __syncthreads();
            }
        }
        __syncthreads();
        {
            const int t = tid & 63, h = tid >> 6;
            const LAS unsigned* pa = TOP + (h * 64 + t) * 36; const LAS unsigned* pb = pa + 16;
            float bv[16];
            { const LAS v4u* qb = (const LAS v4u*)pb;
#pragma unroll
              for (int i = 0; i < 4; ++i) { const v4u y = qb[i];
#pragma unroll
                  for (int j = 0; j < 4; ++j) bv[4 * i + j] = ord2f(y[j] & ~127u); } }
#define CKEY(i, j) ((f2ord(ord2f(pa[i] & ~127u) + bv[j]) & ~255u) | (unsigned)(255 - ((i) * 16 + (j))))
            unsigned c0[16];
#pragma unroll
            for (int j = 0; j < 16; ++j) c0[j] = CKEY(0, j);
            bitonic_sort_desc<16>(c0);
            {
                unsigned cb[16];
#pragma unroll
                for (int j = 0; j < 8; ++j) cb[j] = CKEY(1, j);
#pragma unroll
                for (int j = 0; j < 5; ++j) cb[8 + j] = CKEY(2, j);
#pragma unroll
                for (int j = 0; j < 3; ++j) cb[13 + j] = CKEY(4, j);
                bitonic_sort_desc<16>(cb); merge_top16(c0, cb);
            }
            {
                unsigned cc[16];
#pragma unroll
                for (int j = 0; j < 4; ++j) cc[j] = CKEY(3, j);
#pragma unroll
                for (int j = 0; j < 2; ++j) { cc[4 + j] = CKEY(5, j); cc[6 + j] = CKEY(6, j); cc[8 + j] = CKEY(7, j); }
                cc[10] = CKEY(8, 0); cc[11] = CKEY(9, 0); cc[12] = CKEY(10, 0); cc[13] = CKEY(11, 0); cc[14] = CKEY(12, 0); cc[15] = CKEY(13, 0);
                bitonic_sort_desc<16>(cc); merge_top16(c0, cc);
            }
            { unsigned x = CKEY(14, 0);
#pragma unroll
              for (int k = 0; k < 16; ++k) ce_desc(c0[k], x);
              x = CKEY(15, 0);
#pragma unroll
              for (int k = 0; k < 16; ++k) ce_desc(c0[k], x); }
#undef CKEY
            float sv[16]; unsigned ix[16]; float mx = -3.0e38f;
#pragma unroll
            for (int k = 0; k < 16; ++k) { const unsigned pos = 255u - (c0[k] & 255u); const unsigned ua = pa[pos >> 4], ub = pb[pos & 15];
                sv[k] = ord2f(ua & ~127u) + ord2f(ub & ~127u); ix[k] = (127u - (ua & 127u)) * 128u + (127u - (ub & 127u)); mx = fmaxf(mx, sv[k]); }
            float sum = 0.f;
#pragma unroll
            for (int k = 0; k < 16; ++k) { sv[k] = __expf(sv[k] - mx); sum += sv[k]; }
            const float inv = 1.f / sum;
            unsigned c4[4] = {0u, 0u, 0u, 0u};
#pragma unroll
            for (int k = 0; k < 16; ++k) { const unsigned s = ix[k] >> 11, inc = 1u << ((s & 3u) * 8u);
#pragma unroll
                for (int w = 0; w < 4; ++w) c4[w] += ((s >> 2) == (unsigned)w) ? inc : 0u; }
            CNT[h * 64 + t] = (v4u){c4[0], c4[1], c4[2], c4[3]};
            unsigned e0[16]; float e1[16];
#pragma unroll
            for (int k = 0; k < 16; ++k) { const f32x2 sc2 = *(const f32x2*)(F.SUV + 2 * ix[k]); e0[k] = ix[k] << 10; e1[k] = __uint_as_float((f2bf(sv[k] * inv * sc2.y) << 16) | f2bf(sc2.x)); }
            __syncthreads();
            unsigned A4[4] = {0u, 0u, 0u, 0u}, B4[4] = {0u, 0u, 0u, 0u};
#pragma unroll
            for (int hh = 0; hh < 8; ++hh) { const v4u v = CNT[hh * 64 + t];
#pragma unroll
                for (int w = 0; w < 4; ++w) { A4[w] += v[w]; B4[w] += (hh < h) ? v[w] : 0u; } }
            unsigned off4[4] = {0u, 0u, 0u, 0u}; unsigned run = 0u;
#pragma unroll
            for (int s = 0; s < 16; ++s) { off4[s >> 2] |= run << ((s & 3) * 8); run += (A4[s >> 2] >> ((s & 3) * 8)) & 255u; }
            if (h == 0) { *(LAS v4u*)(OFFS + t * 32) = (v4u){off4[0], off4[1], off4[2], off4[3]}; OFFS[t * 32 + 16] = (unsigned char)128; }
            unsigned base4[4], r4[4] = {0u, 0u, 0u, 0u};
#pragma unroll
            for (int w = 0; w < 4; ++w) base4[w] = off4[w] + B4[w];
#pragma unroll
            for (int k = 0; k < 16; ++k) { const unsigned s = ix[k] >> 11, wsel = s >> 2, sh8 = (s & 3u) * 8u;
                const unsigned bsel = wsel == 0 ? base4[0] : wsel == 1 ? base4[1] : wsel == 2 ? base4[2] : base4[3];
                const unsigned rsel = wsel == 0 ? r4[0] : wsel == 1 ? r4[1] : wsel == 2 ? r4[2] : r4[3];
                const unsigned pos = ((bsel >> sh8) & 255u) + ((rsel >> sh8) & 255u);
                IDXS[t * 129 + pos] = (v2u){e0[k], __float_as_uint(e1[k])};
#pragma unroll
                for (int w = 0; w < 4; ++w) r4[w] += (wsel == (unsigned)w) ? (1u << sh8) : 0u; }
        }
        __syncthreads();
        {
#pragma unroll 2
            for (int tk = 0; tk < 8; ++tk) { const int tl = wave * 8 + tk; const size_t row = r0 + tl;
                const v4u a = *(const v4u*)(F.H2 + row * D + 16 * lane), bq = *(const v4u*)(F.H2 + row * D + 16 * lane + 8);
                float hv[16]; float am = 0.f;
#pragma unroll
                for (int w = 0; w < 4; ++w) { hv[2 * w] = bf2f(a[w] & 0xffffu); hv[2 * w + 1] = __uint_as_float(a[w] & 0xffff0000u); hv[8 + 2 * w] = bf2f(bq[w] & 0xffffu); hv[8 + 2 * w + 1] = __uint_as_float(bq[w] & 0xffff0000u); }
#pragma unroll
                for (int i = 0; i < 16; ++i) am = fmaxf(am, fabsf(hv[i]));
#pragma unroll
                for (int o = 1; o < 64; o <<= 1) am = fmaxf(am, __shfl_xor(am, o));
                const float inv = am > 0.f ? 127.f / am : 0.f; unsigned hq[4];
#pragma unroll
                for (int i = 0; i < 4; ++i) { const int q0 = (int)rintf(hv[4 * i] * inv), q1 = (int)rintf(hv[4 * i + 1] * inv), q2 = (int)rintf(hv[4 * i + 2] * inv), q3 = (int)rintf(hv[4 * i + 3] * inv);
                    hq[i] = (unsigned)(q0 & 255) | ((unsigned)(q1 & 255) << 8) | ((unsigned)(q2 & 255) << 16) | ((unsigned)(q3 & 255) << 24); }
                *(LAS v4u*)(HQ + tl * 1024 + 16 * lane) = (v4u){hq[0], hq[1], hq[2], hq[3]};
                if (lane == 0) SH[tl] = am * (1.f / 127.f); }
        }
        __syncthreads();
        {
            const int c16 = lane & 15, rp = lane >> 4;
            f32x2 acc[8][8];
#pragma unroll
            for (int tk = 0; tk < 8; ++tk) {
#pragma unroll
                for (int i = 0; i < 8; ++i) acc[tk][i] = (f32x2){0.f, 0.f}; }
#pragma unroll 1
            for (int s = 0; s < 16; ++s) {
#pragma unroll
                for (int tk = 0; tk < 8; ++tk) {
                    const int tl = wave * 8 + tk;
                    const int n0 = OFFS[tl * 32 + s], n1 = OFFS[tl * 32 + s + 1];
                    if (n0 >= n1) continue;
                    const float sh = SH[tl];
                    const LAS v2u* ent = IDXS + tl * 129;
                    v4u hq[4];
#pragma unroll
                    for (int S = 0; S < 4; ++S) hq[S] = *(const LAS v4u*)(HQ + tl * 1024 + c16 * 16 + S * 256);
                    const unsigned uoff = (unsigned)c16 * 16u, voff = (unsigned)lane * 16u;
#pragma unroll 1
                    for (int i = n0; i < n1; i += 4) {
                        const int last = n1 - 1;
                        const int iu = (i + rp) < last ? (i + rp) : last;
                        const v2u eu = ent[iu];
                        v4u uu[4], vv[4]; float gsv[4];
#pragma unroll
                        for (int S = 0; S < 4; ++S) uu[S] = *(const v4u*)(F.U8 + (eu.x + uoff + (unsigned)S * 256u));
#pragma unroll
                        for (int j = 0; j < 4; ++j) { const int ij = (i + j) < last ? (i + j) : last; const v2u ev = ent[ij];
                            vv[j] = *(const v4u*)(F.V8 + (ev.x + voff)); gsv[j] = (i + j) <= last ? __uint_as_float(ev.y & 0xffff0000u) : 0.f; }
                        int dt = 0;
#pragma unroll
                        for (int S = 0; S < 4; ++S)
#pragma unroll
                            for (int w = 0; w < 4; ++w) dt = __builtin_amdgcn_sdot4((int)uu[S][w], (int)hq[S][w], dt, false);
                        dt = row16_sum_i32(dt);
                        const float gl = gelu_as((float)dt * (__uint_as_float(eu.y << 16) * sh));
#pragma unroll
                        for (int j = 0; j < 4; ++j) {
                            const float cj = __uint_as_float(__builtin_amdgcn_readlane(__float_as_uint(gl), 16 * j)) * gsv[j];
                            const f32x2 c2 = {cj, cj};
#pragma unroll
                            for (int w = 0; w < 4; ++w) { const int x = (int)vv[j][w];
                                acc[tk][2 * w] += c2 * __builtin_amdgcn_cvt_pk_f32_fp8(x, false);
                                acc[tk][2 * w + 1] += c2 * __builtin_amdgcn_cvt_pk_f32_fp8(x, true); }
                        }
                    }
                }
            }
#pragma unroll
            for (int tk = 0; tk < 8; ++tk) {
                const int tl = wave * 8 + tk; const size_t row = r0 + tl; const int b = (int)(row >> 13);
                float x2[16]; float ss = 0.f; const int d0i = 16 * lane;
#pragma unroll
                for (int q = 0; q < 4; ++q) { const f32x4 xa = *(const f32x4*)(F.out + row * D + d0i + 4 * q), ga = *(const f32x4*)(F.MOD + b * 6144 + 5120 + d0i + 4 * q);
#pragma unroll
                    for (int j = 0; j < 4; ++j) { const float a = acc[tk][2 * q + (j >> 1)][j & 1]; const float pv = a; x2[4 * q + j] = xa[j] + ga[j] * pv; ss += x2[4 * q + j] * x2[4 * q + j]; } }
                const float rstd = 1.f / sqrtf(wave_sum(ss) * (1.f / D) + EPS);
#pragma unroll
                for (int q = 0; q < 4; ++q) { const f32x4 wa = *(const f32x4*)(F.final_w + d0i + 4 * q); f32x4 oa;
#pragma unroll
                    for (int j = 0; j < 4; ++j) oa[j] = x2[4 * q + j] * rstd * wa[j];
                    *(f32x4*)(F.out + row * D + d0i + 4 * q) = oa; }
            }
        }
        __syncthreads();
    }
}

#define XB_TMO      128
#define XB_XCNT(j)  (256  + 64 * (j))
#define XB_XSUB(j)  (1280 + 64 * (j))
#define XB_XGEN(j)  (2304 + 64 * (j))
#define XB_TOP      3328
#define XB_TOPGEN   3392
#define XCD_BAR_WORDS 3456
#define XB_SPIN_CAP (1u << 20)
__device__ __forceinline__ unsigned xb_ld(unsigned* p)              { return __hip_atomic_load(p, __ATOMIC_RELAXED, __HIP_MEMORY_SCOPE_AGENT); }
__device__ __forceinline__ unsigned xb_add(unsigned* p, unsigned v) { return __hip_atomic_fetch_add(p, v, __ATOMIC_RELAXED, __HIP_MEMORY_SCOPE_AGENT); }
__device__ __forceinline__ unsigned xb_xcc_id() { return (unsigned)__builtin_amdgcn_s_getreg((3 << 11) | 20) & 0xFu; }
#define XB_SPIN(cond, bar) do { unsigned _sp = 0; while (cond) { __builtin_amdgcn_s_sleep(1); \
    if ((++_sp & 255u) == 0u) { if (xb_ld(&(bar)[XB_TMO])) break; if (_sp > XB_SPIN_CAP) { atomicAdd(&(bar)[XB_TMO], 1u); break; } } } } while (0)
struct XcdBarrier { unsigned* bar; unsigned x; volatile LAS unsigned* st; };
__device__ __forceinline__ XcdBarrier xcd_barrier_post(unsigned* bar, volatile LAS unsigned* st) {
    XcdBarrier b; b.bar = bar; b.x = xb_xcc_id(); b.st = st;
    if (threadIdx.x == 0) (void)xb_add(&bar[XB_XCNT(b.x)], 1u);
    return b;
}
__device__ __forceinline__ void xcd_barrier_complete(unsigned* bar, unsigned x, unsigned& nloc, unsigned& nx) {
    const unsigned G = gridDim.x * gridDim.y * gridDim.z;
    unsigned sum, cnt, mine, sp = 0u;
    for (;;) {
        sum = 0u; cnt = 0u; mine = 0u;
#pragma unroll
        for (unsigned j = 0; j < 16; ++j) { const unsigned c = xb_ld(&bar[XB_XCNT(j)]); sum += c; cnt += (c > 0u) ? 1u : 0u; mine = (j == x) ? c : mine; }
        if (sum == G) break;
        __builtin_amdgcn_s_sleep(1);
        if ((++sp & 255u) == 0u) { if (xb_ld(&bar[XB_TMO])) break; if (sp > XB_SPIN_CAP) { atomicAdd(&bar[XB_TMO], 1u); break; } }
    }
    nloc = mine > 0u ? mine : 1u; nx = cnt > 0u ? cnt : 1u;
}
__device__ __forceinline__ void xcd_barrier(const XcdBarrier& b) {
    asm volatile("s_waitcnt vmcnt(0)" ::: "memory");
    __syncthreads();
    if (threadIdx.x == 0) {
        unsigned* bar = b.bar;
        __builtin_amdgcn_s_waitcnt(0);
        unsigned nloc = b.st[0], nx = b.st[1];
        if (nloc == 0u) { xcd_barrier_complete(bar, b.x, nloc, nx); b.st[0] = nloc; b.st[1] = nx; }
        const unsigned old = xb_add(&bar[XB_XSUB(b.x)], 1u);
        const unsigned gen = old / nloc;
        if (old + 1u == (gen + 1u) * nloc) {
            __builtin_amdgcn_fence(__ATOMIC_RELEASE, "agent");
            asm volatile("s_waitcnt vmcnt(0)" ::: "memory");
            const unsigned og = xb_add(&bar[XB_TOP], 1u);
            const unsigned tg = og / nx;
            if (og + 1u == (tg + 1u) * nx) xb_add(&bar[XB_TOPGEN], 1u);
            else XB_SPIN(xb_ld(&bar[XB_TOPGEN]) == tg, bar);
            __builtin_amdgcn_fence(__ATOMIC_ACQUIRE, "agent");
            xb_add(&bar[XB_XGEN(b.x)], 1u);
            asm volatile("s_waitcnt vmcnt(0)" ::: "memory");
        } else {
            XB_SPIN(xb_ld(&bar[XB_XGEN(b.x)]) == gen, bar);
            __builtin_amdgcn_fence(__ATOMIC_ACQUIRE, "agent");
            asm volatile("s_waitcnt vmcnt(0)" ::: "memory");
        }
    }
    __syncthreads();
}

__global__ void __launch_bounds__(NTHR, 2) mk_fwd(Args args) {
    extern __shared__ __attribute__((aligned(16))) unsigned char lds_raw[];
    Ctx F;
    F.lds = (LAS unsigned char*)lds_raw;
    F.tid = threadIdx.x; F.lane = F.tid & 63; F.wave = __builtin_amdgcn_readfirstlane(F.tid >> 6); F.G = gridDim.x; F.bid = blockIdx.x;
    F.x = args.in[0]; F.c = args.in[1]; F.w_ada = args.in[2]; F.b_ada = args.in[3]; F.norm1_w = args.in[4]; F.w_in = args.in[5]; F.lb_logits = args.in[6];
    F.hgrn_onorm_w = args.in[7]; F.conv_w = args.in[8]; F.conv_onorm_w = args.in[9]; F.w_out = args.in[10]; F.norm2_w = args.in[11]; F.w_query = args.in[12];
    F.sub_keys = args.in[13]; F.peer_u = args.in[14]; F.peer_v = args.in[15]; F.final_w = args.in[16];
    F.out = args.out;
    unsigned char* ws = args.ws;
    F.ACH = (float*)(ws + WS_ACH); F.MOD = (float*)(ws + WS_MOD); F.LB = (float*)(ws + WS_LB);
    F.WIN = (bf16*)(ws + WS_WIN); F.WOUT = (bf16*)(ws + WS_WOUT); F.WQ = (bf16*)(ws + WS_WQ); F.KEYS = (bf16*)(ws + WS_KEYS);
    F.U8 = ws + WS_U8; F.V8 = ws + WS_V8; F.SUV = (float*)(ws + WS_SUV); F.H1 = (bf16*)(ws + WS_H1); F.YCAT = (bf16*)(ws + WS_H1);
    F.PROJ = (bf16*)(ws + WS_PROJ); F.H2 = (bf16*)(ws + WS_PROJ); F.QP = (bf16*)(ws + WS_PROJ + 32 * MiB); F.ST = (bf16*)(ws + WS_ST);
    const int lo = args.ph_lo, hi = args.ph_hi;
    volatile LAS unsigned* MISC = (volatile LAS unsigned*)(F.lds + MISC_OFF);
    if (F.tid < 16) MISC[F.tid] = 0u;
    __syncthreads();
    XcdBarrier bar = xcd_barrier_post((unsigned*)(ws + WS_CTL), MISC);
#define IN(k) (lo <= (k) && (k) < hi)
#define SEAM(k) do { if (IN(k) && IN((k) + 1)) { xcd_barrier(bar); } } while (0)
    if (IN(0)) { for (int rep = 0; rep < NREP(0); ++rep) p0_prep(F); } SEAM(0);
    if (IN(1)) for (int rep = 0; rep < NREP(1); ++rep) { if (rep == 0) p0_prep2(F); const int gw = F.bid * NWAVES + F.wave, NGW = F.G * NWAVES;
        for (int m = gw; m < M; m += NGW) { const float* md = F.MOD + (m >> 13) * 6144; modnorm_row(F.x + (size_t)m * D, F.norm1_w, md, md + 1024, F.H1 + (size_t)m * D, F.lane); } } SEAM(1);
    if (IN(2)) for (int rep = 0; rep < NREP(2); ++rep) { pg8::Gemm g{F.H1, F.WIN, M, NIN, D}; pg8::StaticOrder S; S.init(M, NIN, F.G, F.bid); pg8::EpiBf16 E{F.PROJ, NIN}; pg8::gemm_phase<pg8::EpiBf16>(F.lds, g, S, E);
        if (rep == 0) { if (F.G == 256) { if (F.bid >= 128) convert_experts(F, F.bid - 128, 128); } else convert_experts(F, F.bid, F.G); } } SEAM(2);
    if (IN(3)) { for (int rep = 0; rep < NREP(3); ++rep) p3_local(F); } SEAM(3);
    if (IN(4)) { p4_scan(F); } SEAM(4);
    if (IN(5)) { for (int rep = 0; rep < NREP(5); ++rep) p5_out(F); } SEAM(5);
    if (IN(6)) for (int rep = 0; rep < NREP(6); ++rep) { pg8::Gemm g{F.YCAT, F.WOUT, M, D, D}; pg8::StaticOrder S; S.init(M, D, F.G, F.bid); pg8::EpiRes E{F.x, F.out, F.MOD}; pg8::gemm_phase<pg8::EpiRes>(F.lds, g, S, E); } SEAM(6);
    if (IN(7)) for (int rep = 0; rep < NREP(7); ++rep) { const int gw = F.bid * NWAVES + F.wave, NGW = F.G * NWAVES;
        for (int m = gw; m < M; m += NGW) { const float* md = F.MOD + (m >> 13) * 6144; modnorm_row(F.out + (size_t)m * D, F.norm2_w, md + 3072, md + 4096, F.H2 + (size_t)m * D, F.lane); } } SEAM(7);
    if (IN(8)) for (int rep = 0; rep < NREP(8); ++rep) { pg8::Gemm g{F.H2, F.WQ, M, NQ, D}; pg8::StaticOrder S; S.init(M, NQ, F.G, F.bid); pg8::EpiBf16 E{F.QP, NQ}; pg8::gemm_phase<pg8::EpiBf16>(F.lds, g, S, E); } SEAM(8);
#ifndef DBG_STOP
    if (IN(9)) { p9_peer(F); }
#else
    xcd_barrier(bar);
    {
        const size_t gt = (size_t)F.bid * NTHR + F.tid, gs = (size_t)F.G * NTHR;
        for (size_t i = gt; i < (size_t)M * D; i += gs) { const size_t r = i >> 10, c = i & 1023; float v = 0.f;
            if (DBG_STOP == 2) { const bf16* p = F.PROJ + r * NIN + c; v = bf2f(p[0]) + bf2f(p[1024]) + bf2f(p[2048]) + (c < 512 ? bf2f(p[3072]) : 0.f); }
            else if (DBG_STOP == 5) { v = bf2f(F.YCAT[r * D + c]); }
            else if (DBG_STOP == 6) { v = F.out[i]; }
            else if (DBG_STOP == 8) { v = bf2f(F.QP[r * NQ + c]) + bf2f(F.QP[r * NQ + c + 1024]); }
            else if (DBG_STOP == 4 || DBG_STOP == 3) { v = bf2f(F.ST[i]); }
            else if (DBG_STOP == 1) { v = bf2f(F.H1[i]); }
            F.out[i] = v; }
    }
#endif
#undef IN
#undef SEAM
}

extern "C" void kernel_launch(void* const* d_in, const int* in_sizes, int n_in, void* d_out, int out_size, void* d_ws, size_t ws_size, hipStream_t stream) {
    static int grid = 0;
    if (grid == 0) {
        if (n_in != 17 || out_size != M * D || ws_size < WS_END) { fprintf(stderr, "kernel_launch: unexpected shapes (n_in %d out %d ws %zu)\n", n_in, out_size, ws_size); grid = -1; return; }
        int dev = 0, cus = 0, per_cu = 0;
        (void)hipGetDevice(&dev); (void)hipDeviceGetAttribute(&cus, hipDeviceAttributeMultiprocessorCount, dev);
        if (hipFuncSetAttribute((const void*)mk_fwd, hipFuncAttributeMaxDynamicSharedMemorySize, LDS_BYTES) != hipSuccess) { fprintf(stderr, "kernel_launch: hipFuncSetAttribute failed\n"); grid = -1; return; }
        if (hipOccupancyMaxActiveBlocksPerMultiprocessor(&per_cu, (const void*)mk_fwd, NTHR, LDS_BYTES) != hipSuccess || per_cu < 1) { fprintf(stderr, "kernel_launch: occupancy query gives %d\n", per_cu); per_cu = 1; }
        (void)hipGetLastError();
        grid = cus;
    }
    if (grid < 0) return;
    if (hipMemsetAsync((char*)d_ws + WS_CTL, 0, CTL_ZERO_BYTES, stream) != hipSuccess) { fprintf(stderr, "kernel_launch: memset failed\n"); return; }
    Args a{};
    for (int i = 0; i < 17; ++i) a.in[i] = (const float*)d_in[i];
    a.out = (float*)d_out; a.ws = (unsigned char*)d_ws;
#if MK_LAUNCHES == 1
#ifdef DBG_STOP
    a.ph_lo = 0; a.ph_hi = DBG_STOP + 1;
#else
    a.ph_lo = 0; a.ph_hi = 10;
#endif
    void* kargs[] = {&a};
    hipError_t e = hipLaunchCooperativeKernel((const void*)mk_fwd, dim3(grid), dim3(NTHR), kargs, LDS_BYTES, stream);
    if (e != hipSuccess) fprintf(stderr, "kernel_launch: cooperative launch failed: %s (grid %d)\n", hipGetErrorString(e), grid);
#else
    for (int ph = 0; ph < 10; ++ph) { a.ph_lo = ph; a.ph_hi = ph + 1; hipLaunchKernelGGL(mk_fwd, dim3(grid), dim3(NTHR), LDS_BYTES, stream, a); }
#endif
}
```

```cpp
#include <hip/hip_runtime.h>
#include <hip/hip_cooperative_groups.h>
#include <cstdio>
#include <cstdint>
namespace cg = cooperative_groups;

#ifndef REP_MASK
#define REP_MASK 0
#endif
#define NREP(k) (((REP_MASK) >> (k)) & 1 ? 2 : 1)
#ifndef MK_LAUNCHES
#define MK_LAUNCHES 1
#endif

#define LAS __attribute__((address_space(3)))
typedef unsigned short bf16;
typedef unsigned v4u __attribute__((ext_vector_type(4)));
typedef unsigned v2u __attribute__((ext_vector_type(2)));
typedef float f32x4 __attribute__((ext_vector_type(4)));
typedef short bf16x8 __attribute__((ext_vector_type(8)));
typedef __bf16 bf16x2 __attribute__((ext_vector_type(2)));

constexpr int D = 1024, SEQ = 8192, M = 16384;
constexpr int NIN = 3584, NQ = 2048;
constexpr float EPS = 1e-6f;
constexpr int NWAVES = 8, NTHR = 512;

constexpr size_t MiB = 1u << 20;
constexpr size_t WS_ACH = 1 * MiB;
constexpr size_t WS_MOD = 1 * MiB + 512 * 1024;
constexpr size_t WS_LB = WS_MOD + 64 * 1024;
constexpr size_t WS_WIN = 2 * MiB;
constexpr size_t WS_WOUT = 9 * MiB;
constexpr size_t WS_WQ = 11 * MiB;
constexpr size_t WS_KEYS = 15 * MiB;
constexpr size_t WS_U8 = 16 * MiB, WS_V8 = 32 * MiB;
constexpr size_t WS_SUV = WS_MOD + 128 * 1024;
constexpr size_t WS_H1 = 80 * MiB;
constexpr size_t WS_PROJ = 112 * MiB;
constexpr size_t WS_ST = 224 * MiB;
constexpr size_t WS_END = 256 * MiB;
constexpr int LDS_BYTES = 147456, MISC_OFF = 147456 - 256;
constexpr size_t WS_CTL = 0, CTL_ZERO_BYTES = 65536;

__device__ __forceinline__ float bf2f(unsigned h) { return __uint_as_float(h << 16); }
__device__ __forceinline__ unsigned f2bf(float f) { unsigned u = __float_as_uint(f); return (u + 0x7fffu + ((u >> 16) & 1u)) >> 16; }
typedef float f32x2 __attribute__((ext_vector_type(2)));
__device__ __forceinline__ unsigned pk2(float lo, float hi) { const f32x2 v = {lo, hi}; return __builtin_bit_cast(unsigned, __builtin_convertvector(v, bf16x2)); }
__device__ __forceinline__ float dot2(unsigned w, unsigned x, float acc) { return __builtin_amdgcn_fdot2_f32_bf16(__builtin_bit_cast(bf16x2, w), __builtin_bit_cast(bf16x2, x), acc, false); }
__device__ __forceinline__ float wave_sum(float v) {
#pragma unroll
    for (int o = 1; o < 64; o <<= 1) v += __shfl_xor(v, o);
    return v;
}

namespace pg8 {
constexpr int BM = 256, BK = 64, HALF = 128, HTB = HALF * BK * 2, STAGE_BYTES = 8 * HTB, NXCD = 8, WGM = 8;
__host__ __device__ __forceinline__ int lds_byte(int r, int c) { const int st = (r >> 4) * 2 + (c >> 5), rr = r & 15, cc = c & 31, ob = rr * 64 + cc * 2; return st * 1024 + (ob ^ (((ob >> 9) & 1) << 5)); }
__host__ __device__ __forceinline__ void stage_rc(int b, int& R, int& C) { const int st = b / 1024, sb = b % 1024, swz = sb ^ (((sb >> 9) & 1) << 5); R = (st >> 1) * 16 + swz / 64; C = (st & 1) * 32 + (swz % 64) / 2; }
__host__ __device__ __forceinline__ int perm32(int rho) { const int n = rho >> 4, i = rho & 15; return 8 * (i >> 2) + 4 * n + (i & 3); }
struct Unit { int pm, pn; };
struct Gemm { const bf16* A; const bf16* Bt; int M, N, K; };
struct StaticOrder {
    int nM, nN, nwg, G, c;
    __host__ __device__ void init(int M_, int N_, int G_, int c_) { nM = M_ / BM; nN = N_ / BM; nwg = nM * nN; G = G_; c = c_; }
    __host__ __device__ bool next(int i, Unit& u) const {
        const long L = (long)i * G + c; if (L >= nwg) return false;
        int wgid = (int)L; { const int q = nwg / NXCD, r = nwg % NXCD, xcd = wgid % NXCD, off = wgid / NXCD; wgid = (xcd < r ? xcd * (q + 1) : r * (q + 1) + (xcd - r) * q) + off; }
        const int nig = WGM * nN, gid = wgid / nig, fm = gid * WGM, gsz = (nM - fm) < WGM ? (nM - fm) : WGM;
        u.pm = fm + ((wgid % nig) % gsz); u.pn = (wgid % nig) / gsz; return true;
    }
};
struct EpiBf16 {
    static constexpr bool PERM = true;
    bf16* O; int ldc;
    __device__ __forceinline__ void operator()(const f32x4 (&acc)[2][2][4][2], const Unit& u, int wr, int wc, int fr, int fq) const {
        const int row0 = u.pm * BM + wr * 64 + fr; const int col0 = u.pn * BM + wc * 32 + 8 * fq;
#pragma unroll
        for (int ai = 0; ai < 2; ++ai)
#pragma unroll
            for (int m = 0; m < 4; ++m) { bf16* rowp = O + (size_t)(row0 + ai * HALF + m * 16) * ldc + col0;
#pragma unroll
                for (int bj = 0; bj < 2; ++bj) { const f32x4 v0 = acc[ai][bj][m][0], v1 = acc[ai][bj][m][1];
                    v4u w; w.x = pk2(v0[0], v0[1]); w.y = pk2(v0[2], v0[3]); w.z = pk2(v1[0], v1[1]); w.w = pk2(v1[2], v1[3]);
                    *(v4u*)(rowp + bj * HALF) = w; } }
    }
};
struct EpiRes {
    static constexpr bool PERM = true;
    const float* x; bf16* out; const float* mod;
    __device__ __forceinline__ void operator()(const f32x4 (&acc)[2][2][4][2], const Unit& u, int wr, int wc, int fr, int fq) const {
        const int row0 = u.pm * BM + wr * 64 + fr, col0 = u.pn * BM + wc * 32 + 8 * fq; const int b = u.pm >> 5;
        f32x4 gv[2][2];
#pragma unroll
        for (int bj = 0; bj < 2; ++bj)
#pragma unroll
            for (int n = 0; n < 2; ++n) gv[bj][n] = *(const f32x4*)(mod + b * 6144 + 2048 + col0 + bj * HALF + 4 * n);
#pragma unroll
        for (int ai = 0; ai < 2; ++ai)
#pragma unroll
            for (int m = 0; m < 4; ++m) { const size_t off = (size_t)(row0 + ai * HALF + m * 16) * D + col0;
#pragma unroll
                for (int bj = 0; bj < 2; ++bj) { const f32x4 x0 = *(const f32x4*)(x + off + bj * HALF), x1 = *(const f32x4*)(x + off + bj * HALF + 4);
                    const f32x4 v0 = x0 + gv[bj][0] * acc[ai][bj][m][0], v1 = x1 + gv[bj][1] * acc[ai][bj][m][1];
                    v4u w; w.x = pk2(v0[0], v0[1]); w.y = pk2(v0[2], v0[3]); w.z = pk2(v1[0], v1[1]); w.w = pk2(v1[2], v1[3]);
                    *(v4u*)(out + off + bj * HALF) = w; } }
    }
};

template <class Epi, bool ALIGN_EPI = true>
__device__ __forceinline__ void gemm_phase(LAS unsigned char* lds, const Gemm g, const StaticOrder& S, const Epi& E) {
    const int tid = threadIdx.x, wid = __builtin_amdgcn_readfirstlane(tid >> 6), lane = tid & 63, wr = wid >> 2, wc = wid & 3, fr = lane & 15, fq = lane >> 4;
    const int K = g.K, nt = K / BK;
    unsigned voffA[2], voffB[2];
#pragma unroll
    for (int i = 0; i < 2; ++i) { int R, C; stage_rc(tid * 16 + i * 8192, R, C); const int Rb = Epi::PERM ? ((R & ~31) + perm32(R & 31)) : R;
        voffA[i] = (unsigned)(R * K + C) * 2u; voffB[i] = (unsigned)(Rb * K + C) * 2u; }
    const size_t kstep = (size_t)(BK * 2);
    const size_t hstep = (size_t)HALF * K * 2;
    const size_t tstep = 2 * hstep;
    const unsigned ldsw = (unsigned)wid * 1024u;
    const int aoff = lds_byte(wr * 64 + fr, fq * 8), boff = lds_byte(wc * 32 + fr, fq * 8);
#define PG8_SA(b, h) (((b) * 2 + (h)) * HTB)
#define PG8_SB(b, h) ((4 + (b) * 2 + (h)) * HTB)
#define PG8_STAGE(bufoff, gbase, voff) do { _Pragma("unroll") for (int _i = 0; _i < 2; ++_i) \
        __builtin_amdgcn_global_load_lds((const unsigned*)((const char*)(gbase) + (voff)[_i]), (LAS unsigned*)(lds + (bufoff) + ldsw + _i * 8192), 16, 0, 0); } while (0)
#define PG8_LDA(dst, b, h) do { _Pragma("unroll") for (int m = 0; m < 4; ++m) _Pragma("unroll") for (int k = 0; k < 2; ++k) dst[m][k] = *(const LAS bf16x8*)(lds + PG8_SA(b, h) + aoff + m * 2048 + k * 1024); } while (0)
#define PG8_LDB(dst, b, h) do { _Pragma("unroll") for (int n = 0; n < 2; ++n) _Pragma("unroll") for (int k = 0; k < 2; ++k) dst[n][k] = *(const LAS bf16x8*)(lds + PG8_SB(b, h) + boff + n * 2048 + k * 1024); } while (0)
#define PG8_MMA(ai, bj, At, Bt) do { __builtin_amdgcn_s_setprio(1); _Pragma("unroll") for (int m = 0; m < 4; ++m) _Pragma("unroll") for (int n = 0; n < 2; ++n) _Pragma("unroll") for (int k = 0; k < 2; ++k) \
        acc[ai][bj][m][n] = __builtin_amdgcn_mfma_f32_16x16x32_bf16(Bt[n][k], At[m][k], acc[ai][bj][m][n], 0, 0, 0); __builtin_amdgcn_s_setprio(0); } while (0)
#define PG8_WAIT_V(n) asm volatile("s_waitcnt vmcnt(" #n ")" ::: "memory")
#define PG8_WAIT_L(n) asm volatile("s_waitcnt lgkmcnt(" #n ")" ::: "memory")
#define PG8_BAR __builtin_amdgcn_s_barrier()
#define PG8_SCHED __builtin_amdgcn_sched_barrier(0)
    Unit cur, nxt; int ui = 0;
    if (!S.next(0, cur)) return;
    f32x4 acc[2][2][4][2];
#pragma unroll
    for (int a = 0; a < 2; ++a)
#pragma unroll
        for (int b = 0; b < 2; ++b)
#pragma unroll
            for (int m = 0; m < 4; ++m)
#pragma unroll
                for (int n = 0; n < 2; ++n) acc[a][b][m][n] = (f32x4){0.f, 0.f, 0.f, 0.f};
    bf16x8 At[4][2], B0[2][2], B1[2][2];
    const char* cA = (const char*)g.A + (size_t)cur.pm * tstep; const char* cB = (const char*)g.Bt + (size_t)cur.pn * tstep;
    PG8_STAGE(PG8_SB(0, 0), cB, voffB); PG8_STAGE(PG8_SB(0, 1), cB + hstep, voffB); PG8_STAGE(PG8_SA(0, 0), cA, voffA); PG8_STAGE(PG8_SA(0, 1), cA + hstep, voffA);
    if (wr == 1) PG8_BAR;
    PG8_WAIT_V(2); PG8_BAR;
    PG8_STAGE(PG8_SB(1, 0), cB + kstep, voffB); PG8_STAGE(PG8_SA(1, 0), cA + kstep, voffA); PG8_STAGE(PG8_SB(1, 1), cB + hstep + kstep, voffB);
    PG8_WAIT_V(6); PG8_BAR;
    for (;;) {
        const bool has_next = S.next(ui + 1, nxt);
        const char* nA = has_next ? (const char*)g.A + (size_t)nxt.pm * tstep : cA; const char* nB = has_next ? (const char*)g.Bt + (size_t)nxt.pn * tstep : cB;
        for (int t = 0; t < nt; t += 2) {
            const bool last = (t == nt - 2);
            const char* a1 = cA + (size_t)(t + 1) * kstep;
            const char* a2 = last ? nA : cA + (size_t)(t + 2) * kstep; const char* b2 = last ? nB : cB + (size_t)(t + 2) * kstep;
            const char* a3 = a2 + kstep; const char* b3 = b2 + kstep;
            PG8_LDB(B0, 0, 0); PG8_LDB(B1, 0, 1); PG8_SCHED; PG8_LDA(At, 0, 0); PG8_STAGE(PG8_SA(1, 1), a1 + hstep, voffA);
            PG8_WAIT_V(8); PG8_WAIT_L(0); PG8_BAR; PG8_MMA(0, 0, At, B0); PG8_MMA(0, 1, At, B1); PG8_BAR; PG8_SCHED;
            PG8_LDA(At, 0, 1); PG8_STAGE(PG8_SB(0, 0), b2, voffB); PG8_STAGE(PG8_SB(0, 1), b2 + hstep, voffB); PG8_STAGE(PG8_SA(0, 0), a2, voffA);
            PG8_WAIT_V(8); PG8_WAIT_L(0); PG8_BAR; PG8_MMA(1, 0, At, B0); PG8_MMA(1, 1, At, B1); PG8_BAR; PG8_SCHED;
            PG8_LDB(B0, 1, 0); PG8_LDB(B1, 1, 1); PG8_SCHED; PG8_LDA(At, 1, 0); PG8_STAGE(PG8_SA(0, 1), a2 + hstep, voffA);
            PG8_WAIT_V(8); PG8_WAIT_L(0); PG8_BAR; PG8_MMA(0, 0, At, B0); PG8_MMA(0, 1, At, B1); PG8_BAR; PG8_SCHED;
            PG8_LDA(At, 1, 1); PG8_STAGE(PG8_SB(1, 0), b3, voffB); PG8_STAGE(PG8_SB(1, 1), b3 + hstep, voffB); PG8_STAGE(PG8_SA(1, 0), a3, voffA);
            PG8_WAIT_V(8); PG8_WAIT_L(0); PG8_BAR; PG8_MMA(1, 0, At, B0); PG8_MMA(1, 1, At, B1); PG8_BAR; PG8_SCHED;
        }
        if constexpr (ALIGN_EPI) { if (wr == 0) PG8_BAR; }
        E(acc, cur, wr, wc, fr, fq);
        if (!has_next) break;
#pragma unroll
        for (int a = 0; a < 2; ++a)
#pragma unroll
            for (int b = 0; b < 2; ++b)
#pragma unroll
                for (int m = 0; m < 4; ++m)
#pragma unroll
                    for (int n = 0; n < 2; ++n) acc[a][b][m][n] = (f32x4){0.f, 0.f, 0.f, 0.f};
        cur = nxt; cA = nA; cB = nB; ++ui;
        if constexpr (ALIGN_EPI) { if (wr == 1) PG8_BAR; }
    }
    PG8_WAIT_V(0);
    if constexpr (!ALIGN_EPI) { if (wr == 0) PG8_BAR; }
    PG8_BAR;
#undef PG8_SA
#undef PG8_SB
#undef PG8_STAGE
#undef PG8_LDA
#undef PG8_LDB
#undef PG8_MMA
#undef PG8_WAIT_V
#undef PG8_WAIT_L
#undef PG8_BAR
#undef PG8_SCHED
}
}

struct Args { const float* in[17]; float* out; unsigned char* ws; int ph_lo, ph_hi; };
struct Ctx {
    LAS unsigned char* lds; int tid, lane, wave, G, bid;
    const float *x, *c, *w_ada, *b_ada, *norm1_w, *w_in, *lb_logits, *hgrn_onorm_w, *conv_w, *conv_onorm_w, *w_out, *norm2_w, *w_query, *sub_keys, *peer_u, *peer_v, *final_w;
    float* out; float *ACH, *MOD, *LB;
    bf16 *WIN, *WOUT, *WQ, *KEYS, *H1, *YCAT, *PROJ, *H2, *QP, *ST, *X1B; unsigned char *U8, *V8; float *SUV;
};

__device__ __forceinline__ void p0_transpose_item(const float* W, int K, int N, bf16* WT, LAS float* scr, int item, int lane) {
    const int nblk = N / 32, kb = item / nblk, nb = item % nblk, k0 = 64 * kb, n0 = 32 * nb;
#pragma unroll 8
    for (int i = 0; i < 32; ++i) { const int kk = 2 * i + (lane >> 5); scr[kk * 33 + (lane & 31)] = W[(size_t)(k0 + kk) * N + n0 + (lane & 31)]; }
    asm volatile("s_waitcnt lgkmcnt(0)" ::: "memory"); __builtin_amdgcn_wave_barrier();
    const int c = lane & 7;
#pragma unroll
    for (int j = 0; j < 4; ++j) { const int n = (lane >> 3) + 8 * j; const LAS float* s = scr + (8 * c) * 33 + n;
        v4u o; o.x = pk2(s[0 * 33], s[1 * 33]); o.y = pk2(s[2 * 33], s[3 * 33]); o.z = pk2(s[4 * 33], s[5 * 33]); o.w = pk2(s[6 * 33], s[7 * 33]);
        *(v4u*)(WT + (size_t)(n0 + n) * K + k0 + 8 * c) = o; }
    asm volatile("s_waitcnt lgkmcnt(0)" ::: "memory"); __builtin_amdgcn_wave_barrier();
}
__device__ __forceinline__ void cvt_stream(const float* src, bf16* dst, size_t n8, size_t gtid, size_t gstride) {
    for (size_t i = gtid; i < n8; i += gstride) {
        const f32x4 a = *(const f32x4*)(src + i * 8), b = *(const f32x4*)(src + i * 8 + 4);
        v4u o; o.x = pk2(a[0], a[1]); o.y = pk2(a[2], a[3]); o.z = pk2(b[0], b[1]); o.w = pk2(b[2], b[3]);
        *(v4u*)(dst + i * 8) = o;
    }
}

__device__ __forceinline__ void p0_prep(Ctx& F) {
    {
        LAS float* sc = (LAS float*)(F.lds);
        LAS float* part = (LAS float*)(F.lds + 8192);
        for (int u = F.bid; u < 192; u += F.G) {
            for (int i = F.tid; i < 2048; i += NTHR) { const float v = F.c[i]; sc[i] = v / (1.f + __expf(-v)); }
            __syncthreads();
            const int cgp = F.tid & 7, kg = F.tid >> 3, n0 = 32 * u + 4 * cgp;
            f32x4 a0 = {0.f, 0.f, 0.f, 0.f}, a1 = {0.f, 0.f, 0.f, 0.f};
#pragma unroll 8
            for (int k = kg; k < 1024; k += 64) { const f32x4 w = *(const f32x4*)(F.w_ada + (size_t)k * 6144 + n0); a0 += w * sc[k]; a1 += w * sc[1024 + k]; }
            *(LAS f32x4*)(part + (kg * 2 + 0) * 32 + 4 * cgp) = a0; *(LAS f32x4*)(part + (kg * 2 + 1) * 32 + 4 * cgp) = a1;
            __syncthreads();
            if (F.tid < 64) { const int b = F.tid >> 5, col = F.tid & 31; float s = F.b_ada[32 * u + col];
#pragma unroll 8
                for (int q = 0; q < 64; ++q) s += part[(q * 2 + b) * 32 + col];
                F.MOD[b * 6144 + 32 * u + col] = s; }
            __syncthreads();
        }
    }
}

__device__ __forceinline__ void p0_prep2(Ctx& F) {
    if (F.bid == (F.G > 100 ? 100 : 0)) { const float l0 = F.lb_logits[F.tid], l1 = F.lb_logits[512 + F.tid]; F.LB[F.tid] = 1.f / (1.f + __expf(l1 - l0)); }
    {
        LAS float* scr = (LAS float*)(F.lds + 32768 + F.wave * 12288);
        const int gw = F.bid * NWAVES + F.wave, NGW = F.G * NWAVES;
        constexpr int I_IN = (D / 64) * (NIN / 32), I_OUT = (D / 64) * (D / 32), I_Q = (D / 64) * (NQ / 32);
        for (int it = gw; it < I_IN + I_OUT + I_Q; it += NGW) {
            int r = it;
            if (r < I_IN) { p0_transpose_item(F.w_in, D, NIN, F.WIN, scr, r, F.lane); continue; } r -= I_IN;
            if (r < I_OUT) { p0_transpose_item(F.w_out, D, D, F.WOUT, scr, r, F.lane); continue; } r -= I_OUT;
            p0_transpose_item(F.w_query, D, NQ, F.WQ, scr, r, F.lane);
        }
    }
    {
        const size_t gtid = (size_t)F.bid * NTHR + F.tid, gs = (size_t)F.G * NTHR;
        cvt_stream(F.sub_keys, F.KEYS, (size_t)16 * 128 * 128 / 8, gtid, gs);
    }
}

__device__ __forceinline__ void convert_experts(Ctx& F, int wg, int nwg) {
    {
        const int gw = wg * NWAVES + F.wave, NGW = nwg * NWAVES;
        for (int r = gw; r < 32768; r += NGW) {
            const bool isv = r >= 16384; const int e = r & 16383;
            const float* srow = (isv ? F.peer_v : F.peer_u) + (size_t)e * D;
            f32x4 v[4]; float am = 0.f;
#pragma unroll
            for (int j = 0; j < 4; ++j) { v[j] = *(const f32x4*)(srow + 4 * F.lane + 256 * j);
                am = fmaxf(am, fmaxf(fmaxf(fabsf(v[j].x), fabsf(v[j].y)), fmaxf(fabsf(v[j].z), fabsf(v[j].w)))); }
#pragma unroll
            for (int o = 1; o < 64; o <<= 1) am = fmaxf(am, __shfl_xor(am, o));
            unsigned* drow = (unsigned*)((isv ? F.V8 : F.U8) + (size_t)e * D);
            if (isv) {
                const float inv = am > 0.f ? 432.f / am : 0.f;
#pragma unroll
                for (int j = 0; j < 4; ++j) { int p = __builtin_amdgcn_cvt_pk_fp8_f32(v[j].x * inv, v[j].y * inv, 0, false); p = __builtin_amdgcn_cvt_pk_fp8_f32(v[j].z * inv, v[j].w * inv, p, true);
                    drow[F.lane + 64 * j] = (unsigned)p; }
                if (F.lane == 0) F.SUV[2 * e + 1] = am * (1.f / 432.f);
            } else {
                const float inv = am > 0.f ? 127.f / am : 0.f;
#pragma unroll
                for (int j = 0; j < 4; ++j) {
                    const int q0 = (int)rintf(v[j].x * inv), q1 = (int)rintf(v[j].y * inv), q2 = (int)rintf(v[j].z * inv), q3 = (int)rintf(v[j].w * inv);
                    drow[F.lane + 64 * j] = (unsigned)(q0 & 255) | ((unsigned)(q1 & 255) << 8) | ((unsigned)(q2 & 255) << 16) | ((unsigned)(q3 & 255) << 24); }
                if (F.lane == 0) F.SUV[2 * e] = am * (1.f / 127.f);
            }
        }
    }
}

__device__ __forceinline__ void modnorm_row_bf16(const bf16* xrow, const float* w, const float* shift, const float* scale, bf16* orow, int lane) {
    const v4u a = *(const v4u*)(xrow + 16 * lane), bq = *(const v4u*)(xrow + 16 * lane + 8);
    float v[16]; float s = 0.f;
#pragma unroll
    for (int i = 0; i < 4; ++i) { v[2 * i] = bf2f(a[i] & 0xffffu); v[2 * i + 1] = __uint_as_float(a[i] & 0xffff0000u); v[8 + 2 * i] = bf2f(bq[i] & 0xffffu); v[8 + 2 * i + 1] = __uint_as_float(bq[i] & 0xffff0000u); }
#pragma unroll
    for (int i = 0; i < 16; ++i) s += v[i] * v[i];
    const float rstd = 1.f / sqrtf(wave_sum(s) * (1.f / D) + EPS);
    unsigned o[8];
#pragma unroll
    for (int q = 0; q < 4; ++q) { const int col = 16 * lane + 4 * q;
        const f32x4 wv = *(const f32x4*)(w + col), sh = *(const f32x4*)(shift + col), sc = *(const f32x4*)(scale + col);
        const float y0 = v[4 * q] * rstd * wv[0] * (sc[0] + 1.f) + sh[0], y1 = v[4 * q + 1] * rstd * wv[1] * (sc[1] + 1.f) + sh[1];
        const float y2 = v[4 * q + 2] * rstd * wv[2] * (sc[2] + 1.f) + sh[2], y3 = v[4 * q + 3] * rstd * wv[3] * (sc[3] + 1.f) + sh[3];
        o[2 * q] = pk2(y0, y1); o[2 * q + 1] = pk2(y2, y3); }
    *(v4u*)(orow + 16 * lane) = (v4u){o[0], o[1], o[2], o[3]}; *(v4u*)(orow + 16 * lane + 8) = (v4u){o[4], o[5], o[6], o[7]};
}
__device__ __forceinline__ void modnorm_row(const float* xrow, const float* w, const float* shift, const float* scale, bf16* orow, int lane) {
    f32x4 v[4]; float s = 0.f;
#pragma unroll
    for (int j = 0; j < 4; ++j) { v[j] = *(const f32x4*)(xrow + 4 * lane + 256 * j); s += (v[j].x * v[j].x + v[j].y * v[j].y) + (v[j].z * v[j].z + v[j].w * v[j].w); }
    const float rstd = 1.f / sqrtf(wave_sum(s) * (1.f / D) + EPS);
#pragma unroll
    for (int j = 0; j < 4; ++j) { const int col = 4 * lane + 256 * j;
        const f32x4 wv = *(const f32x4*)(w + col), sh = *(const f32x4*)(shift + col), sc = *(const f32x4*)(scale + col);
        const f32x4 y = v[j] * rstd * wv * (sc + 1.f) + sh;
        v2u o; o.x = pk2(y.x, y.y); o.y = pk2(y.z, y.w); *(v2u*)(orow + col) = o; }
}

__device__ __forceinline__ void p3_local(Ctx& F) {
    LAS unsigned char* KT = F.lds;
    LAS unsigned char* VT = F.lds + 18432;
    LAS float* QT = (LAS float*)(F.lds + 36864);
    LAS unsigned char* OUT = F.lds + 38912;
    const int tid = F.tid, lane = F.lane, wave = F.wave, fr = lane & 15, fq = lane >> 4;
    for (int u = F.bid; u < 1024; u += F.G) {
        const int bh = u >> 7, c = u & 127, b = bh >> 2, hh = bh & 3;
        const size_t r0 = (size_t)b * SEQ + (size_t)c * 64;
        const int d = tid & 127, tq = tid >> 7;
        const bf16* pf = F.PROJ + (r0 + 16 * tq) * NIN + 512 + hh * 128 + d;
        const bf16* pv = F.PROJ + (r0 + 16 * tq) * NIN + 1024 + hh * 128 + d;
        const float lbv = F.LB[hh * 128 + d], oml = 1.f - lbv;
        unsigned short fraw[16], vraw[16];
#pragma unroll
        for (int j = 0; j < 16; ++j) { fraw[j] = pf[(size_t)j * NIN]; vraw[j] = pv[(size_t)j * NIN]; }
        float cs[16], kk[16]; float run = 0.f;
#pragma unroll
        for (int j = 0; j < 16; ++j) { const float fv = bf2f(fraw[j]); const float e = __expf(-fv); const float sg = 1.f / (1.f + e);
            const float f = lbv + oml * sg; run += __logf(f); cs[j] = run; kk[j] = oml * (e * sg); }
        QT[tq * 128 + d] = run;
        __syncthreads();
        float prefix = 0.f, total = 0.f;
#pragma unroll
        for (int q = 0; q < 4; ++q) { const float t = QT[q * 128 + d]; total += t; if (q < tq) prefix += t; }
        unsigned kp[8], vp[8];
#pragma unroll
        for (int j = 0; j < 8; ++j) { const float k0 = kk[2 * j] * __expf(total - (prefix + cs[2 * j])), k1 = kk[2 * j + 1] * __expf(total - (prefix + cs[2 * j + 1]));
            kp[j] = pk2(k0, k1); vp[j] = (unsigned)vraw[2 * j] | ((unsigned)vraw[2 * j + 1] << 16); }
        *(LAS v4u*)(KT + d * 144 + tq * 32) = (v4u){kp[0], kp[1], kp[2], kp[3]}; *(LAS v4u*)(KT + d * 144 + tq * 32 + 16) = (v4u){kp[4], kp[5], kp[6], kp[7]};
        *(LAS v4u*)(VT + d * 144 + tq * 32) = (v4u){vp[0], vp[1], vp[2], vp[3]}; *(LAS v4u*)(VT + d * 144 + tq * 32 + 16) = (v4u){vp[4], vp[5], vp[6], vp[7]};
        if (tq == 0) F.ACH[u * 128 + d] = __expf(total);
        __syncthreads();
        {
            const int dblk = wave & 3, vh = wave >> 2;
            f32x4 acc[2][4];
#pragma unroll
            for (int a = 0; a < 2; ++a)
#pragma unroll
                for (int n = 0; n < 4; ++n) acc[a][n] = (f32x4){0.f, 0.f, 0.f, 0.f};
#pragma unroll
            for (int k2 = 0; k2 < 2; ++k2) {
                bf16x8 af[2], bfv[4];
#pragma unroll
                for (int a = 0; a < 2; ++a) af[a] = *(const LAS bf16x8*)(KT + (dblk * 32 + a * 16 + fr) * 144 + (k2 * 32 + fq * 8) * 2);
#pragma unroll
                for (int n = 0; n < 4; ++n) bfv[n] = *(const LAS bf16x8*)(VT + (vh * 64 + n * 16 + fr) * 144 + (k2 * 32 + fq * 8) * 2);
#pragma unroll
                for (int a = 0; a < 2; ++a)
#pragma unroll
                    for (int n = 0; n < 4; ++n) acc[a][n] = __builtin_amdgcn_mfma_f32_16x16x32_bf16(af[a], bfv[n], acc[a][n], 0, 0, 0);
            }
#pragma unroll
            for (int a = 0; a < 2; ++a)
#pragma unroll
                for (int n = 0; n < 4; ++n) { const int v = vh * 64 + n * 16 + fr, dd = dblk * 32 + a * 16 + 4 * fq;
                    *(LAS v2u*)(OUT + v * 272 + dd * 2) = (v2u){pk2(acc[a][n][0], acc[a][n][1]), pk2(acc[a][n][2], acc[a][n][3])}; }
        }
        __syncthreads();
        { const int row = tid >> 2, part = tid & 3; bf16* dst = F.ST + (size_t)u * 16384 + row * 128 + part * 32;
#pragma unroll
            for (int i = 0; i < 4; ++i) *(v4u*)(dst + i * 8) = *(const LAS v4u*)(OUT + row * 272 + part * 64 + i * 16); }
        __syncthreads();
    }
    {
        const int gw = F.bid * NWAVES + F.wave, NGW = F.G * NWAVES;
        const int ch = lane * 8;
        float w0[8], w1[8], w2[8], ow[8];
#pragma unroll
        for (int j = 0; j < 8; ++j) { w0[j] = F.conv_w[ch + j]; w1[j] = F.conv_w[512 + ch + j]; w2[j] = F.conv_w[1024 + ch + j]; ow[j] = F.conv_onorm_w[ch + j]; }
        for (int run = gw; run < M / 8; run += NGW) {
            const int rbase = run * 8;
            float u1[8], u2[8];
#pragma unroll
            for (int j = 0; j < 8; ++j) { u1[j] = 0.f; u2[j] = 0.f; }
            const int tpos = rbase & (SEQ - 1);
            if (tpos >= 1) { const bf16* p = F.PROJ + (size_t)(rbase - 1) * NIN + 2048 + ch; const v4u cc = *(const v4u*)(p + 512), xx = *(const v4u*)(p + 1024);
#pragma unroll
                for (int j = 0; j < 4; ++j) { const unsigned cw = cc[j], xw = xx[j]; u1[2 * j] = bf2f(cw & 0xffffu) * bf2f(xw & 0xffffu); u1[2 * j + 1] = bf2f(cw >> 16) * bf2f(xw >> 16); } }
            if (tpos >= 2) { const bf16* p = F.PROJ + (size_t)(rbase - 2) * NIN + 2048 + ch; const v4u cc = *(const v4u*)(p + 512), xx = *(const v4u*)(p + 1024);
#pragma unroll
                for (int j = 0; j < 4; ++j) { const unsigned cw = cc[j], xw = xx[j]; u2[2 * j] = bf2f(cw & 0xffffu) * bf2f(xw & 0xffffu); u2[2 * j + 1] = bf2f(cw >> 16) * bf2f(xw >> 16); } }
            for (int t = 0; t < 8; ++t) {
                const bf16* p = F.PROJ + (size_t)(rbase + t) * NIN + 2048 + ch;
                const v4u bb = *(const v4u*)(p), cc = *(const v4u*)(p + 512), xx = *(const v4u*)(p + 1024);
                float u0[8], y[8]; float ss = 0.f;
#pragma unroll
                for (int j = 0; j < 4; ++j) { const unsigned cw = cc[j], xw = xx[j]; u0[2 * j] = bf2f(cw & 0xffffu) * bf2f(xw & 0xffffu); u0[2 * j + 1] = bf2f(cw >> 16) * bf2f(xw >> 16); }
#pragma unroll
                for (int j = 0; j < 8; ++j) { const float bg = bf2f((j & 1) ? (bb[j >> 1] >> 16) : (bb[j >> 1] & 0xffffu));
                    y[j] = bg * (w0[j] * u2[j] + w1[j] * u1[j] + w2[j] * u0[j]); ss += y[j] * y[j]; }
                ss += __shfl_xor(ss, 1); ss += __shfl_xor(ss, 2); ss += __shfl_xor(ss, 4); ss += __shfl_xor(ss, 8);
                const float rstd = 1.f / sqrtf(ss * (1.f / 128.f) + EPS);
                v4u o; o.x = pk2(y[0] * rstd * ow[0], y[1] * rstd * ow[1]); o.y = pk2(y[2] * rstd * ow[2], y[3] * rstd * ow[3]);
                o.z = pk2(y[4] * rstd * ow[4], y[5] * rstd * ow[5]); o.w = pk2(y[6] * rstd * ow[6], y[7] * rstd * ow[7]);
                *(v4u*)(F.YCAT + (size_t)(rbase + t) * D + 512 + ch) = o;
#pragma unroll
                for (int j = 0; j < 8; ++j) { u2[j] = u1[j]; u1[j] = u0[j]; }
            }
        }
    }
}

__device__ __forceinline__ void p4_scan(Ctx& F) {
    const int gtid = F.bid * NTHR + F.tid;
    if (gtid >= 65536) return;
    const int bh = gtid >> 13, e2 = gtid & 8191, v = e2 >> 6, d = (e2 & 63) * 2;
    unsigned* p = (unsigned*)(F.ST + (size_t)bh * 128 * 16384 + v * 128 + d);
    const float* a = F.ACH + (size_t)bh * 128 * 128 + d;
    float s0 = 0.f, s1 = 0.f;
#pragma unroll 8
    for (int c = 0; c < 128; ++c) {
        const unsigned uu = p[(size_t)c * 8192]; const float a0 = a[c * 128], a1 = a[c * 128 + 1];
        p[(size_t)c * 8192] = pk2(s0, s1);
        s0 = a0 * s0 + bf2f(uu & 0xffffu); s1 = a1 * s1 + bf2f(uu >> 16);
    }
}

__device__ __forceinline__ void p5_out(Ctx& F) {
    LAS unsigned char* QM = F.lds;
    LAS unsigned char* Q0 = F.lds + 17408;
    LAS unsigned char* KM = F.lds + 34816;
    LAS unsigned char* VT = F.lds + 52224;
    LAS unsigned char* STL = F.lds + 70656;
    LAS float* QT = (LAS float*)(F.lds + 105472);
    LAS unsigned char* PB = F.lds + 107520;
    LAS float* NRM = (LAS float*)(F.lds + 125952);
    const int tid = F.tid, lane = F.lane, wave = F.wave, fr = lane & 15, fq = lane >> 4;
    for (int u = F.bid; u < 1024; u += F.G) {
        const int bh = u >> 7, c = u & 127, b = bh >> 2, hh = bh & 3;
        const size_t r0 = (size_t)b * SEQ + (size_t)c * 64;
        const int d = tid & 127, tq = tid >> 7;
        const bf16* pq = F.PROJ + (r0 + 16 * tq) * NIN + hh * 128 + d;
        const float lbv = F.LB[hh * 128 + d], oml = 1.f - lbv;
        unsigned short qraw[16], fraw[16], vraw[16];
#pragma unroll
        for (int j = 0; j < 16; ++j) { qraw[j] = pq[(size_t)j * NIN]; fraw[j] = pq[(size_t)j * NIN + 512]; vraw[j] = pq[(size_t)j * NIN + 1024]; }
        {
            const bf16* src = F.ST + (size_t)u * 16384;
#pragma unroll
            for (int i = 0; i < 4; ++i) { const int row = (tid >> 4) + 32 * i, ck = tid & 15; *(LAS v4u*)(STL + row * 272 + ck * 16) = *(const v4u*)(src + row * 128 + ck * 8); }
        }
        float cs[16], kk[16]; float run = 0.f;
#pragma unroll
        for (int j = 0; j < 16; ++j) { const float fv = bf2f(fraw[j]); const float e = __expf(-fv); const float sg = 1.f / (1.f + e);
            const float f = lbv + oml * sg; run += __logf(f); cs[j] = run; kk[j] = oml * (e * sg); }
        QT[tq * 128 + d] = run;
        __syncthreads();
        float prefix = 0.f; const float q0t = QT[d], q1t = QT[128 + d], q2t = QT[256 + d];
        if (tq >= 1) prefix += q0t; if (tq >= 2) prefix += q1t; if (tq >= 3) prefix += q2t;
        const float bmid = q0t + q1t;
        unsigned vp[8];
#pragma unroll
        for (int j = 0; j < 16; ++j) { const float bj = prefix + cs[j]; const float qv = bf2f(qraw[j]); const int t = 16 * tq + j;
            *(LAS unsigned short*)(QM + t * 272 + d * 2) = (unsigned short)f2bf(qv * __expf(bj - bmid));
            *(LAS unsigned short*)(Q0 + t * 272 + d * 2) = (unsigned short)f2bf(qv * __expf(bj));
            *(LAS unsigned short*)(KM + t * 272 + d * 2) = (unsigned short)f2bf(kk[j] * __expf(bmid - bj)); }
#pragma unroll
        for (int j = 0; j < 8; ++j) vp[j] = (unsigned)vraw[2 * j] | ((unsigned)vraw[2 * j + 1] << 16);
        *(LAS v4u*)(VT + d * 144 + tq * 32) = (v4u){vp[0], vp[1], vp[2], vp[3]}; *(LAS v4u*)(VT + d * 144 + tq * 32 + 16) = (v4u){vp[4], vp[5], vp[6], vp[7]};
        __syncthreads();
        const int rb = wave >> 1, vh = wave & 1;
        LAS unsigned char* P = PB + wave * 2304;
        {
            f32x4 sc[4];
#pragma unroll
            for (int sf = 0; sf < 4; ++sf) sc[sf] = (f32x4){0.f, 0.f, 0.f, 0.f};
#pragma unroll
            for (int k4 = 0; k4 < 4; ++k4) {
                const bf16x8 bq = *(const LAS bf16x8*)(QM + (16 * rb + fr) * 272 + (k4 * 32 + fq * 8) * 2);
#pragma unroll
                for (int sf = 0; sf < 4; ++sf) { const bf16x8 ak = *(const LAS bf16x8*)(KM + (16 * sf + fr) * 272 + (k4 * 32 + fq * 8) * 2);
                    sc[sf] = __builtin_amdgcn_mfma_f32_16x16x32_bf16(ak, bq, sc[sf], 0, 0, 0); }
            }
            const int t = 16 * rb + fr;
#pragma unroll
            for (int sf = 0; sf < 4; ++sf) { const int s0 = 16 * sf + 4 * fq;
                const float p0 = (s0 + 0 <= t) ? sc[sf][0] : 0.f, p1 = (s0 + 1 <= t) ? sc[sf][1] : 0.f, p2 = (s0 + 2 <= t) ? sc[sf][2] : 0.f, p3 = (s0 + 3 <= t) ? sc[sf][3] : 0.f;
                *(LAS v2u*)(P + fr * 144 + s0 * 2) = (v2u){pk2(p0, p1), pk2(p2, p3)}; }
        }
        __syncthreads();
        f32x4 oc[4];
#pragma unroll
        for (int n = 0; n < 4; ++n) oc[n] = (f32x4){0.f, 0.f, 0.f, 0.f};
#pragma unroll
        for (int k2 = 0; k2 < 2; ++k2) {
            const bf16x8 bp = *(const LAS bf16x8*)(P + fr * 144 + (k2 * 32 + fq * 8) * 2);
#pragma unroll
            for (int n = 0; n < 4; ++n) { const bf16x8 av = *(const LAS bf16x8*)(VT + (64 * vh + 16 * n + fr) * 144 + (k2 * 32 + fq * 8) * 2);
                oc[n] = __builtin_amdgcn_mfma_f32_16x16x32_bf16(av, bp, oc[n], 0, 0, 0); }
        }
#pragma unroll
        for (int k4 = 0; k4 < 4; ++k4) {
            const bf16x8 bq = *(const LAS bf16x8*)(Q0 + (16 * rb + fr) * 272 + (k4 * 32 + fq * 8) * 2);
#pragma unroll
            for (int n = 0; n < 4; ++n) { const bf16x8 as = *(const LAS bf16x8*)(STL + (64 * vh + 16 * n + fr) * 272 + (k4 * 32 + fq * 8) * 2);
                oc[n] = __builtin_amdgcn_mfma_f32_16x16x32_bf16(as, bq, oc[n], 0, 0, 0); }
        }
        float ss = 0.f;
#pragma unroll
        for (int n = 0; n < 4; ++n) ss += (oc[n][0] * oc[n][0] + oc[n][1] * oc[n][1]) + (oc[n][2] * oc[n][2] + oc[n][3] * oc[n][3]);
        ss += __shfl_xor(ss, 16); ss += __shfl_xor(ss, 32);
        if (fq == 0) NRM[(16 * rb + fr) * 2 + vh] = ss;
        __syncthreads();
        {
            const int t = 16 * rb + fr; const float tot = NRM[t * 2] + NRM[t * 2 + 1];
            const float rstd = 1.f / sqrtf(tot * (1.f / 128.f) + EPS);
            const bf16* pg = F.PROJ + (r0 + t) * NIN + 1536 + hh * 128;
            bf16* po = F.YCAT + (r0 + t) * D + hh * 128;
#pragma unroll
            for (int n = 0; n < 4; ++n) { const int v = 64 * vh + 16 * n + 4 * fq;
                const v2u gw = *(const v2u*)(pg + v); const f32x4 wv = *(const f32x4*)(F.hgrn_onorm_w + hh * 128 + v);
                float g[4] = {bf2f(gw.x & 0xffffu), bf2f(gw.x >> 16), bf2f(gw.y & 0xffffu), bf2f(gw.y >> 16)}; float o[4];
#pragma unroll
                for (int j = 0; j < 4; ++j) { const float sl = g[j] / (1.f + __expf(-g[j])); o[j] = oc[n][j] * rstd * wv[j] * sl; }
                *(v2u*)(po + v) = (v2u){pk2(o[0], o[1]), pk2(o[2], o[3])}; }
        }
        __syncthreads();
    }
}

__device__ __forceinline__ unsigned f2ord(float f) { const unsigned u = __float_as_uint(f); return (u & 0x80000000u) ? ~u : (u | 0x80000000u); }
__device__ __forceinline__ float ord2f(unsigned o) { return __uint_as_float((o & 0x80000000u) ? (o & 0x7fffffffu) : ~o); }
__device__ __forceinline__ void ce_desc(unsigned& a, unsigned& b) { const unsigned mx = a > b ? a : b, mn = a > b ? b : a; a = mx; b = mn; }
template <int N> __device__ __forceinline__ void bitonic_sort_desc(unsigned (&k)[N]) {
#pragma unroll
    for (int size = 2; size <= N; size <<= 1) {
#pragma unroll
        for (int stride = size >> 1; stride > 0; stride >>= 1) {
#pragma unroll
            for (int i = 0; i < N; ++i) { const int j = i ^ stride; if (j > i) { if ((i & size) == 0) ce_desc(k[i], k[j]); else ce_desc(k[j], k[i]); } }
        }
    }
}
__device__ __forceinline__ void bitonic_merge16_desc(unsigned (&k)[16]) {
#pragma unroll
    for (int stride = 8; stride > 0; stride >>= 1) {
#pragma unroll
        for (int i = 0; i < 16; ++i) { const int j = i ^ stride; if (j > i) ce_desc(k[i], k[j]); }
    }
}
__device__ __forceinline__ void merge_top16(unsigned (&a)[16], const unsigned (&b)[16]) {
#pragma unroll
    for (int i = 0; i < 16; ++i) a[i] = a[i] > b[15 - i] ? a[i] : b[15 - i];
    bitonic_merge16_desc(a);
}
__device__ __forceinline__ float gelu_as(float v) {
    const float av = fabsf(v), t = __builtin_amdgcn_rcpf(av * 0.2316418882f + 1.0f);
    float q = t * 0.5307027145f + (-0.7265760135f); q = q * t + 0.7107068705f; q = q * t + (-0.142248368f); q = q * t + 0.127414796f; q = q * t;
    const float e = __builtin_amdgcn_exp2f((v * v) * (-0.72134752044f));
    const float m = v * (q * e);
    return v < 0.f ? m : v - m;
}
__device__ __forceinline__ float gelu_erf(float x) { return 0.5f * x * (1.f + erff(x * 0.70710678118654752f)); }

__device__ __forceinline__ int row16_sum_i32(int v) {
    v += __builtin_amdgcn_update_dpp(0, v, 0xB1, 0xf, 0xf, true);
    v += __builtin_amdgcn_update_dpp(0, v, 0x4E, 0xf, 0xf, true);
    v += __builtin_amdgcn_update_dpp(0, v, 0x141, 0xf, 0xf, true);
    v += __builtin_amdgcn_update_dpp(0, v, 0x140, 0xf, 0xf, true);
    return v;
}
__device__ __forceinline__ void p9_peer(Ctx& F) {
    LAS unsigned* TOP = (LAS unsigned*)F.lds;
    LAS v2u* IDXS = (LAS v2u*)(F.lds + 65536);
    LAS v4u* CNT = (LAS v4u*)(F.lds + 132096);
    LAS unsigned char* OFFS = F.lds + 140288;
    LAS float* SH = (LAS float*)(F.lds + 142336);
    LAS unsigned char* HQ = F.lds;
    const int tid = F.tid, lane = F.lane, wave = F.wave, fr = lane & 15, fq = lane >> 4;
    for (int tile = F.bid; tile < M / 64; tile += F.G) {
        const size_t r0 = (size_t)tile * 64;
        {
            const int p = wave >> 2, tb = wave & 3;
            LAS unsigned char* KL = F.lds + 73728;
            v4u kpre[8]; bf16x8 qpre[4];
            const bf16* qbase = F.QP + (r0 + 16 * tb + fr) * NQ + p * 128 + fq * 8;
#pragma unroll
            for (int i = 0; i < 8; ++i) kpre[i] = *(const v4u*)(F.KEYS + (size_t)(tid + 512 * i) * 8);
#pragma unroll
            for (int k4 = 0; k4 < 4; ++k4) qpre[k4] = *(const bf16x8*)(qbase + k4 * 32);
#pragma unroll 1
            for (int h = 0; h < 8; ++h) {
#pragma unroll
                for (int i = 0; i < 8; ++i) { const int c = tid + 512 * i; *(LAS v4u*)(KL + (c >> 4) * 272 + (c & 15) * 16) = kpre[i]; }
                bf16x8 bq[4];
#pragma unroll
                for (int k4 = 0; k4 < 4; ++k4) bq[k4] = qpre[k4];
                __syncthreads();
                if (h < 7) {
#pragma unroll
                    for (int i = 0; i < 8; ++i) kpre[i] = *(const v4u*)(F.KEYS + (size_t)(h + 1) * 32768 + (size_t)(tid + 512 * i) * 8);
#pragma unroll
                    for (int k4 = 0; k4 < 4; ++k4) qpre[k4] = *(const bf16x8*)(qbase + (h + 1) * 256 + k4 * 32);
                }
                f32x4 sc[8];
#pragma unroll
                for (int nf = 0; nf < 8; ++nf) sc[nf] = (f32x4){0.f, 0.f, 0.f, 0.f};
                const LAS unsigned char* krow = KL + (p * 128 + fr) * 272 + fq * 16;
#pragma unroll
                for (int k4 = 0; k4 < 4; ++k4) {
#pragma unroll
                    for (int nf = 0; nf < 8; ++nf) { const bf16x8 ak = *(const LAS bf16x8*)(krow + nf * 16 * 272 + k4 * 64);
                        sc[nf] = __builtin_amdgcn_mfma_f32_16x16x32_bf16(ak, bq[k4], sc[nf], 0, 0, 0); }
                }
                unsigned ka[16], kb[16];
#pragma unroll
                for (int nf = 0; nf < 4; ++nf)
#pragma unroll
                    for (int r = 0; r < 4; ++r) {
                        ka[nf * 4 + r] = (f2ord(sc[nf][r]) & ~127u) | (unsigned)(127 - (16 * nf + 4 * fq + r));
                        kb[nf * 4 + r] = (f2ord(sc[nf + 4][r]) & ~127u) | (unsigned)(127 - (16 * (nf + 4) + 4 * fq + r)); }
                bitonic_sort_desc<16>(ka); bitonic_sort_desc<16>(kb);
                merge_top16(ka, kb);
                {
                    unsigned o[16];
#pragma unroll
                    for (int i = 0; i < 16; ++i) o[i] = (unsigned)__shfl_xor((int)ka[i], 16);
                    merge_top16(ka, o);
#pragma unroll
                    for (int i = 0; i < 16; ++i) o[i] = (unsigned)__shfl_xor((int)ka[i], 32);
                    merge_top16(ka, o);
                }
                if (fq == 0) { LAS v4u* dst = (LAS v4u*)(TOP + (h * 64 + 16 * tb + fr) * 36 + p * 16);
                    dst[0] = (v4u){ka[0], ka[1], ka[2], ka[3]}; dst[1] = (v4u){ka[4], ka[5], ka[6], ka[7]}; dst[2] = (v4u){ka[8], ka[9], ka[10], ka[11]}; dst[3] = (v4u){ka[12], ka[13], ka[14], ka[15]}; }
                __syncthreads();
            }
        }
        __syncthreads();
        {
            const int t = tid & 63, h = tid >> 6;
            const LAS unsigned* pa = TOP + (h * 64 + t) * 36; const LAS unsigned* pb = pa + 16;
            float bv[16];
            { const LAS v4u* qb = (const LAS v4u*)pb;
#pragma unroll
              for (int i = 0; i < 4; ++i) { const v4u y = qb[i];
#pragma unroll
                  for (int j = 0; j < 4; ++j) bv[4 * i + j] = ord2f(y[j] & ~127u); } }
#define CKEY(i, j) ((f2ord(ord2f(pa[i] & ~127u) + bv[j]) & ~255u) | (unsigned)(255 - ((i) * 16 + (j))))
            unsigned c0[16];
#pragma unroll
            for (int j = 0; j < 16; ++j) c0[j] = CKEY(0, j);
            bitonic_sort_desc<16>(c0);
            {
                unsigned cb[16];
#pragma unroll
                for (int j = 0; j < 8; ++j) cb[j] = CKEY(1, j);
#pragma unroll
                for (int j = 0; j < 5; ++j) cb[8 + j] = CKEY(2, j);
#pragma unroll
                for (int j = 0; j < 3; ++j) cb[13 + j] = CKEY(4, j);
                bitonic_sort_desc<16>(cb); merge_top16(c0, cb);
            }
            {
                unsigned cc[16];
#pragma unroll
                for (int j = 0; j < 4; ++j) cc[j] = CKEY(3, j);
#pragma unroll
                for (int j = 0; j < 2; ++j) { cc[4 + j] = CKEY(5, j); cc[6 + j] = CKEY(6, j); cc[8 + j] = CKEY(7, j); }
                cc[10] = CKEY(8, 0); cc[11] = CKEY(9, 0); cc[12] = CKEY(10, 0); cc[13] = CKEY(11, 0); cc[14] = CKEY(12, 0); cc[15] = CKEY(13, 0);
                bitonic_sort_desc<16>(cc); merge_top16(c0, cc);
            }
            { unsigned x = CKEY(14, 0);
#pragma unroll
              for (int k = 0; k < 16; ++k) ce_desc(c0[k], x);
              x = CKEY(15, 0);
#pragma unroll
              for (int k = 0; k < 16; ++k) ce_desc(c0[k], x); }
#undef CKEY
            float sv[16]; unsigned ix[16]; float mx = -3.0e38f;
#pragma unroll
            for (int k = 0; k < 16; ++k) { const unsigned pos = 255u - (c0[k] & 255u); const unsigned ua = pa[pos >> 4], ub = pb[pos & 15];
                sv[k] = ord2f(ua & ~127u) + ord2f(ub & ~127u); ix[k] = (127u - (ua & 127u)) * 128u + (127u - (ub & 127u)); mx = fmaxf(mx, sv[k]); }
            float sum = 0.f;
#pragma unroll
            for (int k = 0; k < 16; ++k) { sv[k] = __expf(sv[k] - mx); sum += sv[k]; }
            const float inv = 1.f / sum;
            unsigned c4[4] = {0u, 0u, 0u, 0u};
#pragma unroll
            for (int k = 0; k < 16; ++k) { const unsigned s = ix[k] >> 11, inc = 1u << ((s & 3u) * 8u);
#pragma unroll
                for (int w = 0; w < 4; ++w) c4[w] += ((s >> 2) == (unsigned)w) ? inc : 0u; }
            CNT[h * 64 + t] = (v4u){c4[0], c4[1], c4[2], c4[3]};
            unsigned e0[16]; float e1[16];
#pragma unroll
            for (int k = 0; k < 16; ++k) { const f32x2 sc2 = *(const f32x2*)(F.SUV + 2 * ix[k]); e0[k] = ix[k] << 10; e1[k] = __uint_as_float((f2bf(sv[k] * inv * sc2.y) << 16) | f2bf(sc2.x)); }
            __syncthreads();
            unsigned A4[4] = {0u, 0u, 0u, 0u}, B4[4] = {0u, 0u, 0u, 0u};
#pragma unroll
            for (int hh = 0; hh < 8; ++hh) { const v4u v = CNT[hh * 64 + t];
#pragma unroll
                for (int w = 0; w < 4; ++w) { A4[w] += v[w]; B4[w] += (hh < h) ? v[w] : 0u; } }
            unsigned off4[4] = {0u, 0u, 0u, 0u}; unsigned run = 0u;
#pragma unroll
            for (int s = 0; s < 16; ++s) { off4[s >> 2] |= run << ((s & 3) * 8); run += (A4[s >> 2] >> ((s & 3) * 8)) & 255u; }
            if (h == 0) { *(LAS v4u*)(OFFS + t * 32) = (v4u){off4[0], off4[1], off4[2], off4[3]}; OFFS[t * 32 + 16] = (unsigned char)128; }
            unsigned base4[4], r4[4] = {0u, 0u, 0u, 0u};
#pragma unroll
            for (int w = 0; w < 4; ++w) base4[w] = off4[w] + B4[w];
#pragma unroll
            for (int k = 0; k < 16; ++k) { const unsigned s = ix[k] >> 11, wsel = s >> 2, sh8 = (s & 3u) * 8u;
                const unsigned bsel = wsel == 0 ? base4[0] : wsel == 1 ? base4[1] : wsel == 2 ? base4[2] : base4[3];
                const unsigned rsel = wsel == 0 ? r4[0] : wsel == 1 ? r4[1] : wsel == 2 ? r4[2] : r4[3];
                const unsigned pos = ((bsel >> sh8) & 255u) + ((rsel >> sh8) & 255u);
                IDXS[t * 129 + pos] = (v2u){e0[k], __float_as_uint(e1[k])};
#pragma unroll
                for (int w = 0; w < 4; ++w) r4[w] += (wsel == (unsigned)w) ? (1u << sh8) : 0u; }
        }
        __syncthreads();
        {
#pragma unroll 2
            for (int tk = 0; tk < 8; ++tk) { const int tl = wave * 8 + tk; const size_t row = r0 + tl;
                const v4u a = *(const v4u*)(F.H2 + row * D + 16 * lane), bq = *(const v4u*)(F.H2 + row * D + 16 * lane + 8);
                float hv[16]; float am = 0.f;
#pragma unroll
                for (int w = 0; w < 4; ++w) { hv[2 * w] = bf2f(a[w] & 0xffffu); hv[2 * w + 1] = __uint_as_float(a[w] & 0xffff0000u); hv[8 + 2 * w] = bf2f(bq[w] & 0xffffu); hv[8 + 2 * w + 1] = __uint_as_float(bq[w] & 0xffff0000u); }
#pragma unroll
                for (int i = 0; i < 16; ++i) am = fmaxf(am, fabsf(hv[i]));
#pragma unroll
                for (int o = 1; o < 64; o <<= 1) am = fmaxf(am, __shfl_xor(am, o));
                const float inv = am > 0.f ? 127.f / am : 0.f; unsigned hq[4];
#pragma unroll
                for (int i = 0; i < 4; ++i) { const int q0 = (int)rintf(hv[4 * i] * inv), q1 = (int)rintf(hv[4 * i + 1] * inv), q2 = (int)rintf(hv[4 * i + 2] * inv), q3 = (int)rintf(hv[4 * i + 3] * inv);
                    hq[i] = (unsigned)(q0 & 255) | ((unsigned)(q1 & 255) << 8) | ((unsigned)(q2 & 255) << 16) | ((unsigned)(q3 & 255) << 24); }
                *(LAS v4u*)(HQ + tl * 1024 + 16 * lane) = (v4u){hq[0], hq[1], hq[2], hq[3]};
                if (lane == 0) SH[tl] = am * (1.f / 127.f); }
        }
        __syncthreads();
        {
            const int c16 = lane & 15, rp = lane >> 4;
            f32x2 acc[8][8];
#pragma unroll
            for (int tk = 0; tk < 8; ++tk) {
#pragma unroll
                for (int i = 0; i < 8; ++i) acc[tk][i] = (f32x2){0.f, 0.f}; }
#pragma unroll 1
            for (int s = 0; s < 16; ++s) {
#pragma unroll
                for (int tk = 0; tk < 8; ++tk) {
                    const int tl = wave * 8 + tk;
                    const int n0 = OFFS[tl * 32 + s], n1 = OFFS[tl * 32 + s + 1];
                    if (n0 >= n1) continue;
                    const float sh = SH[tl];
                    const LAS v2u* ent = IDXS + tl * 129;
                    v4u hq[4];
#pragma unroll
                    for (int S = 0; S < 4; ++S) hq[S] = *(const LAS v4u*)(HQ + tl * 1024 + c16 * 16 + S * 256);
                    const unsigned uoff = (unsigned)c16 * 16u, voff = (unsigned)lane * 16u;
#pragma unroll 1
                    for (int i = n0; i < n1; i += 4) {
                        const int last = n1 - 1;
                        const int iu = (i + rp) < last ? (i + rp) : last;
                        const v2u eu = ent[iu];
                        v4u uu[4], vv[4]; float gsv[4];
#pragma unroll
                        for (int S = 0; S < 4; ++S) uu[S] = *(const v4u*)(F.U8 + (eu.x + uoff + (unsigned)S * 256u));
#pragma unroll
                        for (int j = 0; j < 4; ++j) { const int ij = (i + j) < last ? (i + j) : last; const v2u ev = ent[ij];
                            vv[j] = *(const v4u*)(F.V8 + (ev.x + voff)); gsv[j] = (i + j) <= last ? __uint_as_float(ev.y & 0xffff0000u) : 0.f; }
                        int dt = 0;
#pragma unroll
                        for (int S = 0; S < 4; ++S)
#pragma unroll
                            for (int w = 0; w < 4; ++w) dt = __builtin_amdgcn_sdot4((int)uu[S][w], (int)hq[S][w], dt, false);
                        dt = row16_sum_i32(dt);
                        const float gl = gelu_as((float)dt * (__uint_as_float(eu.y << 16) * sh));
#pragma unroll
                        for (int j = 0; j < 4; ++j) {
                            const float cj = __uint_as_float(__builtin_amdgcn_readlane(__float_as_uint(gl), 16 * j)) * gsv[j];
                            const f32x2 c2 = {cj, cj};
#pragma unroll
                            for (int w = 0; w < 4; ++w) { const int x = (int)vv[j][w];
                                acc[tk][2 * w] += c2 * __builtin_amdgcn_cvt_pk_f32_fp8(x, false);
                                acc[tk][2 * w + 1] += c2 * __builtin_amdgcn_cvt_pk_f32_fp8(x, true); }
                        }
                    }
                }
            }
#pragma unroll
            for (int tk = 0; tk < 8; ++tk) {
                const int tl = wave * 8 + tk; const size_t row = r0 + tl; const int b = (int)(row >> 13);
                float x2[16]; float ss = 0.f; const int d0i = 16 * lane;
                const v4u xb0 = *(const v4u*)(F.X1B + row * D + d0i), xb1 = *(const v4u*)(F.X1B + row * D + d0i + 8);
#pragma unroll
                for (int q = 0; q < 4; ++q) { const unsigned w0 = q < 2 ? xb0[2 * q] : xb1[2 * q - 4], w1 = q < 2 ? xb0[2 * q + 1] : xb1[2 * q - 3];
                    const f32x4 xa = {bf2f(w0 & 0xffffu), __uint_as_float(w0 & 0xffff0000u), bf2f(w1 & 0xffffu), __uint_as_float(w1 & 0xffff0000u)}, ga = *(const f32x4*)(F.MOD + b * 6144 + 5120 + d0i + 4 * q);
#pragma unroll
                    for (int j = 0; j < 4; ++j) { const float a = acc[tk][2 * q + (j >> 1)][j & 1]; const float pv = a; x2[4 * q + j] = xa[j] + ga[j] * pv; ss += x2[4 * q + j] * x2[4 * q + j]; } }
                const float rstd = 1.f / sqrtf(wave_sum(ss) * (1.f / D) + EPS);
#pragma unroll
                for (int q = 0; q < 4; ++q) { const f32x4 wa = *(const f32x4*)(F.final_w + d0i + 4 * q); f32x4 oa;
#pragma unroll
                    for (int j = 0; j < 4; ++j) oa[j] = x2[4 * q + j] * rstd * wa[j];
                    *(f32x4*)(F.out + row * D + d0i + 4 * q) = oa; }
            }
        }
        __syncthreads();
    }
}

#define XB_TMO      128
#define XB_XCNT(j)  (256  + 64 * (j))
#define XB_XSUB(j)  (1280 + 64 * (j))
#define XB_XGEN(j)  (2304 + 64 * (j))
#define XB_TOP      3328
#define XB_TOPGEN   3392
#define XCD_BAR_WORDS 3456
#define XB_SPIN_CAP (1u << 20)
__device__ __forceinline__ unsigned xb_ld(unsigned* p)              { return __hip_atomic_load(p, __ATOMIC_RELAXED, __HIP_MEMORY_SCOPE_AGENT); }
__device__ __forceinline__ unsigned xb_add(unsigned* p, unsigned v) { return __hip_atomic_fetch_add(p, v, __ATOMIC_RELAXED, __HIP_MEMORY_SCOPE_AGENT); }
__device__ __forceinline__ unsigned xb_xcc_id() { return (unsigned)__builtin_amdgcn_s_getreg((3 << 11) | 20) & 0xFu; }
#define XB_SPIN(cond, bar) do { unsigned _sp = 0; while (cond) { __builtin_amdgcn_s_sleep(1); \
    if ((++_sp & 255u) == 0u) { if (xb_ld(&(bar)[XB_TMO])) break; if (_sp > XB_SPIN_CAP) { atomicAdd(&(bar)[XB_TMO], 1u); break; } } } } while (0)
struct XcdBarrier { unsigned* bar; unsigned x; volatile LAS unsigned* st; };
__device__ __forceinline__ XcdBarrier xcd_barrier_post(unsigned* bar, volatile LAS unsigned* st) {
    XcdBarrier b; b.bar = bar; b.x = xb_xcc_id(); b.st = st;
    if (threadIdx.x == 0) (void)xb_add(&bar[XB_XCNT(b.x)], 1u);
    return b;
}
__device__ __forceinline__ void xcd_barrier_complete(unsigned* bar, unsigned x, unsigned& nloc, unsigned& nx) {
    const unsigned G = gridDim.x * gridDim.y * gridDim.z;
    unsigned sum, cnt, mine, sp = 0u;
    for (;;) {
        sum = 0u; cnt = 0u; mine = 0u;
#pragma unroll
        for (unsigned j = 0; j < 16; ++j) { const unsigned c = xb_ld(&bar[XB_XCNT(j)]); sum += c; cnt += (c > 0u) ? 1u : 0u; mine = (j == x) ? c : mine; }
        if (sum == G) break;
        __builtin_amdgcn_s_sleep(1);
        if ((++sp & 255u) == 0u) { if (xb_ld(&bar[XB_TMO])) break; if (sp > XB_SPIN_CAP) { atomicAdd(&bar[XB_TMO], 1u); break; } }
    }
    nloc = mine > 0u ? mine : 1u; nx = cnt > 0u ? cnt : 1u;
}
__device__ __forceinline__ void xcd_barrier(const XcdBarrier& b) {
    asm volatile("s_waitcnt vmcnt(0)" ::: "memory");
    __syncthreads();
    if (threadIdx.x == 0) {
        unsigned* bar = b.bar;
        __builtin_amdgcn_s_waitcnt(0);
        unsigned nloc = b.st[0], nx = b.st[1];
        if (nloc == 0u) { xcd_barrier_complete(bar, b.x, nloc, nx); b.st[0] = nloc; b.st[1] = nx; }
        const unsigned old = xb_add(&bar[XB_XSUB(b.x)], 1u);
        const unsigned gen = old / nloc;
        if (old + 1u == (gen + 1u) * nloc) {
            __builtin_amdgcn_fence(__ATOMIC_RELEASE, "agent");
            asm volatile("s_waitcnt vmcnt(0)" ::: "memory");
            const unsigned og = xb_add(&bar[XB_TOP], 1u);
            const unsigned tg = og / nx;
            if (og + 1u == (tg + 1u) * nx) xb_add(&bar[XB_TOPGEN], 1u);
            else XB_SPIN(xb_ld(&bar[XB_TOPGEN]) == tg, bar);
            __builtin_amdgcn_fence(__ATOMIC_ACQUIRE, "agent");
            xb_add(&bar[XB_XGEN(b.x)], 1u);
            asm volatile("s_waitcnt vmcnt(0)" ::: "memory");
        } else {
            XB_SPIN(xb_ld(&bar[XB_XGEN(b.x)]) == gen, bar);
            __builtin_amdgcn_fence(__ATOMIC_ACQUIRE, "agent");
            asm volatile("s_waitcnt vmcnt(0)" ::: "memory");
        }
    }
    __syncthreads();
}

__global__ void __launch_bounds__(NTHR, 2) mk_fwd(Args args) {
    extern __shared__ __attribute__((aligned(16))) unsigned char lds_raw[];
    Ctx F;
    F.lds = (LAS unsigned char*)lds_raw;
    F.tid = threadIdx.x; F.lane = F.tid & 63; F.wave = __builtin_amdgcn_readfirstlane(F.tid >> 6); F.G = gridDim.x; F.bid = blockIdx.x;
    F.x = args.in[0]; F.c = args.in[1]; F.w_ada = args.in[2]; F.b_ada = args.in[3]; F.norm1_w = args.in[4]; F.w_in = args.in[5]; F.lb_logits = args.in[6];
    F.hgrn_onorm_w = args.in[7]; F.conv_w = args.in[8]; F.conv_onorm_w = args.in[9]; F.w_out = args.in[10]; F.norm2_w = args.in[11]; F.w_query = args.in[12];
    F.sub_keys = args.in[13]; F.peer_u = args.in[14]; F.peer_v = args.in[15]; F.final_w = args.in[16];
    F.out = args.out;
    unsigned char* ws = args.ws;
    F.ACH = (float*)(ws + WS_ACH); F.MOD = (float*)(ws + WS_MOD); F.LB = (float*)(ws + WS_LB);
    F.WIN = (bf16*)(ws + WS_WIN); F.WOUT = (bf16*)(ws + WS_WOUT); F.WQ = (bf16*)(ws + WS_WQ); F.KEYS = (bf16*)(ws + WS_KEYS);
    F.U8 = ws + WS_U8; F.V8 = ws + WS_V8; F.SUV = (float*)(ws + WS_SUV); F.H1 = (bf16*)(ws + WS_H1); F.YCAT = (bf16*)(ws + WS_H1);
    F.PROJ = (bf16*)(ws + WS_PROJ); F.H2 = (bf16*)(ws + WS_PROJ); F.QP = (bf16*)(ws + WS_PROJ + 32 * MiB); F.ST = (bf16*)(ws + WS_ST); F.X1B = (bf16*)(ws + WS_ST);
    const int lo = args.ph_lo, hi = args.ph_hi;
    volatile LAS unsigned* MISC = (volatile LAS unsigned*)(F.lds + MISC_OFF);
    if (F.tid < 16) MISC[F.tid] = 0u;
    __syncthreads();
    XcdBarrier bar = xcd_barrier_post((unsigned*)(ws + WS_CTL), MISC);
#define IN(k) (lo <= (k) && (k) < hi)
#define SEAM(k) do { if (IN(k) && IN((k) + 1)) { xcd_barrier(bar); } } while (0)
    if (IN(0)) { for (int rep = 0; rep < NREP(0); ++rep) p0_prep(F); } SEAM(0);
    if (IN(1)) for (int rep = 0; rep < NREP(1); ++rep) { if (rep == 0) p0_prep2(F); const int gw = F.bid * NWAVES + F.wave, NGW = F.G * NWAVES;
        for (int m = gw; m < M; m += NGW) { const float* md = F.MOD + (m >> 13) * 6144; modnorm_row(F.x + (size_t)m * D, F.norm1_w, md, md + 1024, F.H1 + (size_t)m * D, F.lane); } } SEAM(1);
    if (IN(2)) for (int rep = 0; rep < NREP(2); ++rep) { pg8::Gemm g{F.H1, F.WIN, M, NIN, D}; pg8::StaticOrder S; S.init(M, NIN, F.G, F.bid); pg8::EpiBf16 E{F.PROJ, NIN}; pg8::gemm_phase<pg8::EpiBf16>(F.lds, g, S, E);
        if (rep == 0) { if (F.G == 256) { if (F.bid >= 128) convert_experts(F, F.bid - 128, 128); } else convert_experts(F, F.bid, F.G); } } SEAM(2);
    if (IN(3)) { for (int rep = 0; rep < NREP(3); ++rep) p3_local(F); } SEAM(3);
    if (IN(4)) { p4_scan(F); } SEAM(4);
    if (IN(5)) { for (int rep = 0; rep < NREP(5); ++rep) p5_out(F); } SEAM(5);
    if (IN(6)) for (int rep = 0; rep < NREP(6); ++rep) { pg8::Gemm g{F.YCAT, F.WOUT, M, D, D}; pg8::StaticOrder S; S.init(M, D, F.G, F.bid); pg8::EpiRes E{F.x, F.X1B, F.MOD}; pg8::gemm_phase<pg8::EpiRes>(F.lds, g, S, E); } SEAM(6);
    if (IN(7)) for (int rep = 0; rep < NREP(7); ++rep) { const int gw = F.bid * NWAVES + F.wave, NGW = F.G * NWAVES;
        for (int m = gw; m < M; m += NGW) { const float* md = F.MOD + (m >> 13) * 6144; modnorm_row_bf16(F.X1B + (size_t)m * D, F.norm2_w, md + 3072, md + 4096, F.H2 + (size_t)m * D, F.lane); } } SEAM(7);
    if (IN(8)) for (int rep = 0; rep < NREP(8); ++rep) { pg8::Gemm g{F.H2, F.WQ, M, NQ, D}; pg8::StaticOrder S; S.init(M, NQ, F.G, F.bid); pg8::EpiBf16 E{F.QP, NQ}; pg8::gemm_phase<pg8::EpiBf16>(F.lds, g, S, E); } SEAM(8);
#ifndef DBG_STOP
    if (IN(9)) { p9_peer(F); }
#else
    xcd_barrier(bar);
    {
        const size_t gt = (size_t)F.bid * NTHR + F.tid, gs = (size_t)F.G * NTHR;
        for (size_t i = gt; i < (size_t)M * D; i += gs) { const size_t r = i >> 10, c = i & 1023; float v = 0.f;
            if (DBG_STOP == 2) { const bf16* p = F.PROJ + r * NIN + c; v = bf2f(p[0]) + bf2f(p[1024]) + bf2f(p[2048]) + (c < 512 ? bf2f(p[3072]) : 0.f); }
            else if (DBG_STOP == 5) { v = bf2f(F.YCAT[r * D + c]); }
            else if (DBG_STOP == 6) { v = F.out[i]; }
            else if (DBG_STOP == 8) { v = bf2f(F.QP[r * NQ + c]) + bf2f(F.QP[r * NQ + c + 1024]); }
            else if (DBG_STOP == 4 || DBG_STOP == 3) { v = bf2f(F.ST[i]); }
            else if (DBG_STOP == 1) { v = bf2f(F.H1[i]); }
            F.out[i] = v; }
    }
#endif
#undef IN
#undef SEAM
}

extern "C" void kernel_launch(void* const* d_in, const int* in_sizes, int n_in, void* d_out, int out_size, void* d_ws, size_t ws_size, hipStream_t stream) {
    static int grid = 0;
    if (grid == 0) {
        if (n_in != 17 || out_size != M * D || ws_size < WS_END) { fprintf(stderr, "kernel_launch: unexpected shapes (n_in %d out %d ws %zu)\n", n_in, out_size, ws_size); grid = -1; return; }
        int dev = 0, cus = 0, per_cu = 0;
        (void)hipGetDevice(&dev); (void)hipDeviceGetAttribute(&cus, hipDeviceAttributeMultiprocessorCount, dev);
        if (hipFuncSetAttribute((const void*)mk_fwd, hipFuncAttributeMaxDynamicSharedMemorySize, LDS_BYTES) != hipSuccess) { fprintf(stderr, "kernel_launch: hipFuncSetAttribute failed\n"); grid = -1; return; }
        if (hipOccupancyMaxActiveBlocksPerMultiprocessor(&per_cu, (const void*)mk_fwd, NTHR, LDS_BYTES) != hipSuccess || per_cu < 1) { fprintf(stderr, "kernel_launch: occupancy query gives %d\n", per_cu); per_cu = 1; }
        (void)hipGetLastError();
        grid = cus;
    }
    if (grid < 0) return;
    if (hipMemsetAsync((char*)d_ws + WS_CTL, 0, CTL_ZERO_BYTES, stream) != hipSuccess) { fprintf(stderr, "kernel_launch: memset failed\n"); return; }
    Args a{};
    for (int i = 0; i < 17; ++i) a.in[i] = (const float*)d_in[i];
    a.out = (float*)d_out; a.ws = (unsigned char*)d_ws;
#if MK_LAUNCHES == 1
#ifdef DBG_STOP
    a.ph_lo = 0; a.ph_hi = DBG_STOP + 1;
#else
    a.ph_lo = 0; a.ph_hi = 10;
#endif
    void* kargs[] = {&a};
    hipError_t e = hipLaunchCooperativeKernel((const void*)mk_fwd, dim3(grid), dim3(NTHR), kargs, LDS_BYTES, stream);
    if (e != hipSuccess) fprintf(stderr, "kernel_launch: cooperative launch failed: %s (grid %d)\n", hipGetErrorString(e), grid);
#else
    for (int ph = 0; ph < 10; ++ph) { a.ph_lo = ph; a.ph_hi = ph + 1; hipLaunchKernelGGL(mk_fwd, dim3(grid), dim3(NTHR), LDS_BYTES, stream, a); }
#endif
}
```

```cpp
#include <hip/hip_runtime.h>
#include <hip/hip_cooperative_groups.h>
#include <cstdio>
#include <cstdint>
namespace cg = cooperative_groups;

#ifndef REP_MASK
#define REP_MASK 0
#endif
#define NREP(k) (((REP_MASK) >> (k)) & 1 ? 2 : 1)
#ifndef MK_LAUNCHES
#define MK_LAUNCHES 1
#endif

#define LAS __attribute__((address_space(3)))
typedef unsigned short bf16;
typedef unsigned v4u __attribute__((ext_vector_type(4)));
typedef unsigned v2u __attribute__((ext_vector_type(2)));
typedef float f32x4 __attribute__((ext_vector_type(4)));
typedef short bf16x8 __attribute__((ext_vector_type(8)));
typedef __bf16 bf16x2 __attribute__((ext_vector_type(2)));

constexpr int D = 1024, SEQ = 8192, M = 16384;
constexpr int NIN = 3584, NQ = 2048;
constexpr float EPS = 1e-6f;
constexpr int NWAVES = 8, NTHR = 512;

constexpr size_t MiB = 1u << 20;
constexpr size_t WS_ACH = 1 * MiB;
constexpr size_t WS_MOD = 1 * MiB + 512 * 1024;
constexpr size_t WS_LB = WS_MOD + 64 * 1024;
constexpr size_t WS_WIN = 2 * MiB;
constexpr size_t WS_WOUT = 9 * MiB;
constexpr size_t WS_WQ = 11 * MiB;
constexpr size_t WS_KEYS = 15 * MiB;
constexpr size_t WS_U8 = 16 * MiB, WS_V8 = 32 * MiB;
constexpr size_t WS_SUV = WS_MOD + 128 * 1024;
constexpr size_t WS_H1 = 80 * MiB;
constexpr size_t WS_PROJ = 112 * MiB;
constexpr size_t WS_ST = 224 * MiB;
constexpr size_t WS_END = 256 * MiB;
constexpr int LDS_BYTES = 147456, MISC_OFF = 147456 - 256;
constexpr size_t WS_CTL = 0, CTL_ZERO_BYTES = 65536;

__device__ __forceinline__ float bf2f(unsigned h) { return __uint_as_float(h << 16); }
__device__ __forceinline__ unsigned f2bf(float f) { unsigned u = __float_as_uint(f); return (u + 0x7fffu + ((u >> 16) & 1u)) >> 16; }
typedef float f32x2 __attribute__((ext_vector_type(2)));
__device__ __forceinline__ unsigned pk2(float lo, float hi) { const f32x2 v = {lo, hi}; return __builtin_bit_cast(unsigned, __builtin_convertvector(v, bf16x2)); }
__device__ __forceinline__ float dot2(unsigned w, unsigned x, float acc) { return __builtin_amdgcn_fdot2_f32_bf16(__builtin_bit_cast(bf16x2, w), __builtin_bit_cast(bf16x2, x), acc, false); }
__device__ __forceinline__ float wave_sum(float v) {
#pragma unroll
    for (int o = 1; o < 64; o <<= 1) v += __shfl_xor(v, o);
    return v;
}

namespace pg8 {
constexpr int BM = 256, BK = 64, HALF = 128, HTB = HALF * BK * 2, STAGE_BYTES = 8 * HTB, NXCD = 8, WGM = 8;
__host__ __device__ __forceinline__ int lds_byte(int r, int c) { const int st = (r >> 4) * 2 + (c >> 5), rr = r & 15, cc = c & 31, ob = rr * 64 + cc * 2; return st * 1024 + (ob ^ (((ob >> 9) & 1) << 5)); }
__host__ __device__ __forceinline__ void stage_rc(int b, int& R, int& C) { const int st = b / 1024, sb = b % 1024, swz = sb ^ (((sb >> 9) & 1) << 5); R = (st >> 1) * 16 + swz / 64; C = (st & 1) * 32 + (swz % 64) / 2; }
__host__ __device__ __forceinline__ int perm32(int rho) { const int n = rho >> 4, i = rho & 15; return 8 * (i >> 2) + 4 * n + (i & 3); }
struct Unit { int pm, pn; };
struct Gemm { const bf16* A; const bf16* Bt; int M, N, K; };
struct StaticOrder {
    int nM, nN, nwg, G, c;
    __host__ __device__ void init(int M_, int N_, int G_, int c_) { nM = M_ / BM; nN = N_ / BM; nwg = nM * nN; G = G_; c = c_; }
    __host__ __device__ bool next(int i, Unit& u) const {
        const long L = (long)i * G + c; if (L >= nwg) return false;
        int wgid = (int)L; { const int q = nwg / NXCD, r = nwg % NXCD, xcd = wgid % NXCD, off = wgid / NXCD; wgid = (xcd < r ? xcd * (q + 1) : r * (q + 1) + (xcd - r) * q) + off; }
        const int nig = WGM * nN, gid = wgid / nig, fm = gid * WGM, gsz = (nM - fm) < WGM ? (nM - fm) : WGM;
        u.pm = fm + ((wgid % nig) % gsz); u.pn = (wgid % nig) / gsz; return true;
    }
};
struct EpiBf16 {
    static constexpr bool PERM = true;
    bf16* O; int ldc;
    __device__ __forceinline__ void operator()(const f32x4 (&acc)[2][2][4][2], const Unit& u, int wr, int wc, int fr, int fq) const {
        const int row0 = u.pm * BM + wr * 64 + fr; const int col0 = u.pn * BM + wc * 32 + 8 * fq;
#pragma unroll
        for (int ai = 0; ai < 2; ++ai)
#pragma unroll
            for (int m = 0; m < 4; ++m) { bf16* rowp = O + (size_t)(row0 + ai * HALF + m * 16) * ldc + col0;
#pragma unroll
                for (int bj = 0; bj < 2; ++bj) { const f32x4 v0 = acc[ai][bj][m][0], v1 = acc[ai][bj][m][1];
                    v4u w; w.x = pk2(v0[0], v0[1]); w.y = pk2(v0[2], v0[3]); w.z = pk2(v1[0], v1[1]); w.w = pk2(v1[2], v1[3]);
                    *(v4u*)(rowp + bj * HALF) = w; } }
    }
};
struct EpiRes {
    static constexpr bool PERM = true;
    const float* x; bf16* out; const float* mod;
    __device__ __forceinline__ void operator()(const f32x4 (&acc)[2][2][4][2], const Unit& u, int wr, int wc, int fr, int fq) const {
        const int row0 = u.pm * BM + wr * 64 + fr, col0 = u.pn * BM + wc * 32 + 8 * fq; const int b = u.pm >> 5;
        f32x4 gv[2][2];
#pragma unroll
        for (int bj = 0; bj < 2; ++bj)
#pragma unroll
            for (int n = 0; n < 2; ++n) gv[bj][n] = *(const f32x4*)(mod + b * 6144 + 2048 + col0 + bj * HALF + 4 * n);
#pragma unroll
        for (int ai = 0; ai < 2; ++ai)
#pragma unroll
            for (int m = 0; m < 4; ++m) { const size_t off = (size_t)(row0 + ai * HALF + m * 16) * D + col0;
#pragma unroll
                for (int bj = 0; bj < 2; ++bj) { const f32x4 x0 = *(const f32x4*)(x + off + bj * HALF), x1 = *(const f32x4*)(x + off + bj * HALF + 4);
                    const f32x4 v0 = x0 + gv[bj][0] * acc[ai][bj][m][0], v1 = x1 + gv[bj][1] * acc[ai][bj][m][1];
                    v4u w; w.x = pk2(v0[0], v0[1]); w.y = pk2(v0[2], v0[3]); w.z = pk2(v1[0], v1[1]); w.w = pk2(v1[2], v1[3]);
                    *(v4u*)(out + off + bj * HALF) = w; } }
    }
};

template <class Epi, bool ALIGN_EPI = true>
__device__ __forceinline__ void gemm_phase(LAS unsigned char* lds, const Gemm g, const StaticOrder& S, const Epi& E) {
    const int tid = threadIdx.x, wid = __builtin_amdgcn_readfirstlane(tid >> 6), lane = tid & 63, wr = wid >> 2, wc = wid & 3, fr = lane & 15, fq = lane >> 4;
    const int K = g.K, nt = K / BK;
    unsigned voffA[2], voffB[2];
#pragma unroll
    for (int i = 0; i < 2; ++i) { int R, C; stage_rc(tid * 16 + i * 8192, R, C); const int Rb = Epi::PERM ? ((R & ~31) + perm32(R & 31)) : R;
        voffA[i] = (unsigned)(R * K + C) * 2u; voffB[i] = (unsigned)(Rb * K + C) * 2u; }
    const size_t kstep = (size_t)(BK * 2);
    const size_t hstep = (size_t)HALF * K * 2;
    const size_t tstep = 2 * hstep;
    const unsigned ldsw = (unsigned)wid * 1024u;
    const int aoff = lds_byte(wr * 64 + fr, fq * 8), boff = lds_byte(wc * 32 + fr, fq * 8);
#define PG8_SA(b, h) (((b) * 2 + (h)) * HTB)
#define PG8_SB(b, h) ((4 + (b) * 2 + (h)) * HTB)
#define PG8_STAGE(bufoff, gbase, voff) do { _Pragma("unroll") for (int _i = 0; _i < 2; ++_i) \
        __builtin_amdgcn_global_load_lds((const unsigned*)((const char*)(gbase) + (voff)[_i]), (LAS unsigned*)(lds + (bufoff) + ldsw + _i * 8192), 16, 0, 0); } while (0)
#define PG8_LDA(dst, b, h) do { _Pragma("unroll") for (int m = 0; m < 4; ++m) _Pragma("unroll") for (int k = 0; k < 2; ++k) dst[m][k] = *(const LAS bf16x8*)(lds + PG8_SA(b, h) + aoff + m * 2048 + k * 1024); } while (0)
#define PG8_LDB(dst, b, h) do { _Pragma("unroll") for (int n = 0; n < 2; ++n) _Pragma("unroll") for (int k = 0; k < 2; ++k) dst[n][k] = *(const LAS bf16x8*)(lds + PG8_SB(b, h) + boff + n * 2048 + k * 1024); } while (0)
#define PG8_MMA(ai, bj, At, Bt) do { __builtin_amdgcn_s_setprio(1); _Pragma("unroll") for (int m = 0; m < 4; ++m) _Pragma("unroll") for (int n = 0; n < 2; ++n) _Pragma("unroll") for (int k = 0; k < 2; ++k) \
        acc[ai][bj][m][n] = __builtin_amdgcn_mfma_f32_16x16x32_bf16(Bt[n][k], At[m][k], acc[ai][bj][m][n], 0, 0, 0); __builtin_amdgcn_s_setprio(0); } while (0)
#define PG8_WAIT_V(n) asm volatile("s_waitcnt vmcnt(" #n ")" ::: "memory")
#define PG8_WAIT_L(n) asm volatile("s_waitcnt lgkmcnt(" #n ")" ::: "memory")
#define PG8_BAR __builtin_amdgcn_s_barrier()
#define PG8_SCHED __builtin_amdgcn_sched_barrier(0)
    Unit cur, nxt; int ui = 0;
    if (!S.next(0, cur)) return;
    f32x4 acc[2][2][4][2];
#pragma unroll
    for (int a = 0; a < 2; ++a)
#pragma unroll
        for (int b = 0; b < 2; ++b)
#pragma unroll
            for (int m = 0; m < 4; ++m)
#pragma unroll
                for (int n = 0; n < 2; ++n) acc[a][b][m][n] = (f32x4){0.f, 0.f, 0.f, 0.f};
    bf16x8 At[4][2], B0[2][2], B1[2][2];
    const char* cA = (const char*)g.A + (size_t)cur.pm * tstep; const char* cB = (const char*)g.Bt + (size_t)cur.pn * tstep;
    PG8_STAGE(PG8_SB(0, 0), cB, voffB); PG8_STAGE(PG8_SB(0, 1), cB + hstep, voffB); PG8_STAGE(PG8_SA(0, 0), cA, voffA); PG8_STAGE(PG8_SA(0, 1), cA + hstep, voffA);
    if (wr == 1) PG8_BAR;
    PG8_WAIT_V(2); PG8_BAR;
    PG8_STAGE(PG8_SB(1, 0), cB + kstep, voffB); PG8_STAGE(PG8_SA(1, 0), cA + kstep, voffA); PG8_STAGE(PG8_SB(1, 1), cB + hstep + kstep, voffB);
    PG8_WAIT_V(6); PG8_BAR;
    for (;;) {
        const bool has_next = S.next(ui + 1, nxt);
        const char* nA = has_next ? (const char*)g.A + (size_t)nxt.pm * tstep : cA; const char* nB = has_next ? (const char*)g.Bt + (size_t)nxt.pn * tstep : cB;
        for (int t = 0; t < nt; t += 2) {
            const bool last = (t == nt - 2);
            const char* a1 = cA + (size_t)(t + 1) * kstep;
            const char* a2 = last ? nA : cA + (size_t)(t + 2) * kstep; const char* b2 = last ? nB : cB + (size_t)(t + 2) * kstep;
            const char* a3 = a2 + kstep; const char* b3 = b2 + kstep;
            PG8_LDB(B0, 0, 0); PG8_LDB(B1, 0, 1); PG8_SCHED; PG8_LDA(At, 0, 0); PG8_STAGE(PG8_SA(1, 1), a1 + hstep, voffA);
            PG8_WAIT_V(8); PG8_WAIT_L(0); PG8_BAR; PG8_MMA(0, 0, At, B0); PG8_MMA(0, 1, At, B1); PG8_BAR; PG8_SCHED;
            PG8_LDA(At, 0, 1); PG8_STAGE(PG8_SB(0, 0), b2, voffB); PG8_STAGE(PG8_SB(0, 1), b2 + hstep, voffB); PG8_STAGE(PG8_SA(0, 0), a2, voffA);
            PG8_WAIT_V(8); PG8_WAIT_L(0); PG8_BAR; PG8_MMA(1, 0, At, B0); PG8_MMA(1, 1, At, B1); PG8_BAR; PG8_SCHED;
            PG8_LDB(B0, 1, 0); PG8_LDB(B1, 1, 1); PG8_SCHED; PG8_LDA(At, 1, 0); PG8_STAGE(PG8_SA(0, 1), a2 + hstep, voffA);
            PG8_WAIT_V(8); PG8_WAIT_L(0); PG8_BAR; PG8_MMA(0, 0, At, B0); PG8_MMA(0, 1, At, B1); PG8_BAR; PG8_SCHED;
            PG8_LDA(At, 1, 1); PG8_STAGE(PG8_SB(1, 0), b3, voffB); PG8_STAGE(PG8_SB(1, 1), b3 + hstep, voffB); PG8_STAGE(PG8_SA(1, 0), a3, voffA);
            PG8_WAIT_V(8); PG8_WAIT_L(0); PG8_BAR; PG8_MMA(1, 0, At, B0); PG8_MMA(1, 1, At, B1); PG8_BAR; PG8_SCHED;
        }
        if constexpr (ALIGN_EPI) { if (wr == 0) PG8_BAR; }
        E(acc, cur, wr, wc, fr, fq);
        if (!has_next) break;
#pragma unroll
        for (int a = 0; a < 2; ++a)
#pragma unroll
            for (int b = 0; b < 2; ++b)
#pragma unroll
                for (int m = 0; m < 4; ++m)
#pragma unroll
                    for (int n = 0; n < 2; ++n) acc[a][b][m][n] = (f32x4){0.f, 0.f, 0.f, 0.f};
        cur = nxt; cA = nA; cB = nB; ++ui;
        if constexpr (ALIGN_EPI) { if (wr == 1) PG8_BAR; }
    }
    PG8_WAIT_V(0);
    if constexpr (!ALIGN_EPI) { if (wr == 0) PG8_BAR; }
    PG8_BAR;
#undef PG8_SA
#undef PG8_SB
#undef PG8_STAGE
#undef PG8_LDA
#undef PG8_LDB
#undef PG8_MMA
#undef PG8_WAIT_V
#undef PG8_WAIT_L
#undef PG8_BAR
#undef PG8_SCHED
}
}

struct Args { const float* in[17]; float* out; unsigned char* ws; int ph_lo, ph_hi; };
struct Ctx {
    LAS unsigned char* lds; int tid, lane, wave, G, bid;
    const float *x, *c, *w_ada, *b_ada, *norm1_w, *w_in, *lb_logits, *hgrn_onorm_w, *conv_w, *conv_onorm_w, *w_out, *norm2_w, *w_query, *sub_keys, *peer_u, *peer_v, *final_w;
    float* out; float *ACH, *MOD, *LB;
    bf16 *WIN, *WOUT, *WQ, *KEYS, *H1, *YCAT, *PROJ, *H2, *QP, *ST, *X1B; unsigned char *U8, *V8; float *SUV;
};

__device__ __forceinline__ void p0_transpose_item(const float* W, int K, int N, bf16* WT, LAS float* scr, int item, int lane) {
    const int nblk = N / 32, kb = item / nblk, nb = item % nblk, k0 = 64 * kb, n0 = 32 * nb;
#pragma unroll 8
    for (int i = 0; i < 32; ++i) { const int kk = 2 * i + (lane >> 5); scr[kk * 33 + (lane & 31)] = W[(size_t)(k0 + kk) * N + n0 + (lane & 31)]; }
    asm volatile("s_waitcnt lgkmcnt(0)" ::: "memory"); __builtin_amdgcn_wave_barrier();
    const int c = lane & 7;
#pragma unroll
    for (int j = 0; j < 4; ++j) { const int n = (lane >> 3) + 8 * j; const LAS float* s = scr + (8 * c) * 33 + n;
        v4u o; o.x = pk2(s[0 * 33], s[1 * 33]); o.y = pk2(s[2 * 33], s[3 * 33]); o.z = pk2(s[4 * 33], s[5 * 33]); o.w = pk2(s[6 * 33], s[7 * 33]);
        *(v4u*)(WT + (size_t)(n0 + n) * K + k0 + 8 * c) = o; }
    asm volatile("s_waitcnt lgkmcnt(0)" ::: "memory"); __builtin_amdgcn_wave_barrier();
}
__device__ __forceinline__ void cvt_stream(const float* src, bf16* dst, size_t n8, size_t gtid, size_t gstride) {
    for (size_t i = gtid; i < n8; i += gstride) {
        const f32x4 a = *(const f32x4*)(src + i * 8), b = *(const f32x4*)(src + i * 8 + 4);
        v4u o; o.x = pk2(a[0], a[1]); o.y = pk2(a[2], a[3]); o.z = pk2(b[0], b[1]); o.w = pk2(b[2], b[3]);
        *(v4u*)(dst + i * 8) = o;
    }
}

__device__ __forceinline__ void p0_prep(Ctx& F) {
    {
        LAS float* sc = (LAS float*)(F.lds);
        LAS float* part = (LAS float*)(F.lds + 8192);
        for (int u = F.bid; u < 192; u += F.G) {
            for (int i = F.tid; i < 2048; i += NTHR) { const float v = F.c[i]; sc[i] = v / (1.f + __expf(-v)); }
            __syncthreads();
            const int cgp = F.tid & 7, kg = F.tid >> 3, n0 = 32 * u + 4 * cgp;
            f32x4 a0 = {0.f, 0.f, 0.f, 0.f}, a1 = {0.f, 0.f, 0.f, 0.f};
#pragma unroll 8
            for (int k = kg; k < 1024; k += 64) { const f32x4 w = *(const f32x4*)(F.w_ada + (size_t)k * 6144 + n0); a0 += w * sc[k]; a1 += w * sc[1024 + k]; }
            *(LAS f32x4*)(part + (kg * 2 + 0) * 32 + 4 * cgp) = a0; *(LAS f32x4*)(part + (kg * 2 + 1) * 32 + 4 * cgp) = a1;
            __syncthreads();
            if (F.tid < 64) { const int b = F.tid >> 5, col = F.tid & 31; float s = F.b_ada[32 * u + col];
#pragma unroll 8
                for (int q = 0; q < 64; ++q) s += part[(q * 2 + b) * 32 + col];
                F.MOD[b * 6144 + 32 * u + col] = s; }
            __syncthreads();
        }
    }
}

__device__ __forceinline__ void p0_prep2(Ctx& F) {
    if (F.bid == (F.G > 100 ? 100 : 0)) { const float l0 = F.lb_logits[F.tid], l1 = F.lb_logits[512 + F.tid]; F.LB[F.tid] = 1.f / (1.f + __expf(l1 - l0)); }
    {
        LAS float* scr = (LAS float*)(F.lds + 32768 + F.wave * 12288);
        const int gw = F.bid * NWAVES + F.wave, NGW = F.G * NWAVES;
        constexpr int I_IN = (D / 64) * (NIN / 32), I_OUT = (D / 64) * (D / 32), I_Q = (D / 64) * (NQ / 32);
        for (int it = gw; it < I_IN + I_OUT + I_Q; it += NGW) {
            int r = it;
            if (r < I_IN) { p0_transpose_item(F.w_in, D, NIN, F.WIN, scr, r, F.lane); continue; } r -= I_IN;
            if (r < I_OUT) { p0_transpose_item(F.w_out, D, D, F.WOUT, scr, r, F.lane); continue; } r -= I_OUT;
            p0_transpose_item(F.w_query, D, NQ, F.WQ, scr, r, F.lane);
        }
    }
    {
        const size_t gtid = (size_t)F.bid * NTHR + F.tid, gs = (size_t)F.G * NTHR;
        cvt_stream(F.sub_keys, F.KEYS, (size_t)16 * 128 * 128 / 8, gtid, gs);
    }
}

__device__ __forceinline__ void convert_experts(Ctx& F, int wg, int nwg) {
    {
        const int gw = wg * NWAVES + F.wave, NGW = nwg * NWAVES;
        for (int r = gw; r < 32768; r += NGW) {
            const bool isv = r >= 16384; const int e = r & 16383;
            const float* srow = (isv ? F.peer_v : F.peer_u) + (size_t)e * D;
            f32x4 v[4]; float am = 0.f;
#pragma unroll
            for (int j = 0; j < 4; ++j) { v[j] = *(const f32x4*)(srow + 4 * F.lane + 256 * j);
                am = fmaxf(am, fmaxf(fmaxf(fabsf(v[j].x), fabsf(v[j].y)), fmaxf(fabsf(v[j].z), fabsf(v[j].w)))); }
#pragma unroll
            for (int o = 1; o < 64; o <<= 1) am = fmaxf(am, __shfl_xor(am, o));
            unsigned* drow = (unsigned*)((isv ? F.V8 : F.U8) + (size_t)e * D);
            if (isv) {
                const float inv = am > 0.f ? 432.f / am : 0.f;
#pragma unroll
                for (int j = 0; j < 4; ++j) { int p = __builtin_amdgcn_cvt_pk_fp8_f32(v[j].x * inv, v[j].y * inv, 0, false); p = __builtin_amdgcn_cvt_pk_fp8_f32(v[j].z * inv, v[j].w * inv, p, true);
                    drow[F.lane + 64 * j] = (unsigned)p; }
                if (F.lane == 0) F.SUV[2 * e + 1] = am * (1.f / 432.f);
            } else {
                const float inv = am > 0.f ? 127.f / am : 0.f;
#pragma unroll
                for (int j = 0; j < 4; ++j) {
                    const int q0 = (int)rintf(v[j].x * inv), q1 = (int)rintf(v[j].y * inv), q2 = (int)rintf(v[j].z * inv), q3 = (int)rintf(v[j].w * inv);
                    drow[F.lane + 64 * j] = (unsigned)(q0 & 255) | ((unsigned)(q1 & 255) << 8) | ((unsigned)(q2 & 255) << 16) | ((unsigned)(q3 & 255) << 24); }
                if (F.lane == 0) F.SUV[2 * e] = am * (1.f / 127.f);
            }
        }
    }
}

__device__ __forceinline__ void modnorm_row_bf16(const bf16* xrow, const float* w, const float* shift, const float* scale, bf16* orow, int lane) {
    const v4u a = *(const v4u*)(xrow + 16 * lane), bq = *(const v4u*)(xrow + 16 * lane + 8);
    float v[16]; float s = 0.f;
#pragma unroll
    for (int i = 0; i < 4; ++i) { v[2 * i] = bf2f(a[i] & 0xffffu); v[2 * i + 1] = __uint_as_float(a[i] & 0xffff0000u); v[8 + 2 * i] = bf2f(bq[i] & 0xffffu); v[8 + 2 * i + 1] = __uint_as_float(bq[i] & 0xffff0000u); }
#pragma unroll
    for (int i = 0; i < 16; ++i) s += v[i] * v[i];
    const float rstd = 1.f / sqrtf(wave_sum(s) * (1.f / D) + EPS);
    unsigned o[8];
#pragma unroll
    for (int q = 0; q < 4; ++q) { const int col = 16 * lane + 4 * q;
        const f32x4 wv = *(const f32x4*)(w + col), sh = *(const f32x4*)(shift + col), sc = *(const f32x4*)(scale + col);
        const float y0 = v[4 * q] * rstd * wv[0] * (sc[0] + 1.f) + sh[0], y1 = v[4 * q + 1] * rstd * wv[1] * (sc[1] + 1.f) + sh[1];
        const float y2 = v[4 * q + 2] * rstd * wv[2] * (sc[2] + 1.f) + sh[2], y3 = v[4 * q + 3] * rstd * wv[3] * (sc[3] + 1.f) + sh[3];
        o[2 * q] = pk2(y0, y1); o[2 * q + 1] = pk2(y2, y3); }
    *(v4u*)(orow + 16 * lane) = (v4u){o[0], o[1], o[2], o[3]}; *(v4u*)(orow + 16 * lane + 8) = (v4u){o[4], o[5], o[6], o[7]};
}
__device__ __forceinline__ void modnorm_row(const float* xrow, const float* w, const float* shift, const float* scale, bf16* orow, int lane) {
    f32x4 v[4]; float s = 0.f;
#pragma unroll
    for (int j = 0; j < 4; ++j) { v[j] = *(const f32x4*)(xrow + 4 * lane + 256 * j); s += (v[j].x * v[j].x + v[j].y * v[j].y) + (v[j].z * v[j].z + v[j].w * v[j].w); }
    const float rstd = 1.f / sqrtf(wave_sum(s) * (1.f / D) + EPS);
#pragma unroll
    for (int j = 0; j < 4; ++j) { const int col = 4 * lane + 256 * j;
        const f32x4 wv = *(const f32x4*)(w + col), sh = *(const f32x4*)(shift + col), sc = *(const f32x4*)(scale + col);
        const f32x4 y = v[j] * rstd * wv * (sc + 1.f) + sh;
        v2u o; o.x = pk2(y.x, y.y); o.y = pk2(y.z, y.w); *(v2u*)(orow + col) = o; }
}

__device__ __forceinline__ void p3_local(Ctx& F) {
    LAS unsigned char* KT = F.lds;
    LAS unsigned char* VT = F.lds + 18432;
    LAS float* QT = (LAS float*)(F.lds + 36864);
    LAS unsigned char* OUT = F.lds + 38912;
    const int tid = F.tid, lane = F.lane, wave = F.wave, fr = lane & 15, fq = lane >> 4;
    for (int u = F.bid; u < 1024; u += F.G) {
        const int bh = u >> 7, c = u & 127, b = bh >> 2, hh = bh & 3;
        const size_t r0 = (size_t)b * SEQ + (size_t)c * 64;
        const int d = tid & 127, tq = tid >> 7;
        const bf16* pf = F.PROJ + (r0 + 16 * tq) * NIN + 512 + hh * 128 + d;
        const bf16* pv = F.PROJ + (r0 + 16 * tq) * NIN + 1024 + hh * 128 + d;
        const float lbv = F.LB[hh * 128 + d], oml = 1.f - lbv;
        unsigned short fraw[16], vraw[16];
#pragma unroll
        for (int j = 0; j < 16; ++j) { fraw[j] = pf[(size_t)j * NIN]; vraw[j] = pv[(size_t)j * NIN]; }
        float cs[16], kk[16]; float run = 0.f;
#pragma unroll
        for (int j = 0; j < 16; ++j) { const float fv = bf2f(fraw[j]); const float e = __expf(-fv); const float sg = 1.f / (1.f + e);
            const float f = lbv + oml * sg; run += __logf(f); cs[j] = run; kk[j] = oml * (e * sg); }
        QT[tq * 128 + d] = run;
        __syncthreads();
        float prefix = 0.f, total = 0.f;
#pragma unroll
        for (int q = 0; q < 4; ++q) { const float t = QT[q * 128 + d]; total += t; if (q < tq) prefix += t; }
        unsigned kp[8], vp[8];
#pragma unroll
        for (int j = 0; j < 8; ++j) { const float k0 = kk[2 * j] * __expf(total - (prefix + cs[2 * j])), k1 = kk[2 * j + 1] * __expf(total - (prefix + cs[2 * j + 1]));
            kp[j] = pk2(k0, k1); vp[j] = (unsigned)vraw[2 * j] | ((unsigned)vraw[2 * j + 1] << 16); }
        *(LAS v4u*)(KT + d * 144 + tq * 32) = (v4u){kp[0], kp[1], kp[2], kp[3]}; *(LAS v4u*)(KT + d * 144 + tq * 32 + 16) = (v4u){kp[4], kp[5], kp[6], kp[7]};
        *(LAS v4u*)(VT + d * 144 + tq * 32) = (v4u){vp[0], vp[1], vp[2], vp[3]}; *(LAS v4u*)(VT + d * 144 + tq * 32 + 16) = (v4u){vp[4], vp[5], vp[6], vp[7]};
        if (tq == 0) F.ACH[u * 128 + d] = __expf(total);
        __syncthreads();
        {
            const int dblk = wave & 3, vh = wave >> 2;
            f32x4 acc[2][4];
#pragma unroll
            for (int a = 0; a < 2; ++a)
#pragma unroll
                for (int n = 0; n < 4; ++n) acc[a][n] = (f32x4){0.f, 0.f, 0.f, 0.f};
#pragma unroll
            for (int k2 = 0; k2 < 2; ++k2) {
                bf16x8 af[2], bfv[4];
#pragma unroll
                for (int a = 0; a < 2; ++a) af[a] = *(const LAS bf16x8*)(KT + (dblk * 32 + a * 16 + fr) * 144 + (k2 * 32 + fq * 8) * 2);
#pragma unroll
                for (int n = 0; n < 4; ++n) bfv[n] = *(const LAS bf16x8*)(VT + (vh * 64 + n * 16 + fr) * 144 + (k2 * 32 + fq * 8) * 2);
#pragma unroll
                for (int a = 0; a < 2; ++a)
#pragma unroll
                    for (int n = 0; n < 4; ++n) acc[a][n] = __builtin_amdgcn_mfma_f32_16x16x32_bf16(af[a], bfv[n], acc[a][n], 0, 0, 0);
            }
#pragma unroll
            for (int a = 0; a < 2; ++a)
#pragma unroll
                for (int n = 0; n < 4; ++n) { const int v = vh * 64 + n * 16 + fr, dd = dblk * 32 + a * 16 + 4 * fq;
                    *(LAS v2u*)(OUT + v * 272 + dd * 2) = (v2u){pk2(acc[a][n][0], acc[a][n][1]), pk2(acc[a][n][2], acc[a][n][3])}; }
        }
        __syncthreads();
        { const int row = tid >> 2, part = tid & 3; bf16* dst = F.ST + (size_t)u * 16384 + row * 128 + part * 32;
#pragma unroll
            for (int i = 0; i < 4; ++i) *(v4u*)(dst + i * 8) = *(const LAS v4u*)(OUT + row * 272 + part * 64 + i * 16); }
        __syncthreads();
    }
    {
        const int gw = F.bid * NWAVES + F.wave, NGW = F.G * NWAVES;
        const int ch = lane * 8;
        float w0[8], w1[8], w2[8], ow[8];
#pragma unroll
        for (int j = 0; j < 8; ++j) { w0[j] = F.conv_w[ch + j]; w1[j] = F.conv_w[512 + ch + j]; w2[j] = F.conv_w[1024 + ch + j]; ow[j] = F.conv_onorm_w[ch + j]; }
        for (int run = gw; run < M / 8; run += NGW) {
            const int rbase = run * 8;
            float u1[8], u2[8];
#pragma unroll
            for (int j = 0; j < 8; ++j) { u1[j] = 0.f; u2[j] = 0.f; }
            const int tpos = rbase & (SEQ - 1);
            if (tpos >= 1) { const bf16* p = F.PROJ + (size_t)(rbase - 1) * NIN + 2048 + ch; const v4u cc = *(const v4u*)(p + 512), xx = *(const v4u*)(p + 1024);
#pragma unroll
                for (int j = 0; j < 4; ++j) { const unsigned cw = cc[j], xw = xx[j]; u1[2 * j] = bf2f(cw & 0xffffu) * bf2f(xw & 0xffffu); u1[2 * j + 1] = bf2f(cw >> 16) * bf2f(xw >> 16); } }
            if (tpos >= 2) { const bf16* p = F.PROJ + (size_t)(rbase - 2) * NIN + 2048 + ch; const v4u cc = *(const v4u*)(p + 512), xx = *(const v4u*)(p + 1024);
#pragma unroll
                for (int j = 0; j < 4; ++j) { const unsigned cw = cc[j], xw = xx[j]; u2[2 * j] = bf2f(cw & 0xffffu) * bf2f(xw & 0xffffu); u2[2 * j + 1] = bf2f(cw >> 16) * bf2f(xw >> 16); } }
            for (int t = 0; t < 8; ++t) {
                const bf16* p = F.PROJ + (size_t)(rbase + t) * NIN + 2048 + ch;
                const v4u bb = *(const v4u*)(p), cc = *(const v4u*)(p + 512), xx = *(const v4u*)(p + 1024);
                float u0[8], y[8]; float ss = 0.f;
#pragma unroll
                for (int j = 0; j < 4; ++j) { const unsigned cw = cc[j], xw = xx[j]; u0[2 * j] = bf2f(cw & 0xffffu) * bf2f(xw & 0xffffu); u0[2 * j + 1] = bf2f(cw >> 16) * bf2f(xw >> 16); }
#pragma unroll
                for (int j = 0; j < 8; ++j) { const float bg = bf2f((j & 1) ? (bb[j >> 1] >> 16) : (bb[j >> 1] & 0xffffu));
                    y[j] = bg * (w0[j] * u2[j] + w1[j] * u1[j] + w2[j] * u0[j]); ss += y[j] * y[j]; }
                ss += __shfl_xor(ss, 1); ss += __shfl_xor(ss, 2); ss += __shfl_xor(ss, 4); ss += __shfl_xor(ss, 8);
                const float rstd = 1.f / sqrtf(ss * (1.f / 128.f) + EPS);
                v4u o; o.x = pk2(y[0] * rstd * ow[0], y[1] * rstd * ow[1]); o.y = pk2(y[2] * rstd * ow[2], y[3] * rstd * ow[3]);
                o.z = pk2(y[4] * rstd * ow[4], y[5] * rstd * ow[5]); o.w = pk2(y[6] * rstd * ow[6], y[7] * rstd * ow[7]);
                *(v4u*)(F.YCAT + (size_t)(rbase + t) * D + 512 + ch) = o;
#pragma unroll
                for (int j = 0; j < 8; ++j) { u2[j] = u1[j]; u1[j] = u0[j]; }
            }
        }
    }
}

__device__ __forceinline__ void p4_scan(Ctx& F) {
    const int gtid = F.bid * NTHR + F.tid;
    if (gtid >= 131072) return;
    const int bh = gtid >> 14, e1 = gtid & 16383, d = e1 & 127;
    unsigned short* p = (unsigned short*)(F.ST + (size_t)bh * 128 * 16384 + e1);
    const float* a = F.ACH + (size_t)bh * 128 * 128 + d;
    float s0 = 0.f;
#pragma unroll 16
    for (int c = 0; c < 128; ++c) {
        const unsigned uu = p[(size_t)c * 16384]; const float a0 = a[c * 128];
        p[(size_t)c * 16384] = (unsigned short)f2bf(s0);
        s0 = a0 * s0 + bf2f(uu);
    }
}

__device__ __forceinline__ void p5_out(Ctx& F) {
    LAS unsigned char* QM = F.lds;
    LAS unsigned char* Q0 = F.lds + 17408;
    LAS unsigned char* KM = F.lds + 34816;
    LAS unsigned char* VT = F.lds + 52224;
    LAS unsigned char* STL = F.lds + 70656;
    LAS float* QT = (LAS float*)(F.lds + 105472);
    LAS unsigned char* PB = F.lds + 107520;
    LAS float* NRM = (LAS float*)(F.lds + 125952);
    const int tid = F.tid, lane = F.lane, wave = F.wave, fr = lane & 15, fq = lane >> 4;
    for (int u = F.bid; u < 1024; u += F.G) {
        const int bh = u >> 7, c = u & 127, b = bh >> 2, hh = bh & 3;
        const size_t r0 = (size_t)b * SEQ + (size_t)c * 64;
        const int d = tid & 127, tq = tid >> 7;
        const bf16* pq = F.PROJ + (r0 + 16 * tq) * NIN + hh * 128 + d;
        const float lbv = F.LB[hh * 128 + d], oml = 1.f - lbv;
        unsigned short qraw[16], fraw[16], vraw[16];
#pragma unroll
        for (int j = 0; j < 16; ++j) { qraw[j] = pq[(size_t)j * NIN]; fraw[j] = pq[(size_t)j * NIN + 512]; vraw[j] = pq[(size_t)j * NIN + 1024]; }
        {
            const bf16* src = F.ST + (size_t)u * 16384;
#pragma unroll
            for (int i = 0; i < 4; ++i) { const int row = (tid >> 4) + 32 * i, ck = tid & 15; *(LAS v4u*)(STL + row * 272 + ck * 16) = *(const v4u*)(src + row * 128 + ck * 8); }
        }
        float cs[16], kk[16]; float run = 0.f;
#pragma unroll
        for (int j = 0; j < 16; ++j) { const float fv = bf2f(fraw[j]); const float e = __expf(-fv); const float sg = 1.f / (1.f + e);
            const float f = lbv + oml * sg; run += __logf(f); cs[j] = run; kk[j] = oml * (e * sg); }
        QT[tq * 128 + d] = run;
        __syncthreads();
        float prefix = 0.f; const float q0t = QT[d], q1t = QT[128 + d], q2t = QT[256 + d];
        if (tq >= 1) prefix += q0t; if (tq >= 2) prefix += q1t; if (tq >= 3) prefix += q2t;
        const float bmid = q0t + q1t;
        unsigned vp[8];
#pragma unroll
        for (int j = 0; j < 16; ++j) { const float bj = prefix + cs[j]; const float qv = bf2f(qraw[j]); const int t = 16 * tq + j;
            *(LAS unsigned short*)(QM + t * 272 + d * 2) = (unsigned short)f2bf(qv * __expf(bj - bmid));
            *(LAS unsigned short*)(Q0 + t * 272 + d * 2) = (unsigned short)f2bf(qv * __expf(bj));
            *(LAS unsigned short*)(KM + t * 272 + d * 2) = (unsigned short)f2bf(kk[j] * __expf(bmid - bj)); }
#pragma unroll
        for (int j = 0; j < 8; ++j) vp[j] = (unsigned)vraw[2 * j] | ((unsigned)vraw[2 * j + 1] << 16);
        *(LAS v4u*)(VT + d * 144 + tq * 32) = (v4u){vp[0], vp[1], vp[2], vp[3]}; *(LAS v4u*)(VT + d * 144 + tq * 32 + 16) = (v4u){vp[4], vp[5], vp[6], vp[7]};
        __syncthreads();
        const int rb = wave >> 1, vh = wave & 1;
        LAS unsigned char* P = PB + wave * 2304;
        {
            f32x4 sc[4];
#pragma unroll
            for (int sf = 0; sf < 4; ++sf) sc[sf] = (f32x4){0.f, 0.f, 0.f, 0.f};
#pragma unroll
            for (int k4 = 0; k4 < 4; ++k4) {
                const bf16x8 bq = *(const LAS bf16x8*)(QM + (16 * rb + fr) * 272 + (k4 * 32 + fq * 8) * 2);
#pragma unroll
                for (int sf = 0; sf < 4; ++sf) { const bf16x8 ak = *(const LAS bf16x8*)(KM + (16 * sf + fr) * 272 + (k4 * 32 + fq * 8) * 2);
                    sc[sf] = __builtin_amdgcn_mfma_f32_16x16x32_bf16(ak, bq, sc[sf], 0, 0, 0); }
            }
            const int t = 16 * rb + fr;
#pragma unroll
            for (int sf = 0; sf < 4; ++sf) { const int s0 = 16 * sf + 4 * fq;
                const float p0 = (s0 + 0 <= t) ? sc[sf][0] : 0.f, p1 = (s0 + 1 <= t) ? sc[sf][1] : 0.f, p2 = (s0 + 2 <= t) ? sc[sf][2] : 0.f, p3 = (s0 + 3 <= t) ? sc[sf][3] : 0.f;
                *(LAS v2u*)(P + fr * 144 + s0 * 2) = (v2u){pk2(p0, p1), pk2(p2, p3)}; }
        }
        __syncthreads();
        f32x4 oc[4];
#pragma unroll
        for (int n = 0; n < 4; ++n) oc[n] = (f32x4){0.f, 0.f, 0.f, 0.f};
#pragma unroll
        for (int k2 = 0; k2 < 2; ++k2) {
            const bf16x8 bp = *(const LAS bf16x8*)(P + fr * 144 + (k2 * 32 + fq * 8) * 2);
#pragma unroll
            for (int n = 0; n < 4; ++n) { const bf16x8 av = *(const LAS bf16x8*)(VT + (64 * vh + 16 * n + fr) * 144 + (k2 * 32 + fq * 8) * 2);
                oc[n] = __builtin_amdgcn_mfma_f32_16x16x32_bf16(av, bp, oc[n], 0, 0, 0); }
        }
#pragma unroll
        for (int k4 = 0; k4 < 4; ++k4) {
            const bf16x8 bq = *(const LAS bf16x8*)(Q0 + (16 * rb + fr) * 272 + (k4 * 32 + fq * 8) * 2);
#pragma unroll
            for (int n = 0; n < 4; ++n) { const bf16x8 as = *(const LAS bf16x8*)(STL + (64 * vh + 16 * n + fr) * 272 + (k4 * 32 + fq * 8) * 2);
                oc[n] = __builtin_amdgcn_mfma_f32_16x16x32_bf16(as, bq, oc[n], 0, 0, 0); }
        }
        float ss = 0.f;
#pragma unroll
        for (int n = 0; n < 4; ++n) ss += (oc[n][0] * oc[n][0] + oc[n][1] * oc[n][1]) + (oc[n][2] * oc[n][2] + oc[n][3] * oc[n][3]);
        ss += __shfl_xor(ss, 16); ss += __shfl_xor(ss, 32);
        if (fq == 0) NRM[(16 * rb + fr) * 2 + vh] = ss;
        __syncthreads();
        {
            const int t = 16 * rb + fr; const float tot = NRM[t * 2] + NRM[t * 2 + 1];
            const float rstd = 1.f / sqrtf(tot * (1.f / 128.f) + EPS);
            const bf16* pg = F.PROJ + (r0 + t) * NIN + 1536 + hh * 128;
            bf16* po = F.YCAT + (r0 + t) * D + hh * 128;
#pragma unroll
            for (int n = 0; n < 4; ++n) { const int v = 64 * vh + 16 * n + 4 * fq;
                const v2u gw = *(const v2u*)(pg + v); const f32x4 wv = *(const f32x4*)(F.hgrn_onorm_w + hh * 128 + v);
                float g[4] = {bf2f(gw.x & 0xffffu), bf2f(gw.x >> 16), bf2f(gw.y & 0xffffu), bf2f(gw.y >> 16)}; float o[4];
#pragma unroll
                for (int j = 0; j < 4; ++j) { const float sl = g[j] / (1.f + __expf(-g[j])); o[j] = oc[n][j] * rstd * wv[j] * sl; }
                *(v2u*)(po + v) = (v2u){pk2(o[0], o[1]), pk2(o[2], o[3])}; }
        }
        __syncthreads();
    }
}

__device__ __forceinline__ unsigned f2ord(float f) { const unsigned u = __float_as_uint(f); return (u & 0x80000000u) ? ~u : (u | 0x80000000u); }
__device__ __forceinline__ float ord2f(unsigned o) { return __uint_as_float((o & 0x80000000u) ? (o & 0x7fffffffu) : ~o); }
__device__ __forceinline__ void ce_desc(unsigned& a, unsigned& b) { const unsigned mx = a > b ? a : b, mn = a > b ? b : a; a = mx; b = mn; }
template <int N> __device__ __forceinline__ void bitonic_sort_desc(unsigned (&k)[N]) {
#pragma unroll
    for (int size = 2; size <= N; size <<= 1) {
#pragma unroll
        for (int stride = size >> 1; stride > 0; stride >>= 1) {
#pragma unroll
            for (int i = 0; i < N; ++i) { const int j = i ^ stride; if (j > i) { if ((i & size) == 0) ce_desc(k[i], k[j]); else ce_desc(k[j], k[i]); } }
        }
    }
}
__device__ __forceinline__ void bitonic_merge16_desc(unsigned (&k)[16]) {
#pragma unroll
    for (int stride = 8; stride > 0; stride >>= 1) {
#pragma unroll
        for (int i = 0; i < 16; ++i) { const int j = i ^ stride; if (j > i) ce_desc(k[i], k[j]); }
    }
}
__device__ __forceinline__ void merge_top16(unsigned (&a)[16], const unsigned (&b)[16]) {
#pragma unroll
    for (int i = 0; i < 16; ++i) a[i] = a[i] > b[15 - i] ? a[i] : b[15 - i];
    bitonic_merge16_desc(a);
}
__device__ __forceinline__ float gelu_as(float v) {
    const float av = fabsf(v), t = __builtin_amdgcn_rcpf(av * 0.2316418882f + 1.0f);
    float q = t * 0.5307027145f + (-0.7265760135f); q = q * t + 0.7107068705f; q = q * t + (-0.142248368f); q = q * t + 0.127414796f; q = q * t;
    const float e = __builtin_amdgcn_exp2f((v * v) * (-0.72134752044f));
    const float m = v * (q * e);
    return v < 0.f ? m : v - m;
}
__device__ __forceinline__ float gelu_erf(float x) { return 0.5f * x * (1.f + erff(x * 0.70710678118654752f)); }

__device__ __forceinline__ int row16_sum_i32(int v) {
    v += __builtin_amdgcn_update_dpp(0, v, 0xB1, 0xf, 0xf, true);
    v += __builtin_amdgcn_update_dpp(0, v, 0x4E, 0xf, 0xf, true);
    v += __builtin_amdgcn_update_dpp(0, v, 0x141, 0xf, 0xf, true);
    v += __builtin_amdgcn_update_dpp(0, v, 0x140, 0xf, 0xf, true);
    return v;
}
__device__ __forceinline__ void p9_peer(Ctx& F) {
    LAS unsigned* TOP = (LAS unsigned*)F.lds;
    LAS v2u* IDXS = (LAS v2u*)(F.lds + 65536);
    LAS v4u* CNT = (LAS v4u*)(F.lds + 132096);
    LAS unsigned char* OFFS = F.lds + 140288;
    LAS float* SH = (LAS float*)(F.lds + 142336);
    LAS unsigned char* HQ = F.lds;
    const int tid = F.tid, lane = F.lane, wave = F.wave, fr = lane & 15, fq = lane >> 4;
    for (int tile = F.bid; tile < M / 64; tile += F.G) {
        const size_t r0 = (size_t)tile * 64;
        {
            const int p = wave >> 2, tb = wave & 3;
            LAS unsigned char* KL = F.lds + 73728;
            v4u kpre[8]; bf16x8 qpre[4];
            const bf16* qbase = F.QP + (r0 + 16 * tb + fr) * NQ + p * 128 + fq * 8;
#pragma unroll
            for (int i = 0; i < 8; ++i) kpre[i] = *(const v4u*)(F.KEYS + (size_t)(tid + 512 * i) * 8);
#pragma unroll
            for (int k4 = 0; k4 < 4; ++k4) qpre[k4] = *(const bf16x8*)(qbase + k4 * 32);
#pragma unroll 1
            for (int h = 0; h < 8; ++h) {
#pragma unroll
                for (int i = 0; i < 8; ++i) { const int c = tid + 512 * i; *(LAS v4u*)(KL + (c >> 4) * 272 + (c & 15) * 16) = kpre[i]; }
                bf16x8 bq[4];
#pragma unroll
                for (int k4 = 0; k4 < 4; ++k4) bq[k4] = qpre[k4];
                __syncthreads();
                if (h < 7) {
#pragma unroll
                    for (int i = 0; i < 8; ++i) kpre[i] = *(const v4u*)(F.KEYS + (size_t)(h + 1) * 32768 + (size_t)(tid + 512 * i) * 8);
#pragma unroll
                    for (int k4 = 0; k4 < 4; ++k4) qpre[k4] = *(const bf16x8*)(qbase + (h + 1) * 256 + k4 * 32);
                }
                f32x4 sc[8];
#pragma unroll
                for (int nf = 0; nf < 8; ++nf) sc[nf] = (f32x4){0.f, 0.f, 0.f, 0.f};
                const LAS unsigned char* krow = KL + (p * 128 + fr) * 272 + fq * 16;
#pragma unroll
                for (int k4 = 0; k4 < 4; ++k4) {
#pragma unroll
                    for (int nf = 0; nf < 8; ++nf) { const bf16x8 ak = *(const LAS bf16x8*)(krow + nf * 16 * 272 + k4 * 64);
                        sc[nf] = __builtin_amdgcn_mfma_f32_16x16x32_bf16(ak, bq[k4], sc[nf], 0, 0, 0); }
                }
                unsigned ka[16], kb[16];
#pragma unroll
                for (int nf = 0; nf < 4; ++nf)
#pragma unroll
                    for (int r = 0; r < 4; ++r) {
                        ka[nf * 4 + r] = (f2ord(sc[nf][r]) & ~127u) | (unsigned)(127 - (16 * nf + 4 * fq + r));
                        kb[nf * 4 + r] = (f2ord(sc[nf + 4][r]) & ~127u) | (unsigned)(127 - (16 * (nf + 4) + 4 * fq + r)); }
                bitonic_sort_desc<16>(ka); bitonic_sort_desc<16>(kb);
                merge_top16(ka, kb);
                {
                    unsigned o[16];
#pragma unroll
                    for (int i = 0; i < 16; ++i) o[i] = (unsigned)__shfl_xor((int)ka[i], 16);
                    merge_top16(ka, o);
#pragma unroll
                    for (int i = 0; i < 16; ++i) o[i] = (unsigned)__shfl_xor((int)ka[i], 32);
                    merge_top16(ka, o);
                }
                if (fq == 0) { LAS v4u* dst = (LAS v4u*)(TOP + (h * 64 + 16 * tb + fr) * 36 + p * 16);
                    dst[0] = (v4u){ka[0], ka[1], ka[2], ka[3]}; dst[1] = (v4u){ka[4], ka[5], ka[6], ka[7]}; dst[2] = (v4u){ka[8], ka[9], ka[10], ka[11]}; dst[3] = (v4u){ka[12], ka[13], ka[14], ka[15]}; }
                __syncthreads();
            }
        }
        __syncthreads();
        {
            const int t = tid & 63, h = tid >> 6;
            const LAS unsigned* pa = TOP + (h * 64 + t) * 36; const LAS unsigned* pb = pa + 16;
            float bv[16];
            { const LAS v4u* qb = (const LAS v4u*)pb;
#pragma unroll
              for (int i = 0; i < 4; ++i) { const v4u y = qb[i];
#pragma unroll
                  for (int j = 0; j < 4; ++j) bv[4 * i + j] = ord2f(y[j] & ~127u); } }
#define CKEY(i, j) ((f2ord(ord2f(pa[i] & ~127u) + bv[j]) & ~255u) | (unsigned)(255 - ((i) * 16 + (j))))
            unsigned c0[16];
#pragma unroll
            for (int j = 0; j < 16; ++j) c0[j] = CKEY(0, j);
            bitonic_sort_desc<16>(c0);
            {
                unsigned cb[16];
#pragma unroll
                for (int j = 0; j < 8; ++j) cb[j] = CKEY(1, j);
#pragma unroll
                for (int j = 0; j < 5; ++j) cb[8 + j] = CKEY(2, j);
#pragma unroll
                for (int j = 0; j < 3; ++j) cb[13 + j] = CKEY(4, j);
                bitonic_sort_desc<16>(cb); merge_top16(c0, cb);
            }
            {
                unsigned cc[16];
#pragma unroll
                for (int j = 0; j < 4; ++j) cc[j] = CKEY(3, j);
#pragma unroll
                for (int j = 0; j < 2; ++j) { cc[4 + j] = CKEY(5, j); cc[6 + j] = CKEY(6, j); cc[8 + j] = CKEY(7, j); }
                cc[10] = CKEY(8, 0); cc[11] = CKEY(9, 0); cc[12] = CKEY(10, 0); cc[13] = CKEY(11, 0); cc[14] = CKEY(12, 0); cc[15] = CKEY(13, 0);
                bitonic_sort_desc<16>(cc); merge_top16(c0, cc);
            }
            { unsigned x = CKEY(14, 0);
#pragma unroll
              for (int k = 0; k < 16; ++k) ce_desc(c0[k], x);
              x = CKEY(15, 0);
#pragma unroll
              for (int k = 0; k < 16; ++k) ce_desc(c0[k], x); }
#undef CKEY
            float sv[16]; unsigned ix[16]; float mx = -3.0e38f;
#pragma unroll
            for (int k = 0; k < 16; ++k) { const unsigned pos = 255u - (c0[k] & 255u); const unsigned ua = pa[pos >> 4], ub = pb[pos & 15];
                sv[k] = ord2f(ua & ~127u) + ord2f(ub & ~127u); ix[k] = (127u - (ua & 127u)) * 128u + (127u - (ub & 127u)); mx = fmaxf(mx, sv[k]); }
            float sum = 0.f;
#pragma unroll
            for (int k = 0; k < 16; ++k) { sv[k] = __expf(sv[k] - mx); sum += sv[k]; }
            const float inv = 1.f / sum;
            unsigned c4[4] = {0u, 0u, 0u, 0u};
#pragma unroll
            for (int k = 0; k < 16; ++k) { const unsigned s = ix[k] >> 11, inc = 1u << ((s & 3u) * 8u);
#pragma unroll
                for (int w = 0; w < 4; ++w) c4[w] += ((s >> 2) == (unsigned)w) ? inc : 0u; }
            CNT[h * 64 + t] = (v4u){c4[0], c4[1], c4[2], c4[3]};
            unsigned e0[16]; float e1[16];
#pragma unroll
            for (int k = 0; k < 16; ++k) { const f32x2 sc2 = *(const f32x2*)(F.SUV + 2 * ix[k]); e0[k] = ix[k] << 10; e1[k] = __uint_as_float((f2bf(sv[k] * inv * sc2.y) << 16) | f2bf(sc2.x)); }
            __syncthreads();
            unsigned A4[4] = {0u, 0u, 0u, 0u}, B4[4] = {0u, 0u, 0u, 0u};
#pragma unroll
            for (int hh = 0; hh < 8; ++hh) { const v4u v = CNT[hh * 64 + t];
#pragma unroll
                for (int w = 0; w < 4; ++w) { A4[w] += v[w]; B4[w] += (hh < h) ? v[w] : 0u; } }
            unsigned off4[4] = {0u, 0u, 0u, 0u}; unsigned run = 0u;
#pragma unroll
            for (int s = 0; s < 16; ++s) { off4[s >> 2] |= run << ((s & 3) * 8); run += (A4[s >> 2] >> ((s & 3) * 8)) & 255u; }
            if (h == 0) { *(LAS v4u*)(OFFS + t * 32) = (v4u){off4[0], off4[1], off4[2], off4[3]}; OFFS[t * 32 + 16] = (unsigned char)128; }
            unsigned base4[4], r4[4] = {0u, 0u, 0u, 0u};
#pragma unroll
            for (int w = 0; w < 4; ++w) base4[w] = off4[w] + B4[w];
#pragma unroll
            for (int k = 0; k < 16; ++k) { const unsigned s = ix[k] >> 11, wsel = s >> 2, sh8 = (s & 3u) * 8u;
                const unsigned bsel = wsel == 0 ? base4[0] : wsel == 1 ? base4[1] : wsel == 2 ? base4[2] : base4[3];
                const unsigned rsel = wsel == 0 ? r4[0] : wsel == 1 ? r4[1] : wsel == 2 ? r4[2] : r4[3];
                const unsigned pos = ((bsel >> sh8) & 255u) + ((rsel >> sh8) & 255u);
                IDXS[t * 129 + pos] = (v2u){e0[k], __float_as_uint(e1[k])};
#pragma unroll
                for (int w = 0; w < 4; ++w) r4[w] += (wsel == (unsigned)w) ? (1u << sh8) : 0u; }
        }
        __syncthreads();
        {
#pragma unroll 2
            for (int tk = 0; tk < 8; ++tk) { const int tl = wave * 8 + tk; const size_t row = r0 + tl;
                const v4u a = *(const v4u*)(F.H2 + row * D + 16 * lane), bq = *(const v4u*)(F.H2 + row * D + 16 * lane + 8);
                float hv[16]; float am = 0.f;
#pragma unroll
                for (int w = 0; w < 4; ++w) { hv[2 * w] = bf2f(a[w] & 0xffffu); hv[2 * w + 1] = __uint_as_float(a[w] & 0xffff0000u); hv[8 + 2 * w] = bf2f(bq[w] & 0xffffu); hv[8 + 2 * w + 1] = __uint_as_float(bq[w] & 0xffff0000u); }
#pragma unroll
                for (int i = 0; i < 16; ++i) am = fmaxf(am, fabsf(hv[i]));
#pragma unroll
                for (int o = 1; o < 64; o <<= 1) am = fmaxf(am, __shfl_xor(am, o));
                const float inv = am > 0.f ? 127.f / am : 0.f; unsigned hq[4];
#pragma unroll
                for (int i = 0; i < 4; ++i) { const int q0 = (int)rintf(hv[4 * i] * inv), q1 = (int)rintf(hv[4 * i + 1] * inv), q2 = (int)rintf(hv[4 * i + 2] * inv), q3 = (int)rintf(hv[4 * i + 3] * inv);
                    hq[i] = (unsigned)(q0 & 255) | ((unsigned)(q1 & 255) << 8) | ((unsigned)(q2 & 255) << 16) | ((unsigned)(q3 & 255) << 24); }
                *(LAS v4u*)(HQ + tl * 1024 + 16 * lane) = (v4u){hq[0], hq[1], hq[2], hq[3]};
                if (lane == 0) SH[tl] = am * (1.f / 127.f); }
        }
        __syncthreads();
        {
            const int c16 = lane & 15, rp = lane >> 4;
            f32x2 acc[8][8];
#pragma unroll
            for (int tk = 0; tk < 8; ++tk) {
#pragma unroll
                for (int i = 0; i < 8; ++i) acc[tk][i] = (f32x2){0.f, 0.f}; }
#pragma unroll 1
            for (int s = 0; s < 16; ++s) {
#pragma unroll
                for (int tk = 0; tk < 8; ++tk) {
                    const int tl = wave * 8 + tk;
                    const int n0 = OFFS[tl * 32 + s], n1 = OFFS[tl * 32 + s + 1];
                    if (n0 >= n1) continue;
                    const float sh = SH[tl];
                    const LAS v2u* ent = IDXS + tl * 129;
                    v4u hq[4];
#pragma unroll
                    for (int S = 0; S < 4; ++S) hq[S] = *(const LAS v4u*)(HQ + tl * 1024 + c16 * 16 + S * 256);
                    const unsigned uoff = (unsigned)c16 * 16u, voff = (unsigned)lane * 16u;
#pragma unroll 1
                    for (int i = n0; i < n1; i += 4) {
                        const int last = n1 - 1;
                        const int iu = (i + rp) < last ? (i + rp) : last;
                        const v2u eu = ent[iu];
                        v4u uu[4], vv[4]; float gsv[4];
#pragma unroll
                        for (int S = 0; S < 4; ++S) uu[S] = *(const v4u*)(F.U8 + (eu.x + uoff + (unsigned)S * 256u));
#pragma unroll
                        for (int j = 0; j < 4; ++j) { const int ij = (i + j) < last ? (i + j) : last; const v2u ev = ent[ij];
                            vv[j] = *(const v4u*)(F.V8 + (ev.x + voff)); gsv[j] = (i + j) <= last ? __uint_as_float(ev.y & 0xffff0000u) : 0.f; }
                        int dt = 0;
#pragma unroll
                        for (int S = 0; S < 4; ++S)
#pragma unroll
                            for (int w = 0; w < 4; ++w) dt = __builtin_amdgcn_sdot4((int)uu[S][w], (int)hq[S][w], dt, false);
                        dt = row16_sum_i32(dt);
                        const float gl = gelu_as((float)dt * (__uint_as_float(eu.y << 16) * sh));
#pragma unroll
                        for (int j = 0; j < 4; ++j) {
                            const float cj = __uint_as_float(__builtin_amdgcn_readlane(__float_as_uint(gl), 16 * j)) * gsv[j];
                            const f32x2 c2 = {cj, cj};
#pragma unroll
                            for (int w = 0; w < 4; ++w) { const int x = (int)vv[j][w];
                                acc[tk][2 * w] += c2 * __builtin_amdgcn_cvt_pk_f32_fp8(x, false);
                                acc[tk][2 * w + 1] += c2 * __builtin_amdgcn_cvt_pk_f32_fp8(x, true); }
                        }
                    }
                }
            }
#pragma unroll
            for (int tk = 0; tk < 8; ++tk) {
                const int tl = wave * 8 + tk; const size_t row = r0 + tl; const int b = (int)(row >> 13);
                float x2[16]; float ss = 0.f; const int d0i = 16 * lane;
                const v4u xb0 = *(const v4u*)(F.X1B + row * D + d0i), xb1 = *(const v4u*)(F.X1B + row * D + d0i + 8);
#pragma unroll
                for (int q = 0; q < 4; ++q) { const unsigned w0 = q < 2 ? xb0[2 * q] : xb1[2 * q - 4], w1 = q < 2 ? xb0[2 * q + 1] : xb1[2 * q - 3];
                    const f32x4 xa = {bf2f(w0 & 0xffffu), __uint_as_float(w0 & 0xffff0000u), bf2f(w1 & 0xffffu), __uint_as_float(w1 & 0xffff0000u)}, ga = *(const f32x4*)(F.MOD + b * 6144 + 5120 + d0i + 4 * q);
#pragma unroll
                    for (int j = 0; j < 4; ++j) { const float a = acc[tk][2 * q + (j >> 1)][j & 1]; const float pv = a; x2[4 * q + j] = xa[j] + ga[j] * pv; ss += x2[4 * q + j] * x2[4 * q + j]; } }
                const float rstd = 1.f / sqrtf(wave_sum(ss) * (1.f / D) + EPS);
#pragma unroll
                for (int q = 0; q < 4; ++q) { const f32x4 wa = *(const f32x4*)(F.final_w + d0i + 4 * q); f32x4 oa;
#pragma unroll
                    for (int j = 0; j < 4; ++j) oa[j] = x2[4 * q + j] * rstd * wa[j];
                    *(f32x4*)(F.out + row * D + d0i + 4 * q) = oa; }
            }
        }
        __syncthreads();
    }
}

#define XB_TMO      128
#define XB_XCNT(j)  (256  + 64 * (j))
#define XB_XSUB(j)  (1280 + 64 * (j))
#define XB_XGEN(j)  (2304 + 64 * (j))
#define XB_TOP      3328
#define XB_TOPGEN   3392
#define XCD_BAR_WORDS 3456
#define XB_SPIN_CAP (1u << 20)
__device__ __forceinline__ unsigned xb_ld(unsigned* p)              { return __hip_atomic_load(p, __ATOMIC_RELAXED, __HIP_MEMORY_SCOPE_AGENT); }
__device__ __forceinline__ unsigned xb_add(unsigned* p, unsigned v) { return __hip_atomic_fetch_add(p, v, __ATOMIC_RELAXED, __HIP_MEMORY_SCOPE_AGENT); }
__device__ __forceinline__ unsigned xb_xcc_id() { return (unsigned)__builtin_amdgcn_s_getreg((3 << 11) | 20) & 0xFu; }
#define XB_SPIN(cond, bar) do { unsigned _sp = 0; while (cond) { __builtin_amdgcn_s_sleep(1); \
    if ((++_sp & 255u) == 0u) { if (xb_ld(&(bar)[XB_TMO])) break; if (_sp > XB_SPIN_CAP) { atomicAdd(&(bar)[XB_TMO], 1u); break; } } } } while (0)
struct XcdBarrier { unsigned* bar; unsigned x; volatile LAS unsigned* st; };
__device__ __forceinline__ XcdBarrier xcd_barrier_post(unsigned* bar, volatile LAS unsigned* st) {
    XcdBarrier b; b.bar = bar; b.x = xb_xcc_id(); b.st = st;
    if (threadIdx.x == 0) (void)xb_add(&bar[XB_XCNT(b.x)], 1u);
    return b;
}
__device__ __forceinline__ void xcd_barrier_complete(unsigned* bar, unsigned x, unsigned& nloc, unsigned& nx) {
    const unsigned G = gridDim.x * gridDim.y * gridDim.z;
    unsigned sum, cnt, mine, sp = 0u;
    for (;;) {
        sum = 0u; cnt = 0u; mine = 0u;
#pragma unroll
        for (unsigned j = 0; j < 16; ++j) { const unsigned c = xb_ld(&bar[XB_XCNT(j)]); sum += c; cnt += (c > 0u) ? 1u : 0u; mine = (j == x) ? c : mine; }
        if (sum == G) break;
        __builtin_amdgcn_s_sleep(1);
        if ((++sp & 255u) == 0u) { if (xb_ld(&bar[XB_TMO])) break; if (sp > XB_SPIN_CAP) { atomicAdd(&bar[XB_TMO], 1u); break; } }
    }
    nloc = mine > 0u ? mine : 1u; nx = cnt > 0u ? cnt : 1u;
}
__device__ __forceinline__ void xcd_barrier(const XcdBarrier& b) {
    asm volatile("s_waitcnt vmcnt(0)" ::: "memory");
    __syncthreads();
    if (threadIdx.x == 0) {
        unsigned* bar = b.bar;
        __builtin_amdgcn_s_waitcnt(0);
        unsigned nloc = b.st[0], nx = b.st[1];
        if (nloc == 0u) { xcd_barrier_complete(bar, b.x, nloc, nx); b.st[0] = nloc; b.st[1] = nx; }
        const unsigned old = xb_add(&bar[XB_XSUB(b.x)], 1u);
        const unsigned gen = old / nloc;
        if (old + 1u == (gen + 1u) * nloc) {
            __builtin_amdgcn_fence(__ATOMIC_RELEASE, "agent");
            asm volatile("s_waitcnt vmcnt(0)" ::: "memory");
            const unsigned og = xb_add(&bar[XB_TOP], 1u);
            const unsigned tg = og / nx;
            if (og + 1u == (tg + 1u) * nx) xb_add(&bar[XB_TOPGEN], 1u);
            else XB_SPIN(xb_ld(&bar[XB_TOPGEN]) == tg, bar);
            __builtin_amdgcn_fence(__ATOMIC_ACQUIRE, "agent");
            xb_add(&bar[XB_XGEN(b.x)], 1u);
            asm volatile("s_waitcnt vmcnt(0)" ::: "memory");
        } else {
            XB_SPIN(xb_ld(&bar[XB_XGEN(b.x)]) == gen, bar);
            __builtin_amdgcn_fence(__ATOMIC_ACQUIRE, "agent");
            asm volatile("s_waitcnt vmcnt(0)" ::: "memory");
        }
    }
    __syncthreads();
}

__global__ void __launch_bounds__(NTHR, 2) mk_fwd(Args args) {
    extern __shared__ __attribute__((aligned(16))) unsigned char lds_raw[];
    Ctx F;
    F.lds = (LAS unsigned char*)lds_raw;
    F.tid = threadIdx.x; F.lane = F.tid & 63; F.wave = __builtin_amdgcn_readfirstlane(F.tid >> 6); F.G = gridDim.x; F.bid = blockIdx.x;
    F.x = args.in[0]; F.c = args.in[1]; F.w_ada = args.in[2]; F.b_ada = args.in[3]; F.norm1_w = args.in[4]; F.w_in = args.in[5]; F.lb_logits = args.in[6];
    F.hgrn_onorm_w = args.in[7]; F.conv_w = args.in[8]; F.conv_onorm_w = args.in[9]; F.w_out = args.in[10]; F.norm2_w = args.in[11]; F.w_query = args.in[12];
    F.sub_keys = args.in[13]; F.peer_u = args.in[14]; F.peer_v = args.in[15]; F.final_w = args.in[16];
    F.out = args.out;
    unsigned char* ws = args.ws;
    F.ACH = (float*)(ws + WS_ACH); F.MOD = (float*)(ws + WS_MOD); F.LB = (float*)(ws + WS_LB);
    F.WIN = (bf16*)(ws + WS_WIN); F.WOUT = (bf16*)(ws + WS_WOUT); F.WQ = (bf16*)(ws + WS_WQ); F.KEYS = (bf16*)(ws + WS_KEYS);
    F.U8 = ws + WS_U8; F.V8 = ws + WS_V8; F.SUV = (float*)(ws + WS_SUV); F.H1 = (bf16*)(ws + WS_H1); F.YCAT = (bf16*)(ws + WS_H1);
    F.PROJ = (bf16*)(ws + WS_PROJ); F.H2 = (bf16*)(ws + WS_PROJ); F.QP = (bf16*)(ws + WS_PROJ + 32 * MiB); F.ST = (bf16*)(ws + WS_ST); F.X1B = (bf16*)(ws + WS_ST);
    const int lo = args.ph_lo, hi = args.ph_hi;
    volatile LAS unsigned* MISC = (volatile LAS unsigned*)(F.lds + MISC_OFF);
    if (F.tid < 16) MISC[F.tid] = 0u;
    __syncthreads();
    XcdBarrier bar = xcd_barrier_post((unsigned*)(ws + WS_CTL), MISC);
#define IN(k) (lo <= (k) && (k) < hi)
#define SEAM(k) do { if (IN(k) && IN((k) + 1)) { xcd_barrier(bar); } } while (0)
    if (IN(0)) { for (int rep = 0; rep < NREP(0); ++rep) p0_prep(F); } SEAM(0);
    if (IN(1)) for (int rep = 0; rep < NREP(1); ++rep) { if (rep == 0) p0_prep2(F); const int gw = F.bid * NWAVES + F.wave, NGW = F.G * NWAVES;
        for (int m = gw; m < M; m += NGW) { const float* md = F.MOD + (m >> 13) * 6144; modnorm_row(F.x + (size_t)m * D, F.norm1_w, md, md + 1024, F.H1 + (size_t)m * D, F.lane); } } SEAM(1);
    if (IN(2)) for (int rep = 0; rep < NREP(2); ++rep) { pg8::Gemm g{F.H1, F.WIN, M, NIN, D}; pg8::StaticOrder S; S.init(M, NIN, F.G, F.bid); pg8::EpiBf16 E{F.PROJ, NIN}; pg8::gemm_phase<pg8::EpiBf16>(F.lds, g, S, E);
        if (rep == 0) { if (F.G == 256) { if (F.bid >= 128) convert_experts(F, F.bid - 128, 128); } else convert_experts(F, F.bid, F.G); } } SEAM(2);
    if (IN(3)) { for (int rep = 0; rep < NREP(3); ++rep) p3_local(F); } SEAM(3);
    if (IN(4)) { p4_scan(F); } SEAM(4);
    if (IN(5)) { for (int rep = 0; rep < NREP(5); ++rep) p5_out(F); } SEAM(5);
    if (IN(6)) for (int rep = 0; rep < NREP(6); ++rep) { pg8::Gemm g{F.YCAT, F.WOUT, M, D, D}; pg8::StaticOrder S; S.init(M, D, F.G, F.bid); pg8::EpiRes E{F.x, F.X1B, F.MOD}; pg8::gemm_phase<pg8::EpiRes>(F.lds, g, S, E); } SEAM(6);
    if (IN(7)) for (int rep = 0; rep < NREP(7); ++rep) { const int gw = F.bid * NWAVES + F.wave, NGW = F.G * NWAVES;
        for (int m = gw; m < M; m += NGW) { const float* md = F.MOD + (m >> 13) * 6144; modnorm_row_bf16(F.X1B + (size_t)m * D, F.norm2_w, md + 3072, md + 4096, F.H2 + (size_t)m * D, F.lane); } } SEAM(7);
    if (IN(8)) for (int rep = 0; rep < NREP(8); ++rep) { pg8::Gemm g{F.H2, F.WQ, M, NQ, D}; pg8::StaticOrder S; S.init(M, NQ, F.G, F.bid); pg8::EpiBf16 E{F.QP, NQ}; pg8::gemm_phase<pg8::EpiBf16>(F.lds, g, S, E); } SEAM(8);
#ifndef DBG_STOP
    if (IN(9)) { p9_peer(F); }
#else
    xcd_barrier(bar);
    {
        const size_t gt = (size_t)F.bid * NTHR + F.tid, gs = (size_t)F.G * NTHR;
        for (size_t i = gt; i < (size_t)M * D; i += gs) { const size_t r = i >> 10, c = i & 1023; float v = 0.f;
            if (DBG_STOP == 2) { const bf16* p = F.PROJ + r * NIN + c; v = bf2f(p[0]) + bf2f(p[1024]) + bf2f(p[2048]) + (c < 512 ? bf2f(p[3072]) : 0.f); }
            else if (DBG_STOP == 5) { v = bf2f(F.YCAT[r * D + c]); }
            else if (DBG_STOP == 6) { v = F.out[i]; }
            else if (DBG_STOP == 8) { v = bf2f(F.QP[r * NQ + c]) + bf2f(F.QP[r * NQ + c + 1024]); }
            else if (DBG_STOP == 4 || DBG_STOP == 3) { v = bf2f(F.ST[i]); }
            else if (DBG_STOP == 1) { v = bf2f(F.H1[i]); }
            F.out[i] = v; }
    }
#endif
#undef IN
#undef SEAM
}

extern "C" void kernel_launch(void* const* d_in, const int* in_sizes, int n_in, void* d_out, int out_size, void* d_ws, size_t ws_size, hipStream_t stream) {
    static int grid = 0;
    if (grid == 0) {
        if (n_in != 17 || out_size != M * D || ws_size < WS_END) { fprintf(stderr, "kernel_launch: unexpected shapes (n_in %d out %d ws %zu)\n", n_in, out_size, ws_size); grid = -1; return; }
        int dev = 0, cus = 0, per_cu = 0;
        (void)hipGetDevice(&dev); (void)hipDeviceGetAttribute(&cus, hipDeviceAttributeMultiprocessorCount, dev);
        if (hipFuncSetAttribute((const void*)mk_fwd, hipFuncAttributeMaxDynamicSharedMemorySize, LDS_BYTES) != hipSuccess) { fprintf(stderr, "kernel_launch: hipFuncSetAttribute failed\n"); grid = -1; return; }
        if (hipOccupancyMaxActiveBlocksPerMultiprocessor(&per_cu, (const void*)mk_fwd, NTHR, LDS_BYTES) != hipSuccess || per_cu < 1) { fprintf(stderr, "kernel_launch: occupancy query gives %d\n", per_cu); per_cu = 1; }
        (void)hipGetLastError();
        grid = cus;
    }
    if (grid < 0) return;
    if (hipMemsetAsync((char*)d_ws + WS_CTL, 0, CTL_ZERO_BYTES, stream) != hipSuccess) { fprintf(stderr, "kernel_launch: memset failed\n"); return; }
    Args a{};
    for (int i = 0; i < 17; ++i) a.in[i] = (const float*)d_in[i];
    a.out = (float*)d_out; a.ws = (unsigned char*)d_ws;
#if MK_LAUNCHES == 1
#ifdef DBG_STOP
    a.ph_lo = 0; a.ph_hi = DBG_STOP + 1;
#else
    a.ph_lo = 0; a.ph_hi = 10;
#endif
    void* kargs[] = {&a};
    hipError_t e = hipLaunchCooperativeKernel((const void*)mk_fwd, dim3(grid), dim3(NTHR), kargs, LDS_BYTES, stream);
    if (e != hipSuccess) fprintf(stderr, "kernel_launch: cooperative launch failed: %s (grid %d)\n", hipGetErrorString(e), grid);
#else
    for (int ph = 0; ph < 10; ++ph) { a.ph_lo = ph; a.ph_hi = ph + 1; hipLaunchKernelGGL(mk_fwd, dim3(grid), dim3(NTHR), LDS_BYTES, stream, a); }
#endif
}
```
